# Optimizing an MI355X kernel written in HIP

```python
import jax, jax.numpy as jnp
from jax import lax
import numpy as np

D_MODEL = 1024
BATCH = 8
SEQ = 4096
DEPTH = 2

N_MEM = 256
POOL_WINDOWS = (2, 4, 8, 16)
POOL_WIDTH = 512
POOL_GROUP = POOL_WIDTH // len(POOL_WINDOWS)
FOX_HEADS = 8
FOX_HEAD_DIM = 64
FOX_WIDTH = FOX_HEADS * FOX_HEAD_DIM
MEM_HEADS = 4
MEM_HEAD_DIM = 128
MEM_WIDTH = MEM_HEADS * MEM_HEAD_DIM
N_BRANCH = 3
Q_BLOCK = 128
D_FF = 2816
N_EXPERTS = 8
TOP_K = 2
D_EXPERT = 3584
N_DENSE = (DEPTH + 1) // 2
N_MOE = DEPTH // 2
EPS = 1e-6

OFF_POOL = 0
OFF_Q = OFF_POOL + POOL_WIDTH
OFF_K = OFF_Q + FOX_WIDTH
OFF_V = OFF_K + FOX_WIDTH
OFF_F = OFF_V + FOX_WIDTH
OFF_MQ = OFF_F + FOX_HEADS
OFF_G = OFF_MQ + MEM_WIDTH
N_IN = OFF_G + N_BRANCH * D_MODEL

kernel_name = "hybrid_pool_fox_memxattn_moe_block"


def rms_norm(x, g):
    xf = x.astype(jnp.float32)
    y = xf * lax.rsqrt(jnp.mean(xf * xf, axis=-1, keepdims=True) + EPS)
    return (y * g.astype(jnp.float32)).astype(x.dtype)


def pool_mixer(u, pool_w, pool_scale):
    B, S, _ = u.shape
    G = len(POOL_WINDOWS)
    uf = u.astype(jnp.float32).reshape(B, S, G, POOL_GROUP)
    cpad = jnp.pad(jnp.cumsum(uf, axis=1), ((0, 0), (1, 0), (0, 0), (0, 0)))
    pos = jnp.arange(S)
    outs = []
    for g, w in enumerate(POOL_WINDOWS):
        c = cpad[:, :, g]
        lag = jnp.pad(c, ((0, 0), (w, 0), (0, 0)))[:, 1:S + 1]
        cnt = jnp.minimum(pos + 1, w).astype(jnp.float32)[None, :, None]
        outs.append((c[:, 1:] - lag) / cnt - uf[:, :, g])
    d = jnp.stack(outs, axis=2)
    y = jnp.einsum('bsgc,gcd->bsgd', d, pool_w.astype(jnp.float32))
    return (y.reshape(B, S, POOL_WIDTH) * pool_scale.astype(jnp.float32)).astype(u.dtype)


def head_rms(x, g):
    return rms_norm(x, g)


def fox_attention(q, k, v, f_logit, q_g, k_g):
    B, S, _ = q.shape
    H, dh = FOX_HEADS, FOX_HEAD_DIM
    q = head_rms(q.reshape(B, S, H, dh), q_g)
    k = head_rms(k.reshape(B, S, H, dh), k_g)
    v = v.reshape(B, S, H, dh)
    logf = jax.nn.log_sigmoid(f_logit.astype(jnp.float32))
    c = jnp.cumsum(logf, axis=1).transpose(0, 2, 1)
    nb = S // Q_BLOCK
    qb = q.reshape(B, nb, Q_BLOCK, H, dh).transpose(1, 0, 2, 3, 4)
    cb = c.reshape(B, H, nb, Q_BLOCK).transpose(2, 0, 1, 3)
    kpos = jnp.arange(S)
    scale = dh ** -0.5

    def block(args):
        qi, ci, i = args
        s = jnp.einsum('bqhd,bkhd->bhqk', qi, k, preferred_element_type=jnp.float32) * scale
        s = s + (ci[..., :, None] - c[..., None, :])
        qpos = i * Q_BLOCK + jnp.arange(Q_BLOCK)
        s = jnp.where(kpos[None, :] <= qpos[:, None], s, -jnp.inf)
        p = jax.nn.softmax(s, axis=-1)
        return jnp.einsum('bhqk,bkhd->bqhd', p.astype(v.dtype), v)

    o = lax.map(block, (qb, cb, jnp.arange(nb)))
    return o.transpose(1, 0, 2, 3, 4).reshape(B, S, FOX_WIDTH)


def mem_attention(qm, mem_n, w_kv, q_g, k_g):
    B, S, _ = qm.shape
    M = mem_n.shape[1]
    H, dh = MEM_HEADS, MEM_HEAD_DIM
    kv = mem_n @ w_kv
    k = head_rms(kv[..., :MEM_WIDTH].reshape(B, M, H, dh), k_g)
    v = kv[..., MEM_WIDTH:].reshape(B, M, H, dh)
    q = head_rms(qm.reshape(B, S, H, dh), q_g)
    s = jnp.einsum('bshd,bmhd->bhsm', q, k, preferred_element_type=jnp.float32) * (dh ** -0.5)
    p = jax.nn.softmax(s, axis=-1)
    o = jnp.einsum('bhsm,bmhd->bshd', p.astype(v.dtype), v)
    return o.reshape(B, S, MEM_WIDTH)


def swiglu(h, w_gu, w_d):
    gu = h @ w_gu
    f = w_d.shape[0]
    return (jax.nn.silu(gu[..., :f]) * gu[..., f:]) @ w_d


def moe_ffn(h, w_r, b_r, w_gu, w_d):
    B, S, D = h.shape
    t = h.reshape(B * S, D)
    logits = (t @ w_r).astype(jnp.float32) + b_r.astype(jnp.float32)
    top_v, top_i = lax.top_k(logits, TOP_K)
    wts = jax.nn.softmax(top_v, axis=-1)
    combine = jnp.sum(jax.nn.one_hot(top_i, N_EXPERTS, dtype=jnp.float32) * wts[..., None], axis=1)
    y = jnp.zeros((B * S, D), jnp.float32)
    for e in range(N_EXPERTS):
        y = y + combine[:, e:e + 1] * swiglu(t, w_gu[e], w_d[e]).astype(jnp.float32)
    return y.reshape(B, S, D).astype(h.dtype)


def setup_inputs(seed: int = 0) -> dict:
    key = jax.random.key(seed)
    ks = jax.random.split(key, 24)
    D = D_MODEL
    nrm = lambda k, shape, fan: jax.random.normal(k, shape, jnp.float32) * (fan ** -0.5)
    gain = lambda k, shape: 1.0 + 0.02 * jax.random.normal(k, shape, jnp.float32)
    return {
        "x": jax.random.normal(ks[0], (BATCH, SEQ, D), jnp.float32),
        "mem": jax.random.normal(ks[1], (BATCH, N_MEM, D), jnp.float32),
        "mix_norm_g": gain(ks[2], (DEPTH, D)),
        "w_in": nrm(ks[3], (DEPTH, D, N_IN), D),
        "b_forget": jax.random.uniform(ks[4], (DEPTH, FOX_HEADS), jnp.float32, 1.0, 5.0),
        "fox_q_g": gain(ks[5], (DEPTH, FOX_HEAD_DIM)),
        "fox_k_g": gain(ks[6], (DEPTH, FOX_HEAD_DIM)),
        "pool_w": nrm(ks[7], (DEPTH, len(POOL_WINDOWS), POOL_GROUP, POOL_GROUP), POOL_GROUP),
        "pool_scale": gain(ks[8], (DEPTH, POOL_WIDTH)),
        "mem_norm_g": gain(ks[9], (DEPTH, D)),
        "w_mem_kv": nrm(ks[10], (DEPTH, D, 2 * MEM_WIDTH), D),
        "mem_q_g": gain(ks[11], (DEPTH, MEM_HEAD_DIM)),
        "mem_k_g": gain(ks[12], (DEPTH, MEM_HEAD_DIM)),
        "w_pool_br": nrm(ks[13], (DEPTH, POOL_WIDTH, D), POOL_WIDTH),
        "w_fox_br": nrm(ks[14], (DEPTH, FOX_WIDTH, D), FOX_WIDTH),
        "w_mem_br": nrm(ks[15], (DEPTH, MEM_WIDTH, D), MEM_WIDTH),
        "w_out": 0.5 * nrm(ks[16], (DEPTH, D, D), D),
        "ffn_norm_g": gain(ks[17], (DEPTH, D)),
        "w_ffn_gu": nrm(ks[18], (N_DENSE, D, 2 * D_FF), D),
        "w_ffn_down": 0.5 * nrm(ks[19], (N_DENSE, D_FF, D), D_FF),
        "w_router": nrm(ks[20], (N_MOE, D, N_EXPERTS), D),
        "b_router": 0.01 * jax.random.normal(ks[21], (N_MOE, N_EXPERTS), jnp.float32),
        "w_exp_gu": nrm(ks[22], (N_MOE, N_EXPERTS, D, 2 * D_EXPERT), D),
        "w_exp_down": 0.5 * nrm(ks[23], (N_MOE, N_EXPERTS, D_EXPERT, D), D_EXPERT),
    }


def reference(x, mem, mix_norm_g, w_in, b_forget, fox_q_g, fox_k_g, pool_w, pool_scale,
              mem_norm_g, w_mem_kv, mem_q_g, mem_k_g, w_pool_br, w_fox_br, w_mem_br, w_out,
              ffn_norm_g, w_ffn_gu, w_ffn_down, w_router, b_router, w_exp_gu, w_exp_down):
    B, S, D = x.shape
    for layer in range(DEPTH):
        h = rms_norm(x, mix_norm_g[layer])
        z = h @ w_in[layer]
        pool_o = pool_mixer(z[..., OFF_POOL:OFF_Q], pool_w[layer], pool_scale[layer])
        fox_o = fox_attention(z[..., OFF_Q:OFF_K], z[..., OFF_K:OFF_V], z[..., OFF_V:OFF_F],
                              z[..., OFF_F:OFF_MQ] + b_forget[layer].astype(z.dtype),
                              fox_q_g[layer], fox_k_g[layer])
        mem_n = rms_norm(mem, mem_norm_g[layer])
        mem_o = mem_attention(z[..., OFF_MQ:OFF_G], mem_n, w_mem_kv[layer],
                              mem_q_g[layer], mem_k_g[layer])
        gates = jax.nn.sigmoid(z[..., OFF_G:].astype(jnp.float32)).reshape(B, S, N_BRANCH, D)
        merged = (gates[:, :, 0] * (pool_o @ w_pool_br[layer]).astype(jnp.float32)
                  + gates[:, :, 1] * (fox_o @ w_fox_br[layer]).astype(jnp.float32)
                  + gates[:, :, 2] * (mem_o @ w_mem_br[layer]).astype(jnp.float32))
        x = x + merged.astype(x.dtype) @ w_out[layer]
        h = rms_norm(x, ffn_norm_g[layer])
        if layer % 2 == 0:
            y = swiglu(h, w_ffn_gu[layer // 2], w_ffn_down[layer // 2])
        else:
            y = moe_ffn(h, w_router[layer // 2], b_router[layer // 2],
                        w_exp_gu[layer // 2], w_exp_down[layer // 2])
        x = x + y.astype(x.dtype)
    return x
```

```cpp
#include <hip/hip_runtime.h>
#include <cstdio>
#include <cstdint>

constexpr int D = 1024, BATCH = 8, SEQ = 4096, T = BATCH * SEQ, DEPTH = 2;
constexpr int NMEM = 256, MROWS = BATCH * NMEM;
constexpr int FH = 8, FD = 64, MH = 4, MD = 128;
constexpr int DFF = 2816, NE = 8, DEXP = 3584;
constexpr int OFF_POOL = 0, OFF_Q = 512, OFF_K = 1024, OFF_V = 1536, OFF_F = 2048, OFF_MQ = 2056, OFF_G = 2568, NIN = 5640;
constexpr float EPS = 1e-6f;
constexpr float LOG2E = 1.4426950408889634f;
constexpr float C2F = 0.125f * LOG2E;
constexpr float C2M = 0.08838834764831845f * LOG2E;
constexpr int NWAVES = 8, NTHREADS = 512;

enum { I_X = 0, I_MEM, I_MIXG, I_WIN, I_BF, I_FQG, I_FKG, I_POOLW, I_POOLS, I_MEMG, I_WKV, I_MQG, I_MKG, I_WPBR, I_WFBR, I_WMBR, I_WOUT, I_FFNG, I_WGU, I_WDN, I_WR, I_BR, I_WEGU, I_WEDN, N_IN_ };

constexpr size_t MiB = 1u << 20;
constexpr size_t WS_CTL = 0, CTL_ZERO_BYTES = 1 * MiB;
constexpr size_t WS_LOGF = 1 * MiB, WS_CL = 2 * MiB, WS_CHOICE = 3 * MiB, WS_WCNT = 3 * MiB + 512 * 1024;
constexpr size_t WS_W = 8 * MiB;
constexpr size_t WS_MEMN = 232 * MiB, WS_KVF = 240 * MiB, WS_KM = 256 * MiB, WS_VM = 260 * MiB;
constexpr size_t WS_H = 264 * MiB;
constexpr size_t WS_AR = 328 * MiB;
constexpr size_t AR_U = 0, AR_Q = 32 * MiB, AR_K = 64 * MiB, AR_V = 96 * MiB, AR_MQ = 128 * MiB, AR_G = 192 * MiB, AR_PD = 384 * MiB, AR_MO = 416 * MiB, AR_PO = 448 * MiB, AR_FO = 480 * MiB;
constexpr size_t AR_ACT = 0;
constexpr size_t WS_END = 896 * MiB;

constexpr int CW_TMO = 0, CW_CODE = 1, CW_BAR = 4096;

#define GAS __attribute__((address_space(1)))
#define LAS __attribute__((address_space(3)))
typedef unsigned short bf16;
typedef unsigned v4u __attribute__((ext_vector_type(4)));
typedef unsigned v2u __attribute__((ext_vector_type(2)));
typedef float f32x4 __attribute__((ext_vector_type(4)));
typedef GAS unsigned gu32;
#define RLX_AGENT __ATOMIC_RELAXED, __HIP_MEMORY_SCOPE_AGENT
__device__ __forceinline__ float bf2f(unsigned v) { return __uint_as_float(v << 16); }
__device__ __forceinline__ unsigned f2bf(float f) { unsigned u = __float_as_uint(f); return (u + 0x7fffu + ((u >> 16) & 1u)) >> 16; }
__device__ __forceinline__ unsigned pk2(float lo, float hi) { return f2bf(lo) | (f2bf(hi) << 16); }
__device__ __forceinline__ float wave_sum(float v) {
#pragma unroll
    for (int o = 1; o < 64; o <<= 1) v += __shfl_xor(v, o);
    return v;
}
__device__ __forceinline__ float log_sigmoid_f(float x) { return fminf(x, 0.f) - log1pf(expf(-fabsf(x))); }
__device__ __forceinline__ float sigmoid_f(float x) { return 1.0f / (1.0f + expf(-x)); }

#define XB_TMO      128
#define XB_XCNT(j)  (256  + 64 * (j))
#define XB_XSUB(j)  (1280 + 64 * (j))
#define XB_XGEN(j)  (2304 + 64 * (j))
#define XB_TOP      3328
#define XB_TOPGEN   3392
#define XCD_BAR_WORDS 3456
#define XB_SPIN_CAP (1u << 22)

__device__ __forceinline__ unsigned xb_ld(unsigned* p)              { return __hip_atomic_load(p, __ATOMIC_RELAXED, __HIP_MEMORY_SCOPE_AGENT); }
__device__ __forceinline__ unsigned xb_add(unsigned* p, unsigned v) { return __hip_atomic_fetch_add(p, v, __ATOMIC_RELAXED, __HIP_MEMORY_SCOPE_AGENT); }
__device__ __forceinline__ unsigned xb_xcc_id() { return (unsigned)__builtin_amdgcn_s_getreg((3 << 11) | 20) & 0xFu; }
#define XB_SPIN(cond, bar) do { unsigned _sp = 0; while (cond) { __builtin_amdgcn_s_sleep(1); \
    if ((++_sp & 255u) == 0u) { if (xb_ld(&(bar)[XB_TMO])) break; if (_sp > XB_SPIN_CAP) { atomicAdd(&(bar)[XB_TMO], 1u); break; } } } } while (0)

struct XcdBarrier { unsigned* bar; unsigned x; volatile LAS unsigned* st; };

__device__ __forceinline__ XcdBarrier xcd_barrier_post(unsigned* bar, volatile LAS unsigned* st) {
    XcdBarrier b; b.bar = bar; b.x = xb_xcc_id(); b.st = st;
    if (threadIdx.x == 0) (void)xb_add(&bar[XB_XCNT(b.x)], 1u);
    return b;
}
__device__ __forceinline__ void xcd_barrier_complete(unsigned* bar, unsigned x, unsigned& nloc, unsigned& nx) {
    const unsigned G = gridDim.x * gridDim.y * gridDim.z;
    unsigned sum, cnt, mine, sp = 0u;
    for (;;) {
        sum = 0u; cnt = 0u; mine = 0u;
#pragma unroll
        for (unsigned j = 0; j < 16; ++j) { const unsigned c = xb_ld(&bar[XB_XCNT(j)]); sum += c; cnt += (c > 0u) ? 1u : 0u; mine = (j == x) ? c : mine; }
        if (sum == G) break;
        __builtin_amdgcn_s_sleep(1);
        if ((++sp & 255u) == 0u) { if (xb_ld(&bar[XB_TMO])) break; if (sp > XB_SPIN_CAP) { atomicAdd(&bar[XB_TMO], 1u); break; } }
    }
    nloc = mine > 0u ? mine : 1u; nx = cnt > 0u ? cnt : 1u;
}
__device__ __forceinline__ void xcd_barrier(const XcdBarrier& b) {
    asm volatile("s_waitcnt vmcnt(0)" ::: "memory");
    __syncthreads();
    if (threadIdx.x == 0) {
        unsigned* bar = b.bar;
        __builtin_amdgcn_s_waitcnt(0);
        unsigned nloc = b.st[0], nx = b.st[1];
        if (nloc == 0u) { xcd_barrier_complete(bar, b.x, nloc, nx); b.st[0] = nloc; b.st[1] = nx; }
        const unsigned old = xb_add(&bar[XB_XSUB(b.x)], 1u);
        const unsigned gen = old / nloc;
        if (old + 1u == (gen + 1u) * nloc) {
            __builtin_amdgcn_fence(__ATOMIC_RELEASE, "agent");
            asm volatile("s_waitcnt vmcnt(0)" ::: "memory");
            const unsigned og = xb_add(&bar[XB_TOP], 1u);
            const unsigned tg = og / nx;
            if (og + 1u == (tg + 1u) * nx) xb_add(&bar[XB_TOPGEN], 1u);
            else XB_SPIN(xb_ld(&bar[XB_TOPGEN]) == tg, bar);
            __builtin_amdgcn_fence(__ATOMIC_ACQUIRE, "agent");
            xb_add(&bar[XB_XGEN(b.x)], 1u);
            asm volatile("s_waitcnt vmcnt(0)" ::: "memory");
        } else {
            XB_SPIN(xb_ld(&bar[XB_XGEN(b.x)]) == gen, bar);
            __builtin_amdgcn_fence(__ATOMIC_ACQUIRE, "agent");
            asm volatile("s_waitcnt vmcnt(0)" ::: "memory");
        }
    }
    __syncthreads();
}

constexpr int RING_OFF = 0, RING_BYTES = 131072;
constexpr int LDSCTL_OFF = RING_BYTES, MISC_OFF = LDSCTL_OFF + 320;
constexpr int LDS_BYTES = 147456;

struct Args { const float* in[N_IN_]; float* out; unsigned char* ws; int ph_lo, ph_hi; };
struct Frame {
    LAS unsigned char* lds; volatile LAS unsigned* MISC; gu32* ctl;
    int tid, lane, wave, vcu, G;
    float* X; unsigned char* ws;
};
struct Choice { int e1, e2; float w1, w2; };
constexpr int PTR_OFF = LDSCTL_OFF + 1024;
__device__ __forceinline__ const float* inptr(const Frame& F, int i) {
    const volatile LAS unsigned* p = (const volatile LAS unsigned*)(F.lds + PTR_OFF) + 2 * i;
    const unsigned lo = __builtin_amdgcn_readfirstlane(p[0]), hi = __builtin_amdgcn_readfirstlane(p[1]);
    return (const float*)(uintptr_t)(((unsigned long long)hi << 32) | lo);
}

template <int MODE>
__device__ __forceinline__ void norm_phase(Frame& F, const float* xin, const float* g, const float* W8, int ldw8, const float* b8, bf16* Hout) {
    const int lane = F.lane, gw = F.vcu * NWAVES + F.wave, NGW = F.G * NWAVES;
    f32x4 gv[4];
#pragma unroll
    for (int j = 0; j < 4; ++j) gv[j] = *(const f32x4*)(g + 256 * j + 4 * lane);
    LAS f32x4* tab = (LAS f32x4*)(F.lds + RING_OFF);
    if (MODE != 0) {
        for (int q = F.tid; q < 2048; q += NTHREADS) { const int ln = q & 63, hf = (q >> 6) & 1, ji = q >> 7; const int k = 256 * (ji >> 2) + 4 * ln + (ji & 3);
            tab[q] = *(const f32x4*)(W8 + (size_t)k * ldw8 + 4 * hf); }
        __syncthreads();
    }
    int cnt[8];
#pragma unroll
    for (int e = 0; e < 8; ++e) cnt[e] = 0;
    for (int m = gw; m < T; m += NGW) {
        const f32x4* xr = (const f32x4*)(xin + (size_t)m * D) + lane;
        f32x4 v[4]; float ss = 0.f;
#pragma unroll
        for (int j = 0; j < 4; ++j) { v[j] = xr[64 * j]; ss += (v[j][0] * v[j][0] + v[j][1] * v[j][1]) + (v[j][2] * v[j][2] + v[j][3] * v[j][3]); }
        ss = wave_sum(ss);
        const float rstd = 1.0f / sqrtf(ss * (1.0f / D) + EPS);
        unsigned long long* o8 = (unsigned long long*)(Hout + (size_t)m * D) + lane;
#pragma unroll
        for (int j = 0; j < 4; ++j) { v[j] = v[j] * rstd * gv[j]; o8[64 * j] = (unsigned long long)pk2(v[j][0], v[j][1]) | ((unsigned long long)pk2(v[j][2], v[j][3]) << 32); }
        if (MODE != 0) {
            float p[8];
#pragma unroll
            for (int e = 0; e < 8; ++e) p[e] = 0.f;
#pragma unroll
            for (int j = 0; j < 4; ++j)
#pragma unroll
                for (int i = 0; i < 4; ++i) { const f32x4 wa = tab[((j * 4 + i) * 2 + 0) * 64 + lane], wb = tab[((j * 4 + i) * 2 + 1) * 64 + lane]; const float hv = v[j][i];
                    p[0] = fmaf(hv, wa[0], p[0]); p[1] = fmaf(hv, wa[1], p[1]); p[2] = fmaf(hv, wa[2], p[2]); p[3] = fmaf(hv, wa[3], p[3]);
                    p[4] = fmaf(hv, wb[0], p[4]); p[5] = fmaf(hv, wb[1], p[5]); p[6] = fmaf(hv, wb[2], p[6]); p[7] = fmaf(hv, wb[3], p[7]);
                    if (i == 3) asm volatile("" ::: "memory"); }
            float k4[4];
            { const bool hi = (lane & 32) != 0;
#pragma unroll
              for (int i = 0; i < 4; ++i) { const float keep = hi ? p[4 + i] : p[i], send = hi ? p[i] : p[4 + i]; k4[i] = keep + __shfl_xor(send, 32); } }
            float k2[2];
            { const bool hi = (lane & 16) != 0;
#pragma unroll
              for (int i = 0; i < 2; ++i) { const float keep = hi ? k4[2 + i] : k4[i], send = hi ? k4[i] : k4[2 + i]; k2[i] = keep + __shfl_xor(send, 16); } }
            float k1;
            { const bool hi = (lane & 8) != 0; const float keep = hi ? k2[1] : k2[0], send = hi ? k2[0] : k2[1]; k1 = keep + __shfl_xor(send, 8); }
            k1 += __shfl_xor(k1, 4); k1 += __shfl_xor(k1, 2); k1 += __shfl_xor(k1, 1);
            const int e_mine = ((lane >> 5) & 1) * 4 + ((lane >> 4) & 1) * 2 + ((lane >> 3) & 1);
            const float val = k1 + b8[e_mine];
            if (MODE == 1) {
                if ((lane & 7) == 0) { const int b = m / SEQ, s = m % SEQ; ((float*)(F.ws + WS_LOGF))[(size_t)(b * FH + e_mine) * SEQ + s] = log_sigmoid_f(val); }
            } else {
                float lg[8];
#pragma unroll
                for (int e = 0; e < 8; ++e) lg[e] = __shfl(val, ((e >> 2) & 1) * 32 + ((e >> 1) & 1) * 16 + (e & 1) * 8);
                float b1 = -INFINITY, b2 = -INFINITY; int i1 = 0, i2 = 0;
#pragma unroll
                for (int e = 0; e < 8; ++e) { if (lg[e] > b1) { b2 = b1; i2 = i1; b1 = lg[e]; i1 = e; } else if (lg[e] > b2) { b2 = lg[e]; i2 = e; } }
                const float ex = expf(b2 - b1), w1 = 1.0f / (1.0f + ex), w2 = ex / (1.0f + ex);
                if (lane == 0) { Choice c; c.e1 = i1; c.e2 = i2; c.w1 = w1; c.w2 = w2; ((Choice*)(F.ws + WS_CHOICE))[m] = c; }
#pragma unroll
                for (int e = 0; e < 8; ++e) cnt[e] += (i1 == e) + (i2 == e);
            }
        }
    }
    if (MODE != 0) __syncthreads();
    if (MODE == 2) {
        int mine = 0;
#pragma unroll
        for (int e = 0; e < 8; ++e) mine = (lane == e) ? cnt[e] : mine;
        if (lane < 8) ((int*)(F.ws + WS_WCNT))[gw * 8 + lane] = mine;
    }
}

__device__ __forceinline__ void cumsum_phase(Frame& F) {
    if (F.vcu >= BATCH * FH || F.wave != 0) return;
    const float* lf = (const float*)(F.ws + WS_LOGF) + (size_t)F.vcu * SEQ + 64 * F.lane;
    float* cl = (float*)(F.ws + WS_CL) + (size_t)F.vcu * SEQ + 64 * F.lane;
    double tot = 0.0;
    for (int i = 0; i < 64; ++i) tot += (double)lf[i];
    double inc = tot;
#pragma unroll
    for (int o = 1; o < 64; o <<= 1) { const double t = __shfl_up(inc, o); if (F.lane >= o) inc += t; }
    double run = inc - tot;
    for (int i = 0; i < 64; ++i) { run += (double)lf[i]; cl[i] = (float)(run * 1.4426950408889634); }
}

__device__ __forceinline__ void pool_phase(Frame& F) {
    const bf16* U = (const bf16*)(F.ws + WS_AR + AR_U); bf16* PD = (bf16*)(F.ws + WS_AR + AR_PD);
    const int lane = F.lane, gw = F.vcu * NWAVES + F.wave, NGW = F.G * NWAVES;
    const int w = 2 << (lane >> 4);
    for (int m = gw; m < T; m += NGW) {
        const int t = m % SEQ; const int n = (t + 1 < w) ? (t + 1) : w;
        float s[8];
#pragma unroll
        for (int i = 0; i < 8; ++i) s[i] = 0.f;
        v4u cur = (v4u){0u, 0u, 0u, 0u};
        for (int j = 0; j < n; ++j) { const v4u x = *(const v4u*)(U + (size_t)(m - j) * 512 + 8 * lane); if (j == 0) cur = x;
#pragma unroll
            for (int i = 0; i < 4; ++i) { s[2 * i] += bf2f(x[i] & 0xffffu); s[2 * i + 1] += bf2f(x[i] >> 16); } }
        const float inv = 1.0f / (float)n; v4u o;
#pragma unroll
        for (int i = 0; i < 4; ++i) o[i] = pk2(s[2 * i] * inv - bf2f(cur[i] & 0xffffu), s[2 * i + 1] * inv - bf2f(cur[i] >> 16));
        *(v4u*)(PD + (size_t)m * 512 + 8 * lane) = o;
    }
}

__device__ __forceinline__ void memnorm_phase(Frame& F, const float* mem, const float* memg) {
    const int lane = F.lane, gw = F.vcu * NWAVES + F.wave, NGW = F.G * NWAVES;
    for (int it = gw; it < DEPTH * MROWS; it += NGW) {
        const int l = it / MROWS, r = it % MROWS;
        const f32x4* xr = (const f32x4*)(mem + (size_t)r * D) + lane; const float* g = memg + l * D;
        f32x4 v[4]; float ss = 0.f;
#pragma unroll
        for (int j = 0; j < 4; ++j) { v[j] = xr[64 * j]; ss += (v[j][0] * v[j][0] + v[j][1] * v[j][1]) + (v[j][2] * v[j][2] + v[j][3] * v[j][3]); }
        ss = wave_sum(ss); const float rstd = 1.0f / sqrtf(ss * (1.0f / D) + EPS);
        unsigned long long* o8 = (unsigned long long*)((bf16*)(F.ws + WS_MEMN) + (size_t)it * D) + lane;
#pragma unroll
        for (int j = 0; j < 4; ++j) { const f32x4 h = v[j] * rstd * *(const f32x4*)(g + 256 * j + 4 * lane); o8[64 * j] = (unsigned long long)pk2(h[0], h[1]) | ((unsigned long long)pk2(h[2], h[3]) << 32); }
    }
}
__device__ __forceinline__ void kvfin_phase(Frame& F, const float* mkg) {
    const int lane = F.lane, gw = F.vcu * NWAVES + F.wave, NGW = F.G * NWAVES;
    for (int it = gw; it < DEPTH * MROWS; it += NGW) {
        const int l = it / MROWS;
        const f32x4* xr = (const f32x4*)((const float*)(F.ws + WS_KVF) + (size_t)it * 1024) + lane;
        f32x4 v[4];
#pragma unroll
        for (int j = 0; j < 4; ++j) v[j] = xr[64 * j];
        unsigned long long* ok = (unsigned long long*)((bf16*)(F.ws + WS_KM) + (size_t)it * 512) + lane;
        unsigned long long* ov = (unsigned long long*)((bf16*)(F.ws + WS_VM) + (size_t)it * 512) + lane;
#pragma unroll
        for (int j = 0; j < 2; ++j) {
            float ss = (v[j][0] * v[j][0] + v[j][1] * v[j][1]) + (v[j][2] * v[j][2] + v[j][3] * v[j][3]);
#pragma unroll
            for (int o = 1; o < 32; o <<= 1) ss += __shfl_xor(ss, o);
            const float rstd = 1.0f / sqrtf(ss * (1.0f / MD) + EPS);
            const f32x4 gg = *(const f32x4*)(mkg + l * MD + 4 * (lane & 31));
            const f32x4 h = v[j] * rstd * gg; ok[64 * j] = (unsigned long long)pk2(h[0], h[1]) | ((unsigned long long)pk2(h[2], h[3]) << 32);
        }
#pragma unroll
        for (int j = 0; j < 2; ++j) { const f32x4 h = v[2 + j]; ov[64 * j] = (unsigned long long)pk2(h[0], h[1]) | ((unsigned long long)pk2(h[2], h[3]) << 32); }
    }
}

__device__ __forceinline__ void rb2(float (&acc)[16], const bf16* A, int lda, int K, const float* W, int ldw) {
    for (int k = 0; k < K; k += 8) {
        float w[8];
#pragma unroll
        for (int kk = 0; kk < 8; ++kk) w[kk] = W[(size_t)(k + kk) * ldw];
#pragma unroll
        for (int r = 0; r < 16; ++r) { const v4u a = *(const v4u*)(A + (size_t)r * lda + k);
#pragma unroll
            for (int i = 0; i < 4; ++i) { acc[r] = fmaf(bf2f(a[i] & 0xffffu), w[2 * i], acc[r]); acc[r] = fmaf(bf2f(a[i] >> 16), w[2 * i + 1], acc[r]); } }
    }
}
#define WITEM_LOOP(NRG, NBLK) for (long it_ = (long)F.vcu * NWAVES + F.wave; it_ < (long)(NRG) * (NBLK); it_ += (long)F.G * NWAVES)
#define WITEM_RB(NRG, row0, blk) const int row0 = 16 * (int)(it_ % (NRG)); const int blk = (int)(it_ / (NRG))
#define ZERO16(a) _Pragma("unroll") for (int r_ = 0; r_ < 16; ++r_) a[r_] = 0.f

__device__ __forceinline__ void n_inproj(Frame& F, const float* win, const float* fqg, const float* fkg) {
    const bf16* H = (const bf16*)(F.ws + WS_H); unsigned char* ar = F.ws + WS_AR; const int lane = F.lane;
    WITEM_LOOP(T / 16, 88) { WITEM_RB(T / 16, row0, blk);
        float acc[16]; ZERO16(acc);
        const int col0 = blk < 32 ? 64 * blk : (blk < 40 ? OFF_MQ + 64 * (blk - 32) : OFF_G + 64 * (blk - 40));
        rb2(acc, H + (size_t)row0 * D, D, D, win + col0 + lane, NIN);
        if (blk < 8) { bf16* o = (bf16*)(ar + AR_U) + (size_t)row0 * 512 + 64 * blk + lane;
#pragma unroll
            for (int r = 0; r < 16; ++r) o[(size_t)r * 512] = (bf16)f2bf(acc[r]); }
        else if (blk < 24) { const bool isq = blk < 16; const int h = isq ? blk - 8 : blk - 16; const float gg = (isq ? fqg : fkg)[lane] * (isq ? C2F : 1.0f);
            bf16* o = (bf16*)(ar + (isq ? AR_Q : AR_K)) + (size_t)row0 * 512 + 64 * h + lane;
#pragma unroll
            for (int r = 0; r < 16; ++r) { const float ss = wave_sum(acc[r] * acc[r]); const float rstd = 1.0f / sqrtf(ss * (1.0f / FD) + EPS); o[(size_t)r * 512] = (bf16)f2bf(acc[r] * rstd * gg); } }
        else if (blk < 32) { bf16* o = (bf16*)(ar + AR_V) + (size_t)row0 * 512 + 64 * (blk - 24) + lane;
#pragma unroll
            for (int r = 0; r < 16; ++r) o[(size_t)r * 512] = (bf16)f2bf(acc[r]); }
        else if (blk < 40) { float* o = (float*)(ar + AR_MQ) + (size_t)row0 * 512 + 64 * (blk - 32) + lane;
#pragma unroll
            for (int r = 0; r < 16; ++r) o[(size_t)r * 512] = acc[r]; }
        else { bf16* o = (bf16*)(ar + AR_G) + (size_t)row0 * 3072 + 64 * (blk - 40) + lane;
#pragma unroll
            for (int r = 0; r < 16; ++r) o[(size_t)r * 3072] = (bf16)f2bf(sigmoid_f(acc[r])); }
    }
}
__device__ __forceinline__ void n_memkv(Frame& F, const float* wkv) {
    const int lane = F.lane;
    WITEM_LOOP(DEPTH * MROWS / 16, 16) { WITEM_RB(DEPTH * MROWS / 16, row0, blk);
        const int l = row0 / MROWS;
        float acc[16]; ZERO16(acc);
        rb2(acc, (const bf16*)(F.ws + WS_MEMN) + (size_t)row0 * D, D, D, wkv + (size_t)l * D * 1024 + 64 * blk + lane, 1024);
        float* o = (float*)(F.ws + WS_KVF) + (size_t)row0 * 1024 + 64 * blk + lane;
#pragma unroll
        for (int r = 0; r < 16; ++r) o[(size_t)r * 1024] = acc[r];
    }
}
__device__ __forceinline__ void n_poolo(Frame& F, const float* pw, const float* ps) {
    const bf16* PD = (const bf16*)(F.ws + WS_AR + AR_PD); bf16* PO = (bf16*)(F.ws + WS_AR + AR_PO); const int lane = F.lane;
    WITEM_LOOP(T / 16, 8) { WITEM_RB(T / 16, row0, blk);
        const int g = blk >> 1, c0 = (blk & 1) * 64;
        float acc[16]; ZERO16(acc);
        rb2(acc, PD + (size_t)row0 * 512 + g * 128, 512, 128, pw + (size_t)g * 128 * 128 + c0 + lane, 128);
        const float sc = ps[g * 128 + c0 + lane]; bf16* o = PO + (size_t)row0 * 512 + g * 128 + c0 + lane;
#pragma unroll
        for (int r = 0; r < 16; ++r) o[(size_t)r * 512] = (bf16)f2bf(acc[r] * sc);
    }
}
__device__ __forceinline__ void n_fox(Frame& F) {
    bf16* Q = (bf16*)(F.ws + WS_AR + AR_Q); const bf16* K = (const bf16*)(F.ws + WS_AR + AR_K); const bf16* V = (const bf16*)(F.ws + WS_AR + AR_V);
    bf16* FO = (bf16*)(F.ws + WS_AR + AR_FO);
    const float* CL = (const float*)(F.ws + WS_CL);
    for (long it_ = (long)F.vcu * NTHREADS + F.tid; it_ < (long)BATCH * FH * SEQ * 2; it_ += (long)F.G * NTHREADS) {
        const int hf = (int)((it_ / SEQ) & 1), bh = (int)(it_ / (2 * SEQ)), qi = (int)(it_ % SEQ); const int b = bh / FH, h = bh % FH;
        float q[64], o[32];
        { const bf16* qp = Q + ((size_t)b * SEQ + qi) * 512 + h * 64;
#pragma unroll
          for (int c = 0; c < 64; c += 8) { const v4u x = *(const v4u*)(qp + c);
#pragma unroll
            for (int i = 0; i < 4; ++i) { q[c + 2 * i] = bf2f(x[i] & 0xffffu); q[c + 2 * i + 1] = bf2f(x[i] >> 16); } } }
#pragma unroll
        for (int c = 0; c < 32; ++c) o[c] = 0.f;
        float mx = -INFINITY, l = 0.f; const float clq = CL[(size_t)bh * SEQ + qi];
        const int jend = __builtin_amdgcn_readfirstlane(qi | 63);
        for (int j = 0; j <= jend; ++j) {
            const bf16* kp = K + ((size_t)b * SEQ + j) * 512 + h * 64; const bf16* vp = V + ((size_t)b * SEQ + j) * 512 + h * 64 + hf * 32;
            float s = 0.f;
#pragma unroll
            for (int c = 0; c < 64; c += 8) { const v4u x = *(const v4u*)(kp + c);
#pragma unroll
                for (int i = 0; i < 4; ++i) { s = fmaf(q[c + 2 * i], bf2f(x[i] & 0xffffu), s); s = fmaf(q[c + 2 * i + 1], bf2f(x[i] >> 16), s); } }
            asm volatile("" ::: "memory");
            s += clq - CL[(size_t)bh * SEQ + j];
            if (j <= qi) {
                const float mn = fmaxf(mx, s), sc = exp2f(mx - mn), p = exp2f(s - mn);
                l = l * sc + p; mx = mn;
#pragma unroll
                for (int c = 0; c < 32; c += 8) { const v4u x = *(const v4u*)(vp + c);
#pragma unroll
                    for (int i = 0; i < 4; ++i) { o[c + 2 * i] = o[c + 2 * i] * sc + p * bf2f(x[i] & 0xffffu); o[c + 2 * i + 1] = o[c + 2 * i + 1] * sc + p * bf2f(x[i] >> 16); } }
            }
        }
        const float il = 1.0f / l;
        bf16* op = FO + ((size_t)b * SEQ + qi) * 512 + h * 64 + hf * 32;
#pragma unroll
        for (int c = 0; c < 32; c += 8) *(v4u*)(op + c) = (v4u){pk2(o[c] * il, o[c + 1] * il), pk2(o[c + 2] * il, o[c + 3] * il), pk2(o[c + 4] * il, o[c + 5] * il), pk2(o[c + 6] * il, o[c + 7] * il)};
    }
}
__device__ __forceinline__ void n_memattn(Frame& F, int l, const float* mqg) {
    const float* MQ = (const float*)(F.ws + WS_AR + AR_MQ); bf16* MO = (bf16*)(F.ws + WS_AR + AR_MO);
    const bf16* KM = (const bf16*)(F.ws + WS_KM) + (size_t)l * MROWS * 512; const bf16* VM = (const bf16*)(F.ws + WS_VM) + (size_t)l * MROWS * 512;
    LAS float* qs = (LAS float*)(F.lds + RING_OFF) + F.wave * 512; LAS float* psh = qs + 128; const int lane = F.lane;
    for (long it_ = (long)F.vcu * NWAVES + F.wave; it_ < (long)T * MH; it_ += (long)F.G * NWAVES) {
        const int row = (int)(it_ >> 2), head = (int)(it_ & 3), b = row / SEQ;
        const float x0 = MQ[(size_t)row * 512 + head * 128 + 2 * lane], x1 = MQ[(size_t)row * 512 + head * 128 + 2 * lane + 1];
        const float ss = wave_sum(x0 * x0 + x1 * x1); const float rstd = 1.0f / sqrtf(ss * (1.0f / MD) + EPS) * C2M;
        qs[2 * lane] = x0 * rstd * mqg[2 * lane]; qs[2 * lane + 1] = x1 * rstd * mqg[2 * lane + 1];
        asm volatile("s_waitcnt lgkmcnt(0)" ::: "memory");
        float sc[4]; float mx = -INFINITY;
#pragma unroll
        for (int i = 0; i < 4; ++i) { const bf16* kp = KM + ((size_t)b * NMEM + lane + 64 * i) * 512 + head * 128; float s = 0.f;
#pragma unroll
            for (int c = 0; c < 128; c += 8) { const v4u x = *(const v4u*)(kp + c); const f32x4 qa = *(const LAS f32x4*)(qs + c), qb = *(const LAS f32x4*)(qs + c + 4);
                s = fmaf(qa[0], bf2f(x[0] & 0xffffu), s); s = fmaf(qa[1], bf2f(x[0] >> 16), s); s = fmaf(qa[2], bf2f(x[1] & 0xffffu), s); s = fmaf(qa[3], bf2f(x[1] >> 16), s);
                s = fmaf(qb[0], bf2f(x[2] & 0xffffu), s); s = fmaf(qb[1], bf2f(x[2] >> 16), s); s = fmaf(qb[2], bf2f(x[3] & 0xffffu), s); s = fmaf(qb[3], bf2f(x[3] >> 16), s); }
            sc[i] = s; mx = fmaxf(mx, s); }
#pragma unroll
        for (int o = 1; o < 64; o <<= 1) mx = fmaxf(mx, __shfl_xor(mx, o));
        float lsum = 0.f;
#pragma unroll
        for (int i = 0; i < 4; ++i) { const float p = exp2f(sc[i] - mx); lsum += p; psh[lane + 64 * i] = p; }
        lsum = wave_sum(lsum);
        asm volatile("s_waitcnt lgkmcnt(0)" ::: "memory");
        float o0 = 0.f, o1 = 0.f;
        for (int j = 0; j < NMEM; ++j) { const unsigned vv = *(const unsigned*)(VM + ((size_t)b * NMEM + j) * 512 + head * 128 + 2 * lane); const float p = psh[j];
            o0 = fmaf(p, bf2f(vv & 0xffffu), o0); o1 = fmaf(p, bf2f(vv >> 16), o1); }
        const float il = 1.0f / lsum;
        *(unsigned*)(MO + (size_t)row * 512 + head * 128 + 2 * lane) = pk2(o0 * il, o1 * il);
        asm volatile("s_waitcnt lgkmcnt(0)" ::: "memory");
    }
}
__device__ __forceinline__ void n_merge(Frame& F, const float* wp, const float* wf, const float* wm) {
    unsigned char* ar = F.ws + WS_AR; const bf16* G = (const bf16*)(ar + AR_G); bf16* MG = (bf16*)(F.ws + WS_H); const int lane = F.lane;
    WITEM_LOOP(T / 16, 16) { WITEM_RB(T / 16, row0, blk);
        float m[16]; ZERO16(m);
#pragma unroll 1
        for (int b = 0; b < 3; ++b) {
            const bf16* A = (const bf16*)(ar + (b == 0 ? AR_PO : (b == 1 ? AR_FO : AR_MO))); const float* W = b == 0 ? wp : (b == 1 ? wf : wm);
            float acc[16]; ZERO16(acc);
            rb2(acc, A + (size_t)row0 * 512, 512, 512, W + 64 * blk + lane, D);
            const bf16* gp = G + (size_t)row0 * 3072 + b * 1024 + 64 * blk + lane;
#pragma unroll
            for (int r = 0; r < 16; ++r) m[r] = fmaf(bf2f(gp[(size_t)r * 3072]), acc[r], m[r]);
        }
        bf16* o = MG + (size_t)row0 * D + 64 * blk + lane;
#pragma unroll
        for (int r = 0; r < 16; ++r) o[(size_t)r * D] = (bf16)f2bf(m[r]);
    }
}
__device__ __forceinline__ void n_resgemm(Frame& F, const float* base, const bf16* A, int K, const float* W) {
    const int lane = F.lane;
    WITEM_LOOP(T / 16, 16) { WITEM_RB(T / 16, row0, blk);
        float acc[16]; ZERO16(acc);
        rb2(acc, A + (size_t)row0 * K, K, K, W + 64 * blk + lane, D);
        const float* bp = base + (size_t)row0 * D + 64 * blk + lane; float* op = F.X + (size_t)row0 * D + 64 * blk + lane;
#pragma unroll
        for (int r = 0; r < 16; ++r) op[(size_t)r * D] = bp[(size_t)r * D] + acc[r];
    }
}
__device__ __forceinline__ void n_ffn_up(Frame& F, const float* wgu, int FF, int e) {
    const bf16* H = (const bf16*)(F.ws + WS_H); bf16* ACT = (bf16*)(F.ws + WS_AR + AR_ACT); const int lane = F.lane;
    WITEM_LOOP(T / 16, FF / 64) { WITEM_RB(T / 16, row0, blk);
        float g[16], u[16]; ZERO16(g); ZERO16(u);
        rb2(g, H + (size_t)row0 * D, D, D, wgu + 64 * blk + lane, 2 * FF);
        rb2(u, H + (size_t)row0 * D, D, D, wgu + FF + 64 * blk + lane, 2 * FF);
        bf16* o = ACT + (size_t)row0 * FF + 64 * blk + lane;
#pragma unroll
        for (int r = 0; r < 16; ++r) o[(size_t)r * FF] = (bf16)f2bf(g[r] * sigmoid_f(g[r]) * u[r]);
    }
}
__device__ __forceinline__ void n_ffn_down(Frame& F, const float* wd, int FF, int e) {
    const bf16* ACT = (const bf16*)(F.ws + WS_AR + AR_ACT); const int lane = F.lane;
    WITEM_LOOP(T / 16, 16) { WITEM_RB(T / 16, row0, blk);
        float acc[16]; ZERO16(acc);
        rb2(acc, ACT + (size_t)row0 * FF, FF, FF, wd + 64 * blk + lane, D);
        float* op = F.X + (size_t)row0 * D + 64 * blk + lane;
#pragma unroll
        for (int r = 0; r < 16; ++r) { float comb = 1.0f;
            if (e >= 0) { const Choice c = ((const Choice*)(F.ws + WS_CHOICE))[row0 + r]; comb = (c.e1 == e) ? c.w1 : ((c.e2 == e) ? c.w2 : 0.f); }
            if (comb != 0.f) op[(size_t)r * D] += comb * acc[r]; }
    }
}

__global__ void __launch_bounds__(NTHREADS, 2) mk_fwd(Args args) {
    extern __shared__ __attribute__((aligned(16))) unsigned char lds[];
    Frame F;
    F.lds = (LAS unsigned char*)lds; F.MISC = (volatile LAS unsigned*)(F.lds + MISC_OFF);
    F.tid = threadIdx.x; F.lane = F.tid & 63; F.wave = __builtin_amdgcn_readfirstlane(F.tid >> 6);
    F.G = gridDim.x; { const int bx = blockIdx.x; F.vcu = (F.G % 8 == 0) ? (bx % 8) * (F.G / 8) + bx / 8 : bx; }
    F.ws = args.ws; F.ctl = (gu32*)(args.ws + WS_CTL); F.X = args.out;
    for (int u = F.tid; u < (LDS_BYTES - LDSCTL_OFF) / 4; u += NTHREADS) ((LAS unsigned*)(F.lds + LDSCTL_OFF))[u] = 0u;
    __syncthreads();
    XcdBarrier bar = xcd_barrier_post((unsigned*)(F.ctl + CW_BAR), F.MISC + 8);
#define REFRESH() do { int t_ = threadIdx.x; asm volatile("" : "+v"(t_)); F.tid = t_; F.lane = t_ & 63; int w_ = __builtin_amdgcn_readfirstlane(t_ >> 6); asm volatile("" : "+s"(w_)); F.wave = w_; \
    int v_ = F.vcu; asm volatile("" : "+s"(v_)); F.vcu = v_; } while (0)
#define SEAM() do { xcd_barrier(bar); REFRESH(); } while (0)
    { volatile LAS unsigned long long* PT = (volatile LAS unsigned long long*)(F.lds + PTR_OFF);
      if (F.tid == 0) {
#define PUT_(i) PT[i] = (unsigned long long)(uintptr_t)args.in[i];
        PUT_(0) PUT_(1) PUT_(2) PUT_(3) PUT_(4) PUT_(5) PUT_(6) PUT_(7) PUT_(8) PUT_(9) PUT_(10) PUT_(11) PUT_(12) PUT_(13) PUT_(14) PUT_(15) PUT_(16) PUT_(17) PUT_(18) PUT_(19) PUT_(20) PUT_(21) PUT_(22) PUT_(23)
#undef PUT_
      }
      __syncthreads(); }
#define INP(i) inptr(F, (i))

    memnorm_phase(F, INP(I_MEM), INP(I_MEMG)); SEAM();
    n_memkv(F, INP(I_WKV)); SEAM();
    kvfin_phase(F, INP(I_MKG)); SEAM();

#pragma unroll 1
    for (int l = 0; l < DEPTH; ++l) {
        const float* xin = (l == 0) ? INP(I_X) : (const float*)F.X;
        norm_phase<1>(F, xin, INP(I_MIXG) + l * D, INP(I_WIN) + (size_t)l * D * NIN + OFF_F, NIN, INP(I_BF) + l * FH, (bf16*)(F.ws + WS_H)); SEAM();
        cumsum_phase(F); REFRESH();
        n_inproj(F, INP(I_WIN) + (size_t)l * D * NIN, INP(I_FQG) + l * FD, INP(I_FKG) + l * FD); SEAM();
        pool_phase(F); REFRESH();
        n_memattn(F, l, INP(I_MQG) + l * MD); REFRESH();
        n_fox(F); SEAM();
        n_poolo(F, INP(I_POOLW) + (size_t)l * 4 * 128 * 128, INP(I_POOLS) + l * 512); SEAM();
        n_merge(F, INP(I_WPBR) + (size_t)l * 512 * D, INP(I_WFBR) + (size_t)l * 512 * D, INP(I_WMBR) + (size_t)l * 512 * D); SEAM();
        n_resgemm(F, xin, (const bf16*)(F.ws + WS_H), D, INP(I_WOUT) + (size_t)l * D * D); SEAM();
        if (l == 0) {
            norm_phase<0>(F, F.X, INP(I_FFNG) + l * D, nullptr, 0, nullptr, (bf16*)(F.ws + WS_H)); SEAM();
            n_ffn_up(F, INP(I_WGU), DFF, -1); SEAM();
            n_ffn_down(F, INP(I_WDN), DFF, -1); SEAM();
        } else {
            norm_phase<2>(F, F.X, INP(I_FFNG) + l * D, INP(I_WR), NE, INP(I_BR), (bf16*)(F.ws + WS_H)); SEAM();
#pragma unroll 1
            for (int e = 0; e < NE; ++e) {
                n_ffn_up(F, INP(I_WEGU) + (size_t)e * D * 2 * DEXP, DEXP, e); SEAM();
                n_ffn_down(F, INP(I_WEDN) + (size_t)e * DEXP * D, DEXP, e); SEAM();
            }
        }
    }
}

extern "C" void kernel_launch(void* const* d_in, const int* in_sizes, int n_in, void* d_out, int out_size, void* d_ws, size_t ws_size, hipStream_t stream) {
    static int grid = 0;
    if (grid == 0) {
        if (n_in != N_IN_ || in_sizes[0] != T * D || out_size != T * D || ws_size < WS_END) {
            fprintf(stderr, "kernel_launch: unexpected shapes: n_in %d in0 %d out %d ws %zu (need %zu)\n", n_in, n_in > 0 ? in_sizes[0] : -1, out_size, ws_size, (size_t)WS_END); grid = -1; return; }
        int dev = 0, cus = 0, per_cu = 0;
        if (hipGetDevice(&dev) != hipSuccess || hipDeviceGetAttribute(&cus, hipDeviceAttributeMultiprocessorCount, dev) != hipSuccess) { grid = -1; return; }
        if (hipFuncSetAttribute((const void*)mk_fwd, hipFuncAttributeMaxDynamicSharedMemorySize, LDS_BYTES) != hipSuccess) { fprintf(stderr, "kernel_launch: hipFuncSetAttribute failed\n"); grid = -1; return; }
        if (hipOccupancyMaxActiveBlocksPerMultiprocessor(&per_cu, (const void*)mk_fwd, NTHREADS, LDS_BYTES) != hipSuccess || per_cu < 1) { fprintf(stderr, "kernel_launch: occupancy query says %d\n", per_cu); }
        (void)hipGetLastError();
        grid = cus;
    }
    if (grid < 0) return;
    if (hipMemsetAsync((char*)d_ws + WS_CTL, 0, CTL_ZERO_BYTES, stream) != hipSuccess) return;
    Args a{};
    for (int i = 0; i < N_IN_; ++i) a.in[i] = (const float*)d_in[i];
    a.out = (float*)d_out; a.ws = (unsigned char*)d_ws; a.ph_lo = 0; a.ph_hi = 0;
    hipLaunchKernelGGL(mk_fwd, dim3(grid), dim3(NTHREADS), LDS_BYTES, stream, a);
}
```

```cpp
#include <hip/hip_runtime.h>
#include <cstdio>
#include <cstdint>

constexpr int D = 1024, BATCH = 8, SEQ = 4096, T = BATCH * SEQ, DEPTH = 2;
constexpr int NMEM = 256, MROWS = BATCH * NMEM;
constexpr int FH = 8, FD = 64, MH = 4, MD = 128;
constexpr int DFF = 2816, NE = 8, DEXP = 3584;
constexpr int OFF_POOL = 0, OFF_Q = 512, OFF_K = 1024, OFF_V = 1536, OFF_F = 2048, OFF_MQ = 2056, OFF_G = 2568, NIN = 5640;
constexpr float EPS = 1e-6f;
constexpr float LOG2E = 1.4426950408889634f;
constexpr float C2F = 0.125f * LOG2E;
constexpr float C2M = 0.08838834764831845f * LOG2E;
constexpr int NWAVES = 8, NTHREADS = 512;

enum { I_X = 0, I_MEM, I_MIXG, I_WIN, I_BF, I_FQG, I_FKG, I_POOLW, I_POOLS, I_MEMG, I_WKV, I_MQG, I_MKG, I_WPBR, I_WFBR, I_WMBR, I_WOUT, I_FFNG, I_WGU, I_WDN, I_WR, I_BR, I_WEGU, I_WEDN, N_IN_ };

constexpr size_t MiB = 1u << 20;
constexpr size_t WS_CTL = 0, CTL_ZERO_BYTES = 1 * MiB;
constexpr size_t WS_LOGF = 1 * MiB, WS_CL = 2 * MiB, WS_CHOICE = 3 * MiB, WS_WCNT = 3 * MiB + 512 * 1024;
constexpr size_t WS_W = 8 * MiB;
constexpr size_t WS_MEMN = 232 * MiB, WS_KVF = 240 * MiB, WS_KM = 256 * MiB, WS_VM = 260 * MiB;
constexpr size_t WS_H = 264 * MiB;
constexpr size_t WS_AR = 328 * MiB;
constexpr size_t AR_U = 0, AR_Q = 32 * MiB, AR_K = 64 * MiB, AR_V = 96 * MiB, AR_MQ = 128 * MiB, AR_G = 192 * MiB, AR_PD = 384 * MiB, AR_MO = 416 * MiB, AR_PO = 448 * MiB, AR_FO = 480 * MiB;
constexpr size_t AR_ACT = 0;
constexpr size_t WS_END = 896 * MiB;

constexpr int CW_TMO = 0, CW_CODE = 1, CW_BAR = 4096;

#define GAS __attribute__((address_space(1)))
#define LAS __attribute__((address_space(3)))
typedef unsigned short bf16;
typedef unsigned v4u __attribute__((ext_vector_type(4)));
typedef unsigned v2u __attribute__((ext_vector_type(2)));
typedef float f32x4 __attribute__((ext_vector_type(4)));
typedef GAS unsigned gu32;
#define RLX_AGENT __ATOMIC_RELAXED, __HIP_MEMORY_SCOPE_AGENT
__device__ __forceinline__ float bf2f(unsigned v) { return __uint_as_float(v << 16); }
__device__ __forceinline__ unsigned f2bf(float f) { unsigned u = __float_as_uint(f); return (u + 0x7fffu + ((u >> 16) & 1u)) >> 16; }
__device__ __forceinline__ unsigned pk2(float lo, float hi) { return f2bf(lo) | (f2bf(hi) << 16); }
__device__ __forceinline__ float wave_sum(float v) {
#pragma unroll
    for (int o = 1; o < 64; o <<= 1) v += __shfl_xor(v, o);
    return v;
}
__device__ __forceinline__ float log_sigmoid_f(float x) { return fminf(x, 0.f) - log1pf(expf(-fabsf(x))); }
__device__ __forceinline__ float sigmoid_f(float x) { return 1.0f / (1.0f + expf(-x)); }

#define XB_TMO      128
#define XB_XCNT(j)  (256  + 64 * (j))
#define XB_XSUB(j)  (1280 + 64 * (j))
#define XB_XGEN(j)  (2304 + 64 * (j))
#define XB_TOP      3328
#define XB_TOPGEN   3392
#define XCD_BAR_WORDS 3456
#define XB_SPIN_CAP (1u << 22)

__device__ __forceinline__ unsigned xb_ld(unsigned* p)              { return __hip_atomic_load(p, __ATOMIC_RELAXED, __HIP_MEMORY_SCOPE_AGENT); }
__device__ __forceinline__ unsigned xb_add(unsigned* p, unsigned v) { return __hip_atomic_fetch_add(p, v, __ATOMIC_RELAXED, __HIP_MEMORY_SCOPE_AGENT); }
__device__ __forceinline__ unsigned xb_xcc_id() { return (unsigned)__builtin_amdgcn_s_getreg((3 << 11) | 20) & 0xFu; }
#define XB_SPIN(cond, bar) do { unsigned _sp = 0; while (cond) { __builtin_amdgcn_s_sleep(1); \
    if ((++_sp & 255u) == 0u) { if (xb_ld(&(bar)[XB_TMO])) break; if (_sp > XB_SPIN_CAP) { atomicAdd(&(bar)[XB_TMO], 1u); break; } } } } while (0)

struct XcdBarrier { unsigned* bar; unsigned x; volatile LAS unsigned* st; };

__device__ __forceinline__ XcdBarrier xcd_barrier_post(unsigned* bar, volatile LAS unsigned* st) {
    XcdBarrier b; b.bar = bar; b.x = xb_xcc_id(); b.st = st;
    if (threadIdx.x == 0) (void)xb_add(&bar[XB_XCNT(b.x)], 1u);
    return b;
}
__device__ __forceinline__ void xcd_barrier_complete(unsigned* bar, unsigned x, unsigned& nloc, unsigned& nx) {
    const unsigned G = gridDim.x * gridDim.y * gridDim.z;
    unsigned sum, cnt, mine, sp = 0u;
    for (;;) {
        sum = 0u; cnt = 0u; mine = 0u;
#pragma unroll
        for (unsigned j = 0; j < 16; ++j) { const unsigned c = xb_ld(&bar[XB_XCNT(j)]); sum += c; cnt += (c > 0u) ? 1u : 0u; mine = (j == x) ? c : mine; }
        if (sum == G) break;
        __builtin_amdgcn_s_sleep(1);
        if ((++sp & 255u) == 0u) { if (xb_ld(&bar[XB_TMO])) break; if (sp > XB_SPIN_CAP) { atomicAdd(&bar[XB_TMO], 1u); break; } }
    }
    nloc = mine > 0u ? mine : 1u; nx = cnt > 0u ? cnt : 1u;
}
__device__ __forceinline__ void xcd_barrier(const XcdBarrier& b) {
    asm volatile("s_waitcnt vmcnt(0)" ::: "memory");
    __syncthreads();
    if (threadIdx.x == 0) {
        unsigned* bar = b.bar;
        __builtin_amdgcn_s_waitcnt(0);
        unsigned nloc = b.st[0], nx = b.st[1];
        if (nloc == 0u) { xcd_barrier_complete(bar, b.x, nloc, nx); b.st[0] = nloc; b.st[1] = nx; }
        const unsigned old = xb_add(&bar[XB_XSUB(b.x)], 1u);
        const unsigned gen = old / nloc;
        if (old + 1u == (gen + 1u) * nloc) {
            __builtin_amdgcn_fence(__ATOMIC_RELEASE, "agent");
            asm volatile("s_waitcnt vmcnt(0)" ::: "memory");
            const unsigned og = xb_add(&bar[XB_TOP], 1u);
            const unsigned tg = og / nx;
            if (og + 1u == (tg + 1u) * nx) xb_add(&bar[XB_TOPGEN], 1u);
            else XB_SPIN(xb_ld(&bar[XB_TOPGEN]) == tg, bar);
            __builtin_amdgcn_fence(__ATOMIC_ACQUIRE, "agent");
            xb_add(&bar[XB_XGEN(b.x)], 1u);
            asm volatile("s_waitcnt vmcnt(0)" ::: "memory");
        } else {
            XB_SPIN(xb_ld(&bar[XB_XGEN(b.x)]) == gen, bar);
            __builtin_amdgcn_fence(__ATOMIC_ACQUIRE, "agent");
            asm volatile("s_waitcnt vmcnt(0)" ::: "memory");
        }
    }
    __syncthreads();
}

constexpr int RING_OFF = 0, RING_BYTES = 131072;
constexpr int LDSCTL_OFF = RING_BYTES, MISC_OFF = LDSCTL_OFF + 320;
constexpr int LDS_BYTES = 147456;

struct Args { const float* in[N_IN_]; float* out; unsigned char* ws; int ph_lo, ph_hi; };
struct Frame {
    LAS unsigned char* lds; volatile LAS unsigned* MISC; gu32* ctl;
    int tid, lane, wave, vcu, G;
    float* X; unsigned char* ws;
};
struct Choice { int e1, e2; float w1, w2; };
constexpr int PTR_OFF = LDSCTL_OFF + 1024;
__device__ __forceinline__ const float* inptr(const Frame& F, int i) {
    int z = 0; asm volatile("" : "+v"(z));
    const volatile LAS unsigned* p = (const volatile LAS unsigned*)(F.lds + PTR_OFF + z) + 2 * i;
    const unsigned lo = __builtin_amdgcn_readfirstlane(p[0]), hi = __builtin_amdgcn_readfirstlane(p[1]);
    return (const float*)(uintptr_t)(((unsigned long long)hi << 32) | lo);
}

template <int MODE>
__device__ __forceinline__ void norm_phase(Frame& F, const float* xin, const float* g, const float* W8, int ldw8, const float* b8, bf16* Hout) {
    const int lane = F.lane, gw = F.vcu * NWAVES + F.wave, NGW = F.G * NWAVES;
    f32x4 gv[4];
#pragma unroll
    for (int j = 0; j < 4; ++j) gv[j] = *(const f32x4*)(g + 256 * j + 4 * lane);
    LAS f32x4* tab = (LAS f32x4*)(F.lds + RING_OFF);
    if (MODE != 0) {
        for (int q = F.tid; q < 2048; q += NTHREADS) { const int ln = q & 63, hf = (q >> 6) & 1, ji = q >> 7; const int k = 256 * (ji >> 2) + 4 * ln + (ji & 3);
            tab[q] = *(const f32x4*)(W8 + (size_t)k * ldw8 + 4 * hf); }
        __syncthreads();
    }
    int cnt[8];
#pragma unroll
    for (int e = 0; e < 8; ++e) cnt[e] = 0;
    for (int m = gw; m < T; m += NGW) {
        const f32x4* xr = (const f32x4*)(xin + (size_t)m * D) + lane;
        f32x4 v[4]; float ss = 0.f;
#pragma unroll
        for (int j = 0; j < 4; ++j) { v[j] = xr[64 * j]; ss += (v[j][0] * v[j][0] + v[j][1] * v[j][1]) + (v[j][2] * v[j][2] + v[j][3] * v[j][3]); }
        ss = wave_sum(ss);
        const float rstd = 1.0f / sqrtf(ss * (1.0f / D) + EPS);
        unsigned long long* o8 = (unsigned long long*)(Hout + (size_t)m * D) + lane;
#pragma unroll
        for (int j = 0; j < 4; ++j) { v[j] = v[j] * rstd * gv[j]; o8[64 * j] = (unsigned long long)pk2(v[j][0], v[j][1]) | ((unsigned long long)pk2(v[j][2], v[j][3]) << 32); }
        if (MODE != 0) {
            float p[8];
#pragma unroll
            for (int e = 0; e < 8; ++e) p[e] = 0.f;
#pragma unroll
            for (int j = 0; j < 4; ++j)
#pragma unroll
                for (int i = 0; i < 4; ++i) { const f32x4 wa = tab[((j * 4 + i) * 2 + 0) * 64 + lane], wb = tab[((j * 4 + i) * 2 + 1) * 64 + lane]; const float hv = v[j][i];
                    p[0] = fmaf(hv, wa[0], p[0]); p[1] = fmaf(hv, wa[1], p[1]); p[2] = fmaf(hv, wa[2], p[2]); p[3] = fmaf(hv, wa[3], p[3]);
                    p[4] = fmaf(hv, wb[0], p[4]); p[5] = fmaf(hv, wb[1], p[5]); p[6] = fmaf(hv, wb[2], p[6]); p[7] = fmaf(hv, wb[3], p[7]);
                    if (i == 3) asm volatile("" ::: "memory"); }
            float k4[4];
            { const bool hi = (lane & 32) != 0;
#pragma unroll
              for (int i = 0; i < 4; ++i) { const float keep = hi ? p[4 + i] : p[i], send = hi ? p[i] : p[4 + i]; k4[i] = keep + __shfl_xor(send, 32); } }
            float k2[2];
            { const bool hi = (lane & 16) != 0;
#pragma unroll
              for (int i = 0; i < 2; ++i) { const float keep = hi ? k4[2 + i] : k4[i], send = hi ? k4[i] : k4[2 + i]; k2[i] = keep + __shfl_xor(send, 16); } }
            float k1;
            { const bool hi = (lane & 8) != 0; const float keep = hi ? k2[1] : k2[0], send = hi ? k2[0] : k2[1]; k1 = keep + __shfl_xor(send, 8); }
            k1 += __shfl_xor(k1, 4); k1 += __shfl_xor(k1, 2); k1 += __shfl_xor(k1, 1);
            const int e_mine = ((lane >> 5) & 1) * 4 + ((lane >> 4) & 1) * 2 + ((lane >> 3) & 1);
            const float val = k1 + b8[e_mine];
            if (MODE == 1) {
                if ((lane & 7) == 0) { const int b = m / SEQ, s = m % SEQ; ((float*)(F.ws + WS_LOGF))[(size_t)(b * FH + e_mine) * SEQ + s] = log_sigmoid_f(val); }
            } else {
                float lg[8];
#pragma unroll
                for (int e = 0; e < 8; ++e) lg[e] = __shfl(val, ((e >> 2) & 1) * 32 + ((e >> 1) & 1) * 16 + (e & 1) * 8);
                float b1 = -INFINITY, b2 = -INFINITY; int i1 = 0, i2 = 0;
#pragma unroll
                for (int e = 0; e < 8; ++e) { if (lg[e] > b1) { b2 = b1; i2 = i1; b1 = lg[e]; i1 = e; } else if (lg[e] > b2) { b2 = lg[e]; i2 = e; } }
                const float ex = expf(b2 - b1), w1 = 1.0f / (1.0f + ex), w2 = ex / (1.0f + ex);
                if (lane == 0) { Choice c; c.e1 = i1; c.e2 = i2; c.w1 = w1; c.w2 = w2; ((Choice*)(F.ws + WS_CHOICE))[m] = c; }
#pragma unroll
                for (int e = 0; e < 8; ++e) cnt[e] += (i1 == e) + (i2 == e);
            }
        }
    }
    if (MODE != 0) __syncthreads();
    if (MODE == 2) {
        int mine = 0;
#pragma unroll
        for (int e = 0; e < 8; ++e) mine = (lane == e) ? cnt[e] : mine;
        if (lane < 8) ((int*)(F.ws + WS_WCNT))[gw * 8 + lane] = mine;
    }
}

__device__ __forceinline__ void cumsum_phase(Frame& F) {
    if (F.vcu >= BATCH * FH || F.wave != 0) return;
    const float* lf = (const float*)(F.ws + WS_LOGF) + (size_t)F.vcu * SEQ + 64 * F.lane;
    float* cl = (float*)(F.ws + WS_CL) + (size_t)F.vcu * SEQ + 64 * F.lane;
    double tot = 0.0;
    for (int i = 0; i < 64; ++i) tot += (double)lf[i];
    double inc = tot;
#pragma unroll
    for (int o = 1; o < 64; o <<= 1) { const double t = __shfl_up(inc, o); if (F.lane >= o) inc += t; }
    double run = inc - tot;
    for (int i = 0; i < 64; ++i) { run += (double)lf[i]; cl[i] = (float)(run * 1.4426950408889634); }
}

__device__ __forceinline__ void pool_phase(Frame& F) {
    const bf16* U = (const bf16*)(F.ws + WS_AR + AR_U); bf16* PD = (bf16*)(F.ws + WS_AR + AR_PD);
    const int lane = F.lane, gw = F.vcu * NWAVES + F.wave, NGW = F.G * NWAVES;
    const int w = 2 << (lane >> 4);
    for (int m = gw; m < T; m += NGW) {
        const int t = m % SEQ; const int n = (t + 1 < w) ? (t + 1) : w;
        float s[8];
#pragma unroll
        for (int i = 0; i < 8; ++i) s[i] = 0.f;
        v4u cur = (v4u){0u, 0u, 0u, 0u};
        for (int j = 0; j < n; ++j) { const v4u x = *(const v4u*)(U + (size_t)(m - j) * 512 + 8 * lane); if (j == 0) cur = x;
#pragma unroll
            for (int i = 0; i < 4; ++i) { s[2 * i] += bf2f(x[i] & 0xffffu); s[2 * i + 1] += bf2f(x[i] >> 16); } }
        const float inv = 1.0f / (float)n; v4u o;
#pragma unroll
        for (int i = 0; i < 4; ++i) o[i] = pk2(s[2 * i] * inv - bf2f(cur[i] & 0xffffu), s[2 * i + 1] * inv - bf2f(cur[i] >> 16));
        *(v4u*)(PD + (size_t)m * 512 + 8 * lane) = o;
    }
}

__device__ __forceinline__ void memnorm_phase(Frame& F, const float* mem, const float* memg) {
    const int lane = F.lane, gw = F.vcu * NWAVES + F.wave, NGW = F.G * NWAVES;
    for (int it = gw; it < DEPTH * MROWS; it += NGW) {
        const int l = it / MROWS, r = it % MROWS;
        const f32x4* xr = (const f32x4*)(mem + (size_t)r * D) + lane; const float* g = memg + l * D;
        f32x4 v[4]; float ss = 0.f;
#pragma unroll
        for (int j = 0; j < 4; ++j) { v[j] = xr[64 * j]; ss += (v[j][0] * v[j][0] + v[j][1] * v[j][1]) + (v[j][2] * v[j][2] + v[j][3] * v[j][3]); }
        ss = wave_sum(ss); const float rstd = 1.0f / sqrtf(ss * (1.0f / D) + EPS);
        unsigned long long* o8 = (unsigned long long*)((bf16*)(F.ws + WS_MEMN) + (size_t)it * D) + lane;
#pragma unroll
        for (int j = 0; j < 4; ++j) { const f32x4 h = v[j] * rstd * *(const f32x4*)(g + 256 * j + 4 * lane); o8[64 * j] = (unsigned long long)pk2(h[0], h[1]) | ((unsigned long long)pk2(h[2], h[3]) << 32); }
    }
}
__device__ __forceinline__ void kvfin_phase(Frame& F, const float* mkg) {
    const int lane = F.lane, gw = F.vcu * NWAVES + F.wave, NGW = F.G * NWAVES;
    for (int it = gw; it < DEPTH * MROWS; it += NGW) {
        const int l = it / MROWS;
        const f32x4* xr = (const f32x4*)((const float*)(F.ws + WS_KVF) + (size_t)it * 1024) + lane;
        f32x4 v[4];
#pragma unroll
        for (int j = 0; j < 4; ++j) v[j] = xr[64 * j];
        unsigned long long* ok = (unsigned long long*)((bf16*)(F.ws + WS_KM) + (size_t)it * 512) + lane;
        unsigned long long* ov = (unsigned long long*)((bf16*)(F.ws + WS_VM) + (size_t)it * 512) + lane;
#pragma unroll
        for (int j = 0; j < 2; ++j) {
            float ss = (v[j][0] * v[j][0] + v[j][1] * v[j][1]) + (v[j][2] * v[j][2] + v[j][3] * v[j][3]);
#pragma unroll
            for (int o = 1; o < 32; o <<= 1) ss += __shfl_xor(ss, o);
            const float rstd = 1.0f / sqrtf(ss * (1.0f / MD) + EPS);
            const f32x4 gg = *(const f32x4*)(mkg + l * MD + 4 * (lane & 31));
            const f32x4 h = v[j] * rstd * gg; ok[64 * j] = (unsigned long long)pk2(h[0], h[1]) | ((unsigned long long)pk2(h[2], h[3]) << 32);
        }
#pragma unroll
        for (int j = 0; j < 2; ++j) { const f32x4 h = v[2 + j]; ov[64 * j] = (unsigned long long)pk2(h[0], h[1]) | ((unsigned long long)pk2(h[2], h[3]) << 32); }
    }
}

__device__ __forceinline__ void rb2(float (&acc)[16], const bf16* A, int lda, int K, const float* W, int ldw) {
    for (int k = 0; k < K; k += 8) {
        float w[8];
#pragma unroll
        for (int kk = 0; kk < 8; ++kk) w[kk] = W[(size_t)(k + kk) * ldw];
#pragma unroll
        for (int r = 0; r < 16; ++r) { const v4u a = *(const v4u*)(A + (size_t)r * lda + k);
#pragma unroll
            for (int i = 0; i < 4; ++i) { acc[r] = fmaf(bf2f(a[i] & 0xffffu), w[2 * i], acc[r]); acc[r] = fmaf(bf2f(a[i] >> 16), w[2 * i + 1], acc[r]); } }
    }
}
#define WITEM_LOOP(NRG, NBLK) for (long it_ = (long)F.vcu * NWAVES + F.wave; it_ < (long)(NRG) * (NBLK); it_ += (long)F.G * NWAVES)
#define WITEM_RB(NRG, row0, blk) const int row0 = 16 * (int)(it_ % (NRG)); const int blk = (int)(it_ / (NRG))
#define ZERO16(a) _Pragma("unroll") for (int r_ = 0; r_ < 16; ++r_) a[r_] = 0.f

__device__ __forceinline__ void n_inproj(Frame& F, const float* win, const float* fqg, const float* fkg) {
    const bf16* H = (const bf16*)(F.ws + WS_H); unsigned char* ar = F.ws + WS_AR; const int lane = F.lane;
    WITEM_LOOP(T / 16, 88) { WITEM_RB(T / 16, row0, blk);
        float acc[16]; ZERO16(acc);
        const int col0 = blk < 32 ? 64 * blk : (blk < 40 ? OFF_MQ + 64 * (blk - 32) : OFF_G + 64 * (blk - 40));
        rb2(acc, H + (size_t)row0 * D, D, D, win + col0 + lane, NIN);
        if (blk < 8) { bf16* o = (bf16*)(ar + AR_U) + (size_t)row0 * 512 + 64 * blk + lane;
#pragma unroll
            for (int r = 0; r < 16; ++r) o[(size_t)r * 512] = (bf16)f2bf(acc[r]); }
        else if (blk < 24) { const bool isq = blk < 16; const int h = isq ? blk - 8 : blk - 16; const float gg = (isq ? fqg : fkg)[lane] * (isq ? C2F : 1.0f);
            bf16* o = (bf16*)(ar + (isq ? AR_Q : AR_K)) + (size_t)row0 * 512 + 64 * h + lane;
#pragma unroll
            for (int r = 0; r < 16; ++r) { const float ss = wave_sum(acc[r] * acc[r]); const float rstd = 1.0f / sqrtf(ss * (1.0f / FD) + EPS); o[(size_t)r * 512] = (bf16)f2bf(acc[r] * rstd * gg); } }
        else if (blk < 32) { bf16* o = (bf16*)(ar + AR_V) + (size_t)row0 * 512 + 64 * (blk - 24) + lane;
#pragma unroll
            for (int r = 0; r < 16; ++r) o[(size_t)r * 512] = (bf16)f2bf(acc[r]); }
        else if (blk < 40) { float* o = (float*)(ar + AR_MQ) + (size_t)row0 * 512 + 64 * (blk - 32) + lane;
#pragma unroll
            for (int r = 0; r < 16; ++r) o[(size_t)r * 512] = acc[r]; }
        else { bf16* o = (bf16*)(ar + AR_G) + (size_t)row0 * 3072 + 64 * (blk - 40) + lane;
#pragma unroll
            for (int r = 0; r < 16; ++r) o[(size_t)r * 3072] = (bf16)f2bf(sigmoid_f(acc[r])); }
    }
}
__device__ __forceinline__ void n_memkv(Frame& F, const float* wkv) {
    const int lane = F.lane;
    WITEM_LOOP(DEPTH * MROWS / 16, 16) { WITEM_RB(DEPTH * MROWS / 16, row0, blk);
        const int l = row0 / MROWS;
        float acc[16]; ZERO16(acc);
        rb2(acc, (const bf16*)(F.ws + WS_MEMN) + (size_t)row0 * D, D, D, wkv + (size_t)l * D * 1024 + 64 * blk + lane, 1024);
        float* o = (float*)(F.ws + WS_KVF) + (size_t)row0 * 1024 + 64 * blk + lane;
#pragma unroll
        for (int r = 0; r < 16; ++r) o[(size_t)r * 1024] = acc[r];
    }
}
__device__ __forceinline__ void n_poolo(Frame& F, const float* pw, const float* ps) {
    const bf16* PD = (const bf16*)(F.ws + WS_AR + AR_PD); bf16* PO = (bf16*)(F.ws + WS_AR + AR_PO); const int lane = F.lane;
    WITEM_LOOP(T / 16, 8) { WITEM_RB(T / 16, row0, blk);
        const int g = blk >> 1, c0 = (blk & 1) * 64;
        float acc[16]; ZERO16(acc);
        rb2(acc, PD + (size_t)row0 * 512 + g * 128, 512, 128, pw + (size_t)g * 128 * 128 + c0 + lane, 128);
        const float sc = ps[g * 128 + c0 + lane]; bf16* o = PO + (size_t)row0 * 512 + g * 128 + c0 + lane;
#pragma unroll
        for (int r = 0; r < 16; ++r) o[(size_t)r * 512] = (bf16)f2bf(acc[r] * sc);
    }
}
__device__ __forceinline__ void n_fox(Frame& F) {
    bf16* Q = (bf16*)(F.ws + WS_AR + AR_Q); const bf16* K = (const bf16*)(F.ws + WS_AR + AR_K); const bf16* V = (const bf16*)(F.ws + WS_AR + AR_V);
    bf16* FO = (bf16*)(F.ws + WS_AR + AR_FO);
    const float* CL = (const float*)(F.ws + WS_CL);
    for (long it_ = (long)F.vcu * NTHREADS + F.tid; it_ < (long)BATCH * FH * SEQ * 2; it_ += (long)F.G * NTHREADS) {
        const int hf = (int)((it_ / SEQ) & 1), bh = (int)(it_ / (2 * SEQ)), qi = (int)(it_ % SEQ); const int b = bh / FH, h = bh % FH;
        float q[64], o[32];
        { const bf16* qp = Q + ((size_t)b * SEQ + qi) * 512 + h * 64;
#pragma unroll
          for (int c = 0; c < 64; c += 8) { const v4u x = *(const v4u*)(qp + c);
#pragma unroll
            for (int i = 0; i < 4; ++i) { q[c + 2 * i] = bf2f(x[i] & 0xffffu); q[c + 2 * i + 1] = bf2f(x[i] >> 16); } } }
#pragma unroll
        for (int c = 0; c < 32; ++c) o[c] = 0.f;
        float mx = -INFINITY, l = 0.f; const float clq = CL[(size_t)bh * SEQ + qi];
        const int jend = __builtin_amdgcn_readfirstlane(qi | 63);
        for (int j = 0; j <= jend; ++j) {
            const bf16* kp = K + ((size_t)b * SEQ + j) * 512 + h * 64; const bf16* vp = V + ((size_t)b * SEQ + j) * 512 + h * 64 + hf * 32;
            float s = 0.f;
#pragma unroll
            for (int c = 0; c < 64; c += 8) { const v4u x = *(const v4u*)(kp + c);
#pragma unroll
                for (int i = 0; i < 4; ++i) { s = fmaf(q[c + 2 * i], bf2f(x[i] & 0xffffu), s); s = fmaf(q[c + 2 * i + 1], bf2f(x[i] >> 16), s); } }
            asm volatile("" ::: "memory");
            s += clq - CL[(size_t)bh * SEQ + j];
            if (j <= qi) {
                const float mn = fmaxf(mx, s), sc = exp2f(mx - mn), p = exp2f(s - mn);
                l = l * sc + p; mx = mn;
#pragma unroll
                for (int c = 0; c < 32; c += 8) { const v4u x = *(const v4u*)(vp + c);
#pragma unroll
                    for (int i = 0; i < 4; ++i) { o[c + 2 * i] = o[c + 2 * i] * sc + p * bf2f(x[i] & 0xffffu); o[c + 2 * i + 1] = o[c + 2 * i + 1] * sc + p * bf2f(x[i] >> 16); } }
            }
        }
        const float il = 1.0f / l;
        bf16* op = FO + ((size_t)b * SEQ + qi) * 512 + h * 64 + hf * 32;
#pragma unroll
        for (int c = 0; c < 32; c += 8) *(v4u*)(op + c) = (v4u){pk2(o[c] * il, o[c + 1] * il), pk2(o[c + 2] * il, o[c + 3] * il), pk2(o[c + 4] * il, o[c + 5] * il), pk2(o[c + 6] * il, o[c + 7] * il)};
    }
}
__device__ __forceinline__ void n_memattn(Frame& F, int l, const float* mqg) {
    const float* MQ = (const float*)(F.ws + WS_AR + AR_MQ); bf16* MO = (bf16*)(F.ws + WS_AR + AR_MO);
    const bf16* KM = (const bf16*)(F.ws + WS_KM) + (size_t)l * MROWS * 512; const bf16* VM = (const bf16*)(F.ws + WS_VM) + (size_t)l * MROWS * 512;
    LAS float* qs = (LAS float*)(F.lds + RING_OFF) + F.wave * 512; LAS float* psh = qs + 128; const int lane = F.lane;
    for (long it_ = (long)F.vcu * NWAVES + F.wave; it_ < (long)T * MH; it_ += (long)F.G * NWAVES) {
        const int row = (int)(it_ >> 2), head = (int)(it_ & 3), b = row / SEQ;
        const float x0 = MQ[(size_t)row * 512 + head * 128 + 2 * lane], x1 = MQ[(size_t)row * 512 + head * 128 + 2 * lane + 1];
        const float ss = wave_sum(x0 * x0 + x1 * x1); const float rstd = 1.0f / sqrtf(ss * (1.0f / MD) + EPS) * C2M;
        qs[2 * lane] = x0 * rstd * mqg[2 * lane]; qs[2 * lane + 1] = x1 * rstd * mqg[2 * lane + 1];
        asm volatile("s_waitcnt lgkmcnt(0)" ::: "memory");
        float sc[4]; float mx = -INFINITY;
#pragma unroll
        for (int i = 0; i < 4; ++i) { const bf16* kp = KM + ((size_t)b * NMEM + lane + 64 * i) * 512 + head * 128; float s = 0.f;
#pragma unroll
            for (int c = 0; c < 128; c += 8) { const v4u x = *(const v4u*)(kp + c); const f32x4 qa = *(const LAS f32x4*)(qs + c), qb = *(const LAS f32x4*)(qs + c + 4);
                s = fmaf(qa[0], bf2f(x[0] & 0xffffu), s); s = fmaf(qa[1], bf2f(x[0] >> 16), s); s = fmaf(qa[2], bf2f(x[1] & 0xffffu), s); s = fmaf(qa[3], bf2f(x[1] >> 16), s);
                s = fmaf(qb[0], bf2f(x[2] & 0xffffu), s); s = fmaf(qb[1], bf2f(x[2] >> 16), s); s = fmaf(qb[2], bf2f(x[3] & 0xffffu), s); s = fmaf(qb[3], bf2f(x[3] >> 16), s); }
            sc[i] = s; mx = fmaxf(mx, s); }
#pragma unroll
        for (int o = 1; o < 64; o <<= 1) mx = fmaxf(mx, __shfl_xor(mx, o));
        float lsum = 0.f;
#pragma unroll
        for (int i = 0; i < 4; ++i) { const float p = exp2f(sc[i] - mx); lsum += p; psh[lane + 64 * i] = p; }
        lsum = wave_sum(lsum);
        asm volatile("s_waitcnt lgkmcnt(0)" ::: "memory");
        float o0 = 0.f, o1 = 0.f;
        for (int j = 0; j < NMEM; ++j) { const unsigned vv = *(const unsigned*)(VM + ((size_t)b * NMEM + j) * 512 + head * 128 + 2 * lane); const float p = psh[j];
            o0 = fmaf(p, bf2f(vv & 0xffffu), o0); o1 = fmaf(p, bf2f(vv >> 16), o1); }
        const float il = 1.0f / lsum;
        *(unsigned*)(MO + (size_t)row * 512 + head * 128 + 2 * lane) = pk2(o0 * il, o1 * il);
        asm volatile("s_waitcnt lgkmcnt(0)" ::: "memory");
    }
}
__device__ __forceinline__ void n_merge(Frame& F, const float* wp, const float* wf, const float* wm) {
    unsigned char* ar = F.ws + WS_AR; const bf16* G = (const bf16*)(ar + AR_G); bf16* MG = (bf16*)(F.ws + WS_H); const int lane = F.lane;
    WITEM_LOOP(T / 16, 16) { WITEM_RB(T / 16, row0, blk);
        float m[16]; ZERO16(m);
#pragma unroll 1
        for (int b = 0; b < 3; ++b) {
            const bf16* A = (const bf16*)(ar + (b == 0 ? AR_PO : (b == 1 ? AR_FO : AR_MO))); const float* W = b == 0 ? wp : (b == 1 ? wf : wm);
            float acc[16]; ZERO16(acc);
            rb2(acc, A + (size_t)row0 * 512, 512, 512, W + 64 * blk + lane, D);
            const bf16* gp = G + (size_t)row0 * 3072 + b * 1024 + 64 * blk + lane;
#pragma unroll
            for (int r = 0; r < 16; ++r) m[r] = fmaf(bf2f(gp[(size_t)r * 3072]), acc[r], m[r]);
        }
        bf16* o = MG + (size_t)row0 * D + 64 * blk + lane;
#pragma unroll
        for (int r = 0; r < 16; ++r) o[(size_t)r * D] = (bf16)f2bf(m[r]);
    }
}
__device__ __forceinline__ void n_resgemm(Frame& F, const float* base, const bf16* A, int K, const float* W) {
    const int lane = F.lane;
    WITEM_LOOP(T / 16, 16) { WITEM_RB(T / 16, row0, blk);
        float acc[16]; ZERO16(acc);
        rb2(acc, A + (size_t)row0 * K, K, K, W + 64 * blk + lane, D);
        const float* bp = base + (size_t)row0 * D + 64 * blk + lane; float* op = F.X + (size_t)row0 * D + 64 * blk + lane;
#pragma unroll
        for (int r = 0; r < 16; ++r) op[(size_t)r * D] = bp[(size_t)r * D] + acc[r];
    }
}
__device__ __forceinline__ void n_ffn_up(Frame& F, const float* wgu, int FF, int e) {
    const bf16* H = (const bf16*)(F.ws + WS_H); bf16* ACT = (bf16*)(F.ws + WS_AR + AR_ACT); const int lane = F.lane;
    WITEM_LOOP(T / 16, FF / 64) { WITEM_RB(T / 16, row0, blk);
        float g[16], u[16]; ZERO16(g); ZERO16(u);
        rb2(g, H + (size_t)row0 * D, D, D, wgu + 64 * blk + lane, 2 * FF);
        rb2(u, H + (size_t)row0 * D, D, D, wgu + FF + 64 * blk + lane, 2 * FF);
        bf16* o = ACT + (size_t)row0 * FF + 64 * blk + lane;
#pragma unroll
        for (int r = 0; r < 16; ++r) o[(size_t)r * FF] = (bf16)f2bf(g[r] * sigmoid_f(g[r]) * u[r]);
    }
}
__device__ __forceinline__ void n_ffn_down(Frame& F, const float* wd, int FF, int e) {
    const bf16* ACT = (const bf16*)(F.ws + WS_AR + AR_ACT); const int lane = F.lane;
    WITEM_LOOP(T / 16, 16) { WITEM_RB(T / 16, row0, blk);
        float acc[16]; ZERO16(acc);
        rb2(acc, ACT + (size_t)row0 * FF, FF, FF, wd + 64 * blk + lane, D);
        float* op = F.X + (size_t)row0 * D + 64 * blk + lane;
#pragma unroll
        for (int r = 0; r < 16; ++r) { float comb = 1.0f;
            if (e >= 0) { const Choice c = ((const Choice*)(F.ws + WS_CHOICE))[row0 + r]; comb = (c.e1 == e) ? c.w1 : ((c.e2 == e) ? c.w2 : 0.f); }
            if (comb != 0.f) op[(size_t)r * D] += comb * acc[r]; }
    }
}

namespace pg8 {
#define PG8_LAS __attribute__((address_space(3)))
typedef unsigned short bf16_t;
typedef short bf16x8 __attribute__((ext_vector_type(8)));
typedef float f32x4 __attribute__((ext_vector_type(4)));
typedef unsigned u32x4 __attribute__((ext_vector_type(4)));
constexpr int BM = 256, BK = 64, HALF = 128, HTB = HALF * BK * 2  , STAGE_BYTES = 8 * HTB, NXCD = 8, WGM = 8;

__host__ __device__ __forceinline__ int lds_byte(int r, int c) { const int st = (r >> 4) * 2 + (c >> 5), rr = r & 15, cc = c & 31, ob = rr * 64 + cc * 2; return st * 1024 + (ob ^ (((ob >> 9) & 1) << 5)); }
__host__ __device__ __forceinline__ void stage_rc(int b, int& R, int& C) { const int st = b / 1024, sb = b % 1024, swz = sb ^ (((sb >> 9) & 1) << 5); R = (st >> 1) * 16 + swz / 64; C = (st & 1) * 32 + (swz % 64) / 2; }
__host__ __device__ __forceinline__ int perm32(int rho) { const int n = rho >> 4, i = rho & 15; return 8 * (i >> 2) + 4 * n + (i & 3); }

struct Unit { int pm, pn, aux; };
struct Gemm { const bf16_t* A; const bf16_t* Bt; int M, N, K; };

struct StaticOrder {
    int nM, nN, nwg, G, c;
    __host__ __device__ void init(int M, int N, int G_, int c_) { nM = M / BM; nN = N / BM; nwg = nM * nN; G = G_; c = c_; }
    __host__ __device__ bool next(int i, Unit& u) const {
        const long L = (long)i * G + c; if (L >= nwg) return false;
        int wgid = (int)L; { const int q = nwg / NXCD, r = nwg % NXCD, xcd = wgid % NXCD, off = wgid / NXCD; wgid = (xcd < r ? xcd * (q + 1) : r * (q + 1) + (xcd - r) * q) + off; }
        const int nig = WGM * nN, gid = wgid / nig, fm = gid * WGM, gsz = (nM - fm) < WGM ? (nM - fm) : WGM;
        u.pm = fm + ((wgid % nig) % gsz); u.pn = (wgid % nig) / gsz; u.aux = 0; return true;
    }
    __device__ __forceinline__ void ptrs(const Gemm& g, const Unit& u, const char*& a, const char*& b) const { a = (const char*)g.A + (size_t)u.pm * (size_t)(BM * 2) * g.K; b = (const char*)g.Bt + (size_t)u.pn * (size_t)(BM * 2) * g.K; }
    __device__ __forceinline__ void a_ready(const Unit&) const {}
    __device__ __forceinline__ void done(const Unit&) const {}
};

typedef float f32x2_cv __attribute__((ext_vector_type(2))); typedef __bf16 bf16x2_cv __attribute__((ext_vector_type(2)));
__device__ __forceinline__ unsigned cvt_pk_bf16(float lo, float hi) { const f32x2_cv v = {lo, hi}; const bf16x2_cv b = __builtin_convertvector(v, bf16x2_cv); return __builtin_bit_cast(unsigned, b); }

template <class Epi, class Sched, bool ALIGN_EPI = false, bool SP2 = false>
__device__ __forceinline__ void gemm_phase(PG8_LAS unsigned char* lds, const Gemm g, const Sched& S, const Epi& E, const int tid_opaque) {
    const int tid = tid_opaque, wid = __builtin_amdgcn_readfirstlane(tid >> 6), lane = tid & 63, wr = wid >> 2, wc = wid & 3, fr = lane & 15, fq = lane >> 4;
    const int K = g.K, nt = K / BK;
    unsigned voffA[2], voffB[2];
#pragma unroll
    for (int i = 0; i < 2; ++i) { int R, C; stage_rc(tid * 16 + i * 8192, R, C); const int Rb = Epi::PERM ? ((R & ~31) + perm32(R & 31)) : R;
        voffA[i] = (unsigned)(R * K + C) * 2u; voffB[i] = (unsigned)(Rb * K + C) * 2u; }
    const size_t kstep = (size_t)(BK * 2);
    const size_t hstep = (size_t)HALF * K * 2;
    const unsigned ldsw = (unsigned)wid * 1024u;
    const int aoff = lds_byte(wr * 64 + fr, fq * 8), boff = lds_byte(wc * 32 + fr, fq * 8);
#define PG8_SA(b, h) (((b) * 2 + (h)) * HTB)
#define PG8_SB(b, h) ((4 + (b) * 2 + (h)) * HTB)
#define PG8_STAGE(bufoff, gbase, voff) do { _Pragma("unroll") for (int _i = 0; _i < 2; ++_i) \
        __builtin_amdgcn_global_load_lds((const unsigned*)((const char*)(gbase) + (voff)[_i]), (PG8_LAS unsigned*)(lds + (bufoff) + ldsw + _i * 8192), 16, 0, 0); } while (0)
#define PG8_LDA(dst, b, h) do { _Pragma("unroll") for (int m = 0; m < 4; ++m) _Pragma("unroll") for (int k = 0; k < 2; ++k) dst[m][k] = *(const PG8_LAS bf16x8*)(lds + PG8_SA(b, h) + aoff + m * 2048 + k * 1024); } while (0)
#define PG8_LDB(dst, b, h) do { _Pragma("unroll") for (int n = 0; n < 2; ++n) _Pragma("unroll") for (int k = 0; k < 2; ++k) dst[n][k] = *(const PG8_LAS bf16x8*)(lds + PG8_SB(b, h) + boff + n * 2048 + k * 1024); } while (0)
#define PG8_MMA(ai, bj, At, Bt) do { __builtin_amdgcn_s_setprio(1); _Pragma("unroll") for (int m = 0; m < 4; ++m) _Pragma("unroll") for (int n = 0; n < 2; ++n) _Pragma("unroll") for (int k = 0; k < 2; ++k) \
        acc[ai][bj][m][n] = __builtin_amdgcn_mfma_f32_16x16x32_bf16(Bt[n][k], At[m][k], acc[ai][bj][m][n], 0, 0, 0); __builtin_amdgcn_s_setprio(0); } while (0)
#define PG8_WAIT_V(n) asm volatile("s_waitcnt vmcnt(" #n ")" ::: "memory")
#define PG8_WAIT_L(n) asm volatile("s_waitcnt lgkmcnt(" #n ")" ::: "memory")
#define PG8_BAR __builtin_amdgcn_s_barrier()
#define PG8_SCHED __builtin_amdgcn_sched_barrier(0)
    Unit cur, nxt; int ui = 0;
    if (!S.next(0, cur)) return;
    f32x4 acc[2][2][4][2];
#pragma unroll
    for (int a = 0; a < 2; ++a)
#pragma unroll
        for (int b = 0; b < 2; ++b)
#pragma unroll
            for (int m = 0; m < 4; ++m)
#pragma unroll
                for (int n = 0; n < 2; ++n) acc[a][b][m][n] = (f32x4){0.f, 0.f, 0.f, 0.f};
    bf16x8 At[4][2], B0[2][2], B1[2][2];
    const char* cA; const char* cB; S.ptrs(g, cur, cA, cB);
    S.a_ready(cur);
    if constexpr (SP2) {
        PG8_STAGE(PG8_SB(0, 0), cB, voffB); PG8_STAGE(PG8_SB(0, 1), cB + hstep, voffB); PG8_STAGE(PG8_SA(0, 0), cA, voffA); PG8_STAGE(PG8_SA(0, 1), cA + hstep, voffA);
        if (wr == 1) PG8_BAR;
        PG8_WAIT_V(2); PG8_BAR;
        PG8_STAGE(PG8_SB(1, 0), cB + kstep, voffB); PG8_STAGE(PG8_SA(1, 0), cA + kstep, voffA); PG8_STAGE(PG8_SB(1, 1), cB + hstep + kstep, voffB);
        PG8_WAIT_V(6); PG8_BAR;
    } else {
        PG8_STAGE(PG8_SB(0, 0), cB, voffB); PG8_STAGE(PG8_SA(0, 0), cA, voffA); PG8_STAGE(PG8_SB(0, 1), cB + hstep, voffB); PG8_STAGE(PG8_SA(0, 1), cA + hstep, voffA);
        if (wr == 1) PG8_BAR;
        PG8_WAIT_V(4); PG8_BAR;
        PG8_STAGE(PG8_SB(1, 0), cB + kstep, voffB); PG8_STAGE(PG8_SA(1, 0), cA + kstep, voffA); PG8_STAGE(PG8_SB(1, 1), cB + hstep + kstep, voffB);
        PG8_WAIT_V(6); PG8_BAR;
    }
    for (;;) {
        const bool has_next = S.next(ui + 1, nxt);
        const char* nA = cA; const char* nB = cB; if (has_next) S.ptrs(g, nxt, nA, nB);
        for (int t = 0; t < nt; t += 2) {
            const bool last = (t == nt - 2);
            const char* a1 = cA + (size_t)(t + 1) * kstep;
            const char* a2 = last ? nA : cA + (size_t)(t + 2) * kstep; const char* b2 = last ? nB : cB + (size_t)(t + 2) * kstep;
            const char* a3 = a2 + kstep; const char* b3 = b2 + kstep;
            if (last && has_next) S.a_ready(nxt);
            if constexpr (SP2) {
            PG8_LDB(B0, 0, 0); PG8_LDB(B1, 0, 1); PG8_SCHED; PG8_LDA(At, 0, 0); PG8_STAGE(PG8_SA(1, 1), a1 + hstep, voffA);
            PG8_WAIT_V(8); PG8_WAIT_L(0); PG8_BAR; PG8_MMA(0, 0, At, B0); PG8_MMA(0, 1, At, B1); PG8_BAR; PG8_SCHED;
            PG8_LDA(At, 0, 1); PG8_STAGE(PG8_SB(0, 0), b2, voffB); PG8_STAGE(PG8_SB(0, 1), b2 + hstep, voffB); PG8_STAGE(PG8_SA(0, 0), a2, voffA);
            PG8_WAIT_V(8); PG8_WAIT_L(0); PG8_BAR; PG8_MMA(1, 0, At, B0); PG8_MMA(1, 1, At, B1); PG8_BAR; PG8_SCHED;
            PG8_LDB(B0, 1, 0); PG8_LDB(B1, 1, 1); PG8_SCHED; PG8_LDA(At, 1, 0); PG8_STAGE(PG8_SA(0, 1), a2 + hstep, voffA);
            PG8_WAIT_V(8); PG8_WAIT_L(0); PG8_BAR; PG8_MMA(0, 0, At, B0); PG8_MMA(0, 1, At, B1); PG8_BAR; PG8_SCHED;
            PG8_LDA(At, 1, 1); PG8_STAGE(PG8_SB(1, 0), b3, voffB); PG8_STAGE(PG8_SB(1, 1), b3 + hstep, voffB); PG8_STAGE(PG8_SA(1, 0), a3, voffA);
            PG8_WAIT_V(8); PG8_WAIT_L(0); PG8_BAR; PG8_MMA(1, 0, At, B0); PG8_MMA(1, 1, At, B1); PG8_BAR; PG8_SCHED;
            } else {
            PG8_LDB(B0, 0, 0); PG8_SCHED; PG8_LDA(At, 0, 0); PG8_STAGE(PG8_SA(1, 1), a1 + hstep, voffA);
            PG8_WAIT_L(8); PG8_BAR; PG8_WAIT_L(0); PG8_MMA(0, 0, At, B0); PG8_BAR; PG8_SCHED;
            PG8_LDB(B1, 0, 1); PG8_STAGE(PG8_SB(0, 0), b2, voffB);
            PG8_BAR; PG8_WAIT_L(0); PG8_MMA(0, 1, At, B1); PG8_BAR;
            PG8_LDA(At, 0, 1); PG8_STAGE(PG8_SA(0, 0), a2, voffA);
            PG8_BAR; PG8_WAIT_L(0); PG8_MMA(1, 0, At, B0); PG8_BAR; PG8_SCHED;
            PG8_STAGE(PG8_SB(0, 1), b2 + hstep, voffB);
            PG8_WAIT_V(6); PG8_BAR; PG8_MMA(1, 1, At, B1); PG8_BAR;
            PG8_LDB(B0, 1, 0); PG8_SCHED; PG8_LDA(At, 1, 0); PG8_STAGE(PG8_SA(0, 1), a2 + hstep, voffA);
            PG8_WAIT_L(8); PG8_BAR; PG8_WAIT_L(0); PG8_MMA(0, 0, At, B0); PG8_BAR; PG8_SCHED;
            PG8_LDB(B1, 1, 1); PG8_STAGE(PG8_SB(1, 0), b3, voffB);
            PG8_BAR; PG8_WAIT_L(0); PG8_MMA(0, 1, At, B1); PG8_BAR;
            PG8_LDA(At, 1, 1); PG8_STAGE(PG8_SA(1, 0), a3, voffA);
            PG8_BAR; PG8_WAIT_L(0); PG8_MMA(1, 0, At, B0); PG8_BAR; PG8_SCHED;
            PG8_STAGE(PG8_SB(1, 1), b3 + hstep, voffB);
            PG8_WAIT_V(6); PG8_BAR; PG8_MMA(1, 1, At, B1); PG8_BAR;
            }
        }
        if constexpr (ALIGN_EPI) { if (wr == 0) PG8_BAR; }
        if constexpr (!Epi::AFTER_DRAIN) { E(acc, cur, wr, wc, fr, fq); S.done(cur); }
        if (!has_next) break;
        if (E.zero_after(cur))
#pragma unroll
        for (int a = 0; a < 2; ++a)
#pragma unroll
            for (int b = 0; b < 2; ++b)
#pragma unroll
                for (int m = 0; m < 4; ++m)
#pragma unroll
                    for (int n = 0; n < 2; ++n) acc[a][b][m][n] = (f32x4){0.f, 0.f, 0.f, 0.f};
        cur = nxt; cA = nA; cB = nB; ++ui;
        if constexpr (ALIGN_EPI) { if (wr == 1) PG8_BAR; }
    }
    PG8_WAIT_V(0);
    if constexpr (!ALIGN_EPI) { if (wr == 0) PG8_BAR; }
    PG8_BAR;
    if constexpr (Epi::AFTER_DRAIN) { E.fused(acc, cur, wr, wc, fr, fq, lds, wid, lane); S.done(cur); }
#undef PG8_SA
#undef PG8_SB
#undef PG8_STAGE
#undef PG8_LDA
#undef PG8_LDB
#undef PG8_MMA
#undef PG8_WAIT_V
#undef PG8_WAIT_L
#undef PG8_BAR
#undef PG8_SCHED
}
}

namespace pg8 {
typedef unsigned u32x2 __attribute__((ext_vector_type(2)));
__device__ __forceinline__ float fsigmoid(float x) { return __builtin_amdgcn_rcpf(1.0f + __builtin_amdgcn_exp2f(x * -1.4426950408889634f)); }
__device__ __forceinline__ u32x4 pack8(const f32x4& a, const f32x4& b) { u32x4 w; w.x = cvt_pk_bf16(a[0], a[1]); w.y = cvt_pk_bf16(a[2], a[3]); w.z = cvt_pk_bf16(b[0], b[1]); w.w = cvt_pk_bf16(b[2], b[3]); return w; }

struct EpiF32 {
    static constexpr bool PERM = false, AFTER_DRAIN = false;
    float* C; int ldc; const float* base;
    __device__ __forceinline__ bool zero_after(const Unit&) const { return true; }
    __device__ __forceinline__ void operator()(f32x4 (&acc)[2][2][4][2], const Unit& u, int wr, int wc, int fr, int fq) const {
        const int row0 = u.pm * BM + wr * 64 + fr, col0 = u.pn * BM + wc * 32 + 4 * fq;
#pragma unroll
        for (int ai = 0; ai < 2; ++ai)
#pragma unroll
            for (int m = 0; m < 4; ++m) { const size_t off = (size_t)(row0 + ai * HALF + m * 16) * ldc + col0;
#pragma unroll
                for (int bj = 0; bj < 2; ++bj)
#pragma unroll
                    for (int n = 0; n < 2; ++n) { f32x4 v = acc[ai][bj][m][n]; if (base) v += *(const f32x4*)(base + off + bj * HALF + n * 16); *(f32x4*)(C + off + bj * HALF + n * 16) = v; } }
    }
};
struct EpiBf16P {
    static constexpr bool PERM = true, AFTER_DRAIN = false;
    bf16_t* O; int ldc;
    __device__ __forceinline__ bool zero_after(const Unit&) const { return true; }
    __device__ __forceinline__ void operator()(f32x4 (&acc)[2][2][4][2], const Unit& u, int wr, int wc, int fr, int fq) const {
        const int row0 = u.pm * BM + wr * 64 + fr, col0 = u.pn * BM + wc * 32 + 8 * fq;
#pragma unroll
        for (int ai = 0; ai < 2; ++ai)
#pragma unroll
            for (int m = 0; m < 4; ++m) { bf16_t* rowp = O + (size_t)(row0 + ai * HALF + m * 16) * ldc + col0;
#pragma unroll
                for (int bj = 0; bj < 2; ++bj) *(u32x4*)(rowp + bj * HALF) = pack8(acc[ai][bj][m][0], acc[ai][bj][m][1]); }
    }
};
struct EpiSwiGLU {
    static constexpr bool PERM = true, AFTER_DRAIN = false;
    bf16_t* O; int ldc;
    __device__ __forceinline__ bool zero_after(const Unit&) const { return true; }
    __device__ __forceinline__ void operator()(f32x4 (&acc)[2][2][4][2], const Unit& u, int wr, int wc, int fr, int fq) const {
        const int row0 = u.pm * BM + wr * 64 + fr, col0 = u.pn * HALF + wc * 32 + 8 * fq;
#pragma unroll
        for (int ai = 0; ai < 2; ++ai)
#pragma unroll
            for (int m = 0; m < 4; ++m) { bf16_t* rowp = O + (size_t)(row0 + ai * HALF + m * 16) * ldc + col0; f32x4 r[2];
#pragma unroll
                for (int n = 0; n < 2; ++n) { const f32x4 g = acc[ai][0][m][n], up = acc[ai][1][m][n];
#pragma unroll
                    for (int i = 0; i < 4; ++i) r[n][i] = g[i] * up[i] * fsigmoid(g[i]); }
                *(u32x4*)rowp = pack8(r[0], r[1]); }
    }
};
struct EpiInProj {
    static constexpr bool PERM = true, AFTER_DRAIN = false;
    bf16_t *U, *Q, *K, *V, *G; float* MQ; const float *qg, *kg;
    __device__ __forceinline__ bool zero_after(const Unit&) const { return true; }
    __device__ __forceinline__ void operator()(f32x4 (&acc)[2][2][4][2], const Unit& u, int wr, int wc, int fr, int fq) const {
        const int row0 = u.pm * BM + wr * 64 + fr, pn = u.pn;
        if (pn < 2 || (pn >= 6 && pn < 8)) {
            bf16_t* base = (pn < 2 ? U + 256 * pn : V + 256 * (pn - 6)) + wc * 32 + 8 * fq;
#pragma unroll
            for (int ai = 0; ai < 2; ++ai)
#pragma unroll
                for (int m = 0; m < 4; ++m) { bf16_t* rowp = base + (size_t)(row0 + ai * HALF + m * 16) * 512;
#pragma unroll
                    for (int bj = 0; bj < 2; ++bj) *(u32x4*)(rowp + bj * HALF) = pack8(acc[ai][bj][m][0], acc[ai][bj][m][1]); }
        } else if (pn < 6) {
            const bool isq = pn < 4; const int head = 4 * (pn - (isq ? 2 : 4)) + wc; const float* gg = isq ? qg : kg; const float sc = isq ? C2F : 1.0f;
            f32x4 gv[2][2];
#pragma unroll
            for (int bj = 0; bj < 2; ++bj)
#pragma unroll
                for (int n = 0; n < 2; ++n) gv[bj][n] = *(const f32x4*)(gg + 32 * bj + 8 * fq + 4 * n) * sc;
            bf16_t* base = (isq ? Q : K) + head * 64 + 8 * fq;
#pragma unroll
            for (int ai = 0; ai < 2; ++ai)
#pragma unroll
                for (int m = 0; m < 4; ++m) { float ss = 0.f;
#pragma unroll
                    for (int bj = 0; bj < 2; ++bj)
#pragma unroll
                        for (int n = 0; n < 2; ++n) { const f32x4 x = acc[ai][bj][m][n]; ss += (x[0] * x[0] + x[1] * x[1]) + (x[2] * x[2] + x[3] * x[3]); }
                    ss += __shfl_xor(ss, 16); ss += __shfl_xor(ss, 32);
                    const float rstd = 1.0f / sqrtf(ss * (1.0f / 64.0f) + EPS);
                    bf16_t* rowp = base + (size_t)(row0 + ai * HALF + m * 16) * 512;
#pragma unroll
                    for (int bj = 0; bj < 2; ++bj) *(u32x4*)(rowp + 32 * bj) = pack8(acc[ai][bj][m][0] * rstd * gv[bj][0], acc[ai][bj][m][1] * rstd * gv[bj][1]); }
        } else if (pn < 10) {
            float* base = MQ + 256 * (pn - 8) + wc * 32 + 8 * fq;
#pragma unroll
            for (int ai = 0; ai < 2; ++ai)
#pragma unroll
                for (int m = 0; m < 4; ++m) { float* rowp = base + (size_t)(row0 + ai * HALF + m * 16) * 512;
#pragma unroll
                    for (int bj = 0; bj < 2; ++bj)
#pragma unroll
                        for (int n = 0; n < 2; ++n) *(f32x4*)(rowp + bj * HALF + 4 * n) = acc[ai][bj][m][n]; }
        } else {
            bf16_t* base = G + 256 * (pn - 10) + wc * 32 + 8 * fq;
#pragma unroll
            for (int ai = 0; ai < 2; ++ai)
#pragma unroll
                for (int m = 0; m < 4; ++m) { bf16_t* rowp = base + (size_t)(row0 + ai * HALF + m * 16) * 3072;
#pragma unroll
                    for (int bj = 0; bj < 2; ++bj) { f32x4 r[2];
#pragma unroll
                        for (int n = 0; n < 2; ++n)
#pragma unroll
                            for (int i = 0; i < 4; ++i) r[n][i] = fsigmoid(acc[ai][bj][m][n][i]);
                        *(u32x4*)(rowp + bj * HALF) = pack8(r[0], r[1]); } }
        }
    }
};
struct EpiMerge {
    static constexpr bool PERM = true, AFTER_DRAIN = false;
    const bf16_t* G; bf16_t* O;
    __device__ __forceinline__ bool zero_after(const Unit& u) const { return u.aux == 2; }
    __device__ __forceinline__ void operator()(f32x4 (&acc)[2][2][4][2], const Unit& u, int wr, int wc, int fr, int fq) const {
        const int row0 = u.pm * BM + wr * 64 + fr, col0 = u.pn * BM + wc * 32 + 8 * fq, seg = u.aux;
#pragma unroll
        for (int ai = 0; ai < 2; ++ai)
#pragma unroll
            for (int m = 0; m < 4; ++m) { const size_t row = (size_t)(row0 + ai * HALF + m * 16);
#pragma unroll
                for (int bj = 0; bj < 2; ++bj) { const bf16_t* gp = G + row * 3072 + col0 + bj * HALF + seg * 1024;
                    const u32x4 ga = *(const u32x4*)gp; float f[8];
#pragma unroll
                    for (int i = 0; i < 4; ++i) { f[2 * i] = fmaxf(__uint_as_float(ga[i] << 16), 1e-30f); f[2 * i + 1] = fmaxf(__uint_as_float(ga[i] & 0xffff0000u), 1e-30f); }
                    if (seg < 2) { const u32x4 gb = *(const u32x4*)(gp + 1024);
#pragma unroll
                        for (int i = 0; i < 4; ++i) { f[2 * i] *= __builtin_amdgcn_rcpf(fmaxf(__uint_as_float(gb[i] << 16), 1e-30f)); f[2 * i + 1] *= __builtin_amdgcn_rcpf(fmaxf(__uint_as_float(gb[i] & 0xffff0000u), 1e-30f)); } }
#pragma unroll
                    for (int i = 0; i < 4; ++i) { acc[ai][bj][m][0][i] *= f[i]; acc[ai][bj][m][1][i] *= f[4 + i]; }
                    if (seg == 2) *(u32x4*)(O + row * 1024 + col0 + bj * HALF) = pack8(acc[ai][bj][m][0], acc[ai][bj][m][1]); } }
    }
};
template <size_t O0, size_t O1, size_t O2>
struct MergeOrder {
    StaticOrder so; const char* arena; const char* Bbase;
    __device__ __forceinline__ bool next(int i, Unit& u) const { const int ti = i / 3; if (!so.next(ti, u)) return false; u.aux = i - 3 * ti; return true; }
    __device__ __forceinline__ void ptrs(const Gemm& g, const Unit& u, const char*& a, const char*& b) const {
        const size_t oa = u.aux == 0 ? O0 : (u.aux == 1 ? O1 : O2);
        a = arena + oa + (size_t)u.pm * (size_t)(BM * 2) * g.K; b = Bbase + (size_t)u.aux * (size_t)(1024 * 512 * 2) + (size_t)u.pn * (size_t)(BM * 2) * g.K; }
    __device__ __forceinline__ void a_ready(const Unit&) const {}
    __device__ __forceinline__ void done(const Unit&) const {}
};
struct GroupedOrder {
    StaticOrder so; const int* tile_e; size_t bstride;
    __device__ __forceinline__ bool next(int i, Unit& u) const { if (!so.next(i, u)) return false; u.aux = __builtin_amdgcn_readfirstlane(tile_e[u.pm]); return true; }
    __device__ __forceinline__ void ptrs(const Gemm& g, const Unit& u, const char*& a, const char*& b) const {
        a = (const char*)g.A + (size_t)u.pm * (size_t)(BM * 2) * g.K; b = (const char*)g.Bt + (size_t)u.aux * bstride + (size_t)u.pn * (size_t)(BM * 2) * g.K; }
    __device__ __forceinline__ void a_ready(const Unit&) const {}
    __device__ __forceinline__ void done(const Unit&) const {}
};
}

constexpr size_t W_IN = 8 * MiB, W_KV = 30 * MiB, W_BR = 34 * MiB, W_OUT = 40 * MiB, W_GU = 44 * MiB, W_DN = 55 * MiB, W_EGU = 64 * MiB, W_EDN = 176 * MiB;
constexpr size_t WS_SLOT = 4 * MiB, WS_META = 4 * MiB + 512 * 1024;
constexpr size_t WS_HS = 264 * MiB, WS_YB = WS_HS, WS_ACTE = 434 * MiB, WS_H2 = 434 * MiB;
constexpr int MAXTILES = 264;

template <class Map>
__device__ __forceinline__ void tr_job(Frame& F, const float* W, int K, int ldw, bf16* WT, int nblk, Map map) {
    LAS float* scr = (LAS float*)(F.lds + RING_OFF + F.wave * 16384);
    const int lane = F.lane, gw = F.vcu * NWAVES + F.wave, NGW = F.G * NWAVES, nitems = (K / 64) * nblk;
    for (int it = gw; it < nitems; it += NGW) {
        const int kb = it / nblk, nb = it % nblk, k0 = 64 * kb, n0 = map(nb);
#pragma unroll 8
        for (int i = 0; i < 32; ++i) { const int kk = 2 * i + (lane >> 5); scr[kk * 33 + (lane & 31)] = W[(size_t)(k0 + kk) * ldw + n0 + (lane & 31)]; }
        asm volatile("s_waitcnt lgkmcnt(0)" ::: "memory");
        const int c = lane & 7;
#pragma unroll
        for (int j = 0; j < 4; ++j) { const int n = (lane >> 3) + 8 * j; const LAS float* s = scr + (8 * c) * 33 + n;
            v4u o; o.x = pk2(s[0 * 33], s[1 * 33]); o.y = pk2(s[2 * 33], s[3 * 33]); o.z = pk2(s[4 * 33], s[5 * 33]); o.w = pk2(s[6 * 33], s[7 * 33]);
            *(v4u*)(WT + (size_t)(32 * nb + n) * K + k0 + 8 * c) = o; }
        asm volatile("s_waitcnt lgkmcnt(0)" ::: "memory");
    }
}
struct MapId { __device__ __forceinline__ int operator()(int nb) const { return 32 * nb; } };
struct MapIn { __device__ __forceinline__ int operator()(int nb) const { const int pn = nb >> 3, q = nb & 7;
    if (pn < 2) return 256 * pn + 32 * q;
    if (pn < 4) return OFF_Q + 64 * (4 * (pn - 2) + (q & 3)) + 32 * (q >> 2);
    if (pn < 6) return OFF_K + 64 * (4 * (pn - 4) + (q & 3)) + 32 * (q >> 2);
    if (pn < 8) return OFF_V + 256 * (pn - 6) + 32 * q;
    if (pn < 10) return OFF_MQ + 256 * (pn - 8) + 32 * q;
    return OFF_G + 256 * (pn - 10) + 32 * q; } };
struct MapGU { int FF; __device__ __forceinline__ int operator()(int nb) const { const int pn = nb >> 3, q = nb & 7; return q < 4 ? 128 * pn + 32 * q : FF + 128 * pn + 32 * (q - 4); } };

__device__ __forceinline__ void conv_phase(Frame& F) {
    unsigned char* ws = F.ws;
#pragma unroll 1
    for (int l = 0; l < DEPTH; ++l) {
        tr_job(F, inptr(F, I_WIN) + (size_t)l * D * NIN, D, NIN, (bf16*)(ws + W_IN) + (size_t)l * 5632 * 1024, 176, MapIn{});
        tr_job(F, inptr(F, I_WKV) + (size_t)l * D * 1024, D, 1024, (bf16*)(ws + W_KV) + (size_t)l * 1024 * 1024, 32, MapId{});
        tr_job(F, inptr(F, I_WFBR) + (size_t)l * 512 * D, 512, D, (bf16*)(ws + W_BR) + (size_t)(l * 3 + 1) * 1024 * 512, 32, MapId{});
        tr_job(F, inptr(F, I_WMBR) + (size_t)l * 512 * D, 512, D, (bf16*)(ws + W_BR) + (size_t)(l * 3 + 2) * 1024 * 512, 32, MapId{});
        tr_job(F, inptr(F, I_WOUT) + (size_t)l * D * D, D, D, (bf16*)(ws + W_OUT) + (size_t)l * 1024 * 1024, 32, MapId{});
        { const float* pw = inptr(F, I_POOLW) + (size_t)l * 4 * 128 * 128; const float* ps = inptr(F, I_POOLS) + l * 512; const float* wb = inptr(F, I_WPBR) + (size_t)l * 512 * D;
          bf16* WT = (bf16*)(ws + W_BR) + (size_t)(l * 3) * 1024 * 512; const int lane = F.lane;
          for (int it = F.vcu * NWAVES + F.wave; it < 512 * 16; it += F.G * NWAVES) { const int k = it >> 4, nb = it & 15, g = k >> 7; const int n = 64 * nb + lane;
              const float* pr = pw + (size_t)k * 128; float acc = 0.f;
              for (int d = 0; d < 128; ++d) acc = fmaf(pr[d] * ps[g * 128 + d], wb[(size_t)(g * 128 + d) * D + n], acc);
              WT[(size_t)n * 512 + k] = (bf16)f2bf(acc); } }
    }
    tr_job(F, inptr(F, I_WGU), D, 2 * DFF, (bf16*)(ws + W_GU), 176, MapGU{DFF});
    tr_job(F, inptr(F, I_WDN), DFF, D, (bf16*)(ws + W_DN), 32, MapId{});
#pragma unroll 1
    for (int e = 0; e < NE; ++e) {
        tr_job(F, inptr(F, I_WEGU) + (size_t)e * D * 2 * DEXP, D, 2 * DEXP, (bf16*)(ws + W_EGU) + (size_t)e * 7168 * 1024, 224, MapGU{DEXP});
        tr_job(F, inptr(F, I_WEDN) + (size_t)e * DEXP * D, DEXP, D, (bf16*)(ws + W_EDN) + (size_t)e * 1024 * DEXP, 32, MapId{});
    }
}

__device__ __forceinline__ void moe_scatter_phase(Frame& F, const bf16* H2) {
    const int* WC = (const int*)(F.ws + WS_WCNT); LAS int* sh = (LAS int*)(F.lds + RING_OFF);
    const int tid = F.tid, lane = F.lane, wave = F.wave;
    int before[8], total[8];
    { int s[8];
#pragma unroll
      for (int e = 0; e < 8; ++e) s[e] = 0;
      for (int w = 0; w < 4; ++w) { const int gwv = 4 * tid + w;
#pragma unroll
          for (int e = 0; e < 8; ++e) s[e] += WC[gwv * 8 + e]; }
      const bool isb = tid < 2 * F.vcu;
#pragma unroll
      for (int e = 0; e < 8; ++e) { int t = s[e], b = isb ? s[e] : 0;
#pragma unroll
          for (int o = 1; o < 64; o <<= 1) { t += __shfl_xor(t, o); b += __shfl_xor(b, o); }
          if (lane == 0) { sh[wave * 16 + e] = b; sh[wave * 16 + 8 + e] = t; } }
      __syncthreads();
#pragma unroll
      for (int e = 0; e < 8; ++e) { int b = 0, t = 0;
#pragma unroll
          for (int w = 0; w < 8; ++w) { b += sh[w * 16 + e]; t += sh[w * 16 + 8 + e]; }
          before[e] = b; total[e] = t; } }
    int seg[8]; int ntile = 0;
#pragma unroll
    for (int e = 0; e < 8; ++e) { seg[e] = ntile * 256; ntile += (total[e] + 255) >> 8; }
    if (F.vcu == 0) { int* meta = (int*)(F.ws + WS_META); if (tid == 0) meta[0] = ntile;
        int te = 0;
#pragma unroll
        for (int e = 1; e < 8; ++e) te += (tid * 256 >= seg[e]) ? 1 : 0;
        if (tid < MAXTILES) meta[16 + tid] = te; }
    int base[8];
#pragma unroll
    for (int e = 0; e < 8; ++e) { int b = before[e]; for (int w = 0; w < wave; ++w) b += WC[(F.vcu * NWAVES + w) * 8 + e]; base[e] = seg[e] + b; }
    const int gw = F.vcu * NWAVES + wave, NGW = F.G * NWAVES;
    const int m = gw + (lane & 15) * NGW; const bool act = lane < 16 && m < T;
    Choice c; c.e1 = -1; c.e2 = -1; c.w1 = 0.f; c.w2 = 0.f;
    if (act) c = ((const Choice*)(F.ws + WS_CHOICE))[m];
    int s1 = 0, s2 = 0;
    const unsigned long long lt = (1ull << lane) - 1ull;
#pragma unroll
    for (int e = 0; e < 8; ++e) { const unsigned long long m1 = __ballot(act && c.e1 == e), m2 = __ballot(act && c.e2 == e);
        if (c.e1 == e) s1 = base[e] + __popcll(m1 & lt);
        if (c.e2 == e) s2 = base[e] + __popcll(m1) + __popcll(m2 & lt); }
    if (act) { int* sl = (int*)(F.ws + WS_SLOT) + 2 * m; sl[0] = s1; sl[1] = s2; }
    bf16* HS = (bf16*)(F.ws + WS_HS);
    for (int i = 0; i < 16; ++i) { const int mi = gw + i * NGW; if (mi >= T) break;
        const int d1 = __shfl(s1, i), d2 = __shfl(s2, i);
        const v4u x0 = *(const v4u*)(H2 + (size_t)mi * D + 8 * lane), x1 = *(const v4u*)(H2 + (size_t)mi * D + 512 + 8 * lane);
        *(v4u*)(HS + (size_t)d1 * D + 8 * lane) = x0; *(v4u*)(HS + (size_t)d1 * D + 512 + 8 * lane) = x1;
        *(v4u*)(HS + (size_t)d2 * D + 8 * lane) = x0; *(v4u*)(HS + (size_t)d2 * D + 512 + 8 * lane) = x1; }
    __syncthreads();
}
__device__ __forceinline__ void moe_combine_phase(Frame& F) {
    const bf16* YB = (const bf16*)(F.ws + WS_YB); const int lane = F.lane;
    for (int m = F.vcu * NWAVES + F.wave; m < T; m += F.G * NWAVES) {
        const Choice c = ((const Choice*)(F.ws + WS_CHOICE))[m]; const int* sl = (const int*)(F.ws + WS_SLOT) + 2 * m; const int s1 = sl[0], s2 = sl[1];
#pragma unroll
        for (int h = 0; h < 2; ++h) { const v4u a = *(const v4u*)(YB + (size_t)s1 * D + 512 * h + 8 * lane), b = *(const v4u*)(YB + (size_t)s2 * D + 512 * h + 8 * lane);
            float* xp = F.X + (size_t)m * D + 512 * h + 8 * lane; f32x4 x0 = *(const f32x4*)xp, x1 = *(const f32x4*)(xp + 4);
#pragma unroll
            for (int i = 0; i < 2; ++i) { x0[2 * i] += c.w1 * bf2f(a[i] & 0xffffu) + c.w2 * bf2f(b[i] & 0xffffu); x0[2 * i + 1] += c.w1 * bf2f(a[i] >> 16) + c.w2 * bf2f(b[i] >> 16);
                x1[2 * i] += c.w1 * bf2f(a[2 + i] & 0xffffu) + c.w2 * bf2f(b[2 + i] & 0xffffu); x1[2 * i + 1] += c.w1 * bf2f(a[2 + i] >> 16) + c.w2 * bf2f(b[2 + i] >> 16); }
            *(f32x4*)xp = x0; *(f32x4*)(xp + 4) = x1; }
    }
}

#ifndef FAST_MEMKV
#define FAST_MEMKV 1
#endif
#ifndef FAST_INPROJ
#define FAST_INPROJ 1
#endif
#ifndef FAST_MERGE
#define FAST_MERGE 1
#endif
#ifndef FAST_WOUT
#define FAST_WOUT 1
#endif
#ifndef FAST_FFN
#define FAST_FFN 1
#endif
#ifndef FAST_MOE
#define FAST_MOE 1
#endif
#ifndef FAST_FOX
#define FAST_FOX 0
#endif
struct MemKvOrder {
    int G, c;
    __device__ __forceinline__ bool next(int i, pg8::Unit& u) const { const int L = i * G + c; if (L >= 64) return false; const int l = L >> 5, r = L & 31; u.pm = 8 * l + (r >> 2); u.pn = r & 3; u.aux = l; return true; }
    __device__ __forceinline__ void ptrs(const pg8::Gemm& g, const pg8::Unit& u, const char*& a, const char*& b) const {
        a = (const char*)g.A + (size_t)u.pm * (size_t)(256 * 2) * g.K; b = (const char*)g.Bt + (size_t)u.aux * (size_t)(1024 * 1024 * 2) + (size_t)u.pn * (size_t)(256 * 2) * g.K; }
    __device__ __forceinline__ void a_ready(const pg8::Unit&) const {}
    __device__ __forceinline__ void done(const pg8::Unit&) const {}
};

__global__ void __launch_bounds__(NTHREADS, 2) mk_fwd(Args args) {
    extern __shared__ __attribute__((aligned(16))) unsigned char lds[];
    Frame F;
    F.lds = (LAS unsigned char*)lds; F.MISC = (volatile LAS unsigned*)(F.lds + MISC_OFF);
    F.tid = threadIdx.x; F.lane = F.tid & 63; F.wave = __builtin_amdgcn_readfirstlane(F.tid >> 6);
    F.G = gridDim.x; { const int bx = blockIdx.x; F.vcu = (F.G % 8 == 0) ? (bx % 8) * (F.G / 8) + bx / 8 : bx; }
    F.ws = args.ws; F.ctl = (gu32*)(args.ws + WS_CTL); F.X = args.out;
    for (int u = F.tid; u < (LDS_BYTES - LDSCTL_OFF) / 4; u += NTHREADS) ((LAS unsigned*)(F.lds + LDSCTL_OFF))[u] = 0u;
    __syncthreads();
    (void)xcd_barrier_post((unsigned*)(F.ctl + CW_BAR), F.MISC + 8);
#define REFRESH() do { int t_ = threadIdx.x; asm volatile("" : "+v"(t_)); F.tid = t_; F.lane = t_ & 63; int w_ = __builtin_amdgcn_readfirstlane(t_ >> 6); asm volatile("" : "+s"(w_)); F.wave = w_; \
    int v_ = F.vcu; asm volatile("" : "+s"(v_)); F.vcu = v_; } while (0)
#define SEAM() do { XcdBarrier b_; b_.bar = (unsigned*)(F.ws + WS_CTL) + CW_BAR; b_.x = xb_xcc_id(); b_.st = (volatile LAS unsigned*)(F.lds + MISC_OFF) + 8; xcd_barrier(b_); REFRESH(); } while (0)
    { volatile LAS unsigned long long* PT = (volatile LAS unsigned long long*)(F.lds + PTR_OFF);
      if (F.tid == 0) {
#define PUT_(i) PT[i] = (unsigned long long)(uintptr_t)args.in[i];
        PUT_(0) PUT_(1) PUT_(2) PUT_(3) PUT_(4) PUT_(5) PUT_(6) PUT_(7) PUT_(8) PUT_(9) PUT_(10) PUT_(11) PUT_(12) PUT_(13) PUT_(14) PUT_(15) PUT_(16) PUT_(17) PUT_(18) PUT_(19) PUT_(20) PUT_(21) PUT_(22) PUT_(23)
#undef PUT_
      }
      __syncthreads(); }
#define INP(i) inptr(F, (i))
    unsigned char* const ws = F.ws; unsigned char* const ar = ws + WS_AR;
    LAS unsigned char* const ring = F.lds + RING_OFF;
    const int bx = (int)blockIdx.x;

    conv_phase(F); REFRESH();
    memnorm_phase(F, INP(I_MEM), INP(I_MEMG)); SEAM();
#if FAST_MEMKV
    { pg8::Gemm g{(const bf16*)(ws + WS_MEMN), (const bf16*)(ws + W_KV), DEPTH * MROWS, 1024, D}; MemKvOrder S{F.G, bx};
      pg8::EpiF32 E{(float*)(ws + WS_KVF), 1024, nullptr};
      pg8::gemm_phase<pg8::EpiF32, MemKvOrder, true, true>(ring, g, S, E, F.tid); }
#else
    n_memkv(F, INP(I_WKV));
#endif
    SEAM();
    kvfin_phase(F, INP(I_MKG)); SEAM();

#pragma unroll 1
    for (int l = 0; l < DEPTH; ++l) {
        const float* xin = (l == 0) ? INP(I_X) : (const float*)F.X;
        norm_phase<1>(F, xin, INP(I_MIXG) + l * D, INP(I_WIN) + (size_t)l * D * NIN + OFF_F, NIN, INP(I_BF) + l * FH, (bf16*)(ws + WS_H)); SEAM();
        cumsum_phase(F); REFRESH();
#if FAST_INPROJ
        { pg8::Gemm g{(const bf16*)(ws + WS_H), (const bf16*)(ws + W_IN) + (size_t)l * 5632 * 1024, T, 5632, D}; pg8::StaticOrder S; S.init(T, 5632, F.G, bx);
          pg8::EpiInProj E{(bf16*)(ar + AR_U), (bf16*)(ar + AR_Q), (bf16*)(ar + AR_K), (bf16*)(ar + AR_V), (bf16*)(ar + AR_G), (float*)(ar + AR_MQ), INP(I_FQG) + l * FD, INP(I_FKG) + l * FD};
          pg8::gemm_phase<pg8::EpiInProj, pg8::StaticOrder, true, true>(ring, g, S, E, F.tid); }
#else
        n_inproj(F, INP(I_WIN) + (size_t)l * D * NIN, INP(I_FQG) + l * FD, INP(I_FKG) + l * FD);
#endif
        SEAM();
        pool_phase(F); REFRESH();
        n_memattn(F, l, INP(I_MQG) + l * MD); REFRESH();
        n_fox(F); SEAM();
#if FAST_MERGE
        { pg8::Gemm g{nullptr, nullptr, T, 1024, 512}; typedef pg8::MergeOrder<AR_PD, (FAST_FOX ? AR_Q : AR_FO), AR_MO> MOrd; MOrd S; S.so.init(T, 1024, F.G, bx);
          S.arena = (const char*)ar; S.Bbase = (const char*)(ws + W_BR) + (size_t)(l * 3) * 1024 * 512 * 2;
          pg8::EpiMerge E{(const bf16*)(ar + AR_G), (bf16*)(ws + WS_H)};
          pg8::gemm_phase<pg8::EpiMerge, MOrd, true, true>(ring, g, S, E, F.tid); }
#else
        n_poolo(F, INP(I_POOLW) + (size_t)l * 4 * 128 * 128, INP(I_POOLS) + l * 512); SEAM();
        n_merge(F, INP(I_WPBR) + (size_t)l * 512 * D, INP(I_WFBR) + (size_t)l * 512 * D, INP(I_WMBR) + (size_t)l * 512 * D);
#endif
        SEAM();
#if FAST_WOUT
        { pg8::Gemm g{(const bf16*)(ws + WS_H), (const bf16*)(ws + W_OUT) + (size_t)l * 1024 * 1024, T, 1024, D}; pg8::StaticOrder S; S.init(T, 1024, F.G, bx);
          pg8::EpiF32 E{F.X, 1024, xin};
          pg8::gemm_phase<pg8::EpiF32, pg8::StaticOrder, true, true>(ring, g, S, E, F.tid); }
#else
        n_resgemm(F, xin, (const bf16*)(ws + WS_H), D, INP(I_WOUT) + (size_t)l * D * D);
#endif
        SEAM();
        if (l == 0) {
            norm_phase<0>(F, F.X, INP(I_FFNG) + l * D, nullptr, 0, nullptr, (bf16*)(ws + WS_H)); SEAM();
#if FAST_FFN
            { pg8::Gemm g{(const bf16*)(ws + WS_H), (const bf16*)(ws + W_GU), T, 2 * DFF, D}; pg8::StaticOrder S; S.init(T, 2 * DFF, F.G, bx);
              pg8::EpiSwiGLU E{(bf16*)(ar + AR_ACT), DFF};
              pg8::gemm_phase<pg8::EpiSwiGLU, pg8::StaticOrder, true, true>(ring, g, S, E, F.tid); }
            SEAM();
            { pg8::Gemm g{(const bf16*)(ar + AR_ACT), (const bf16*)(ws + W_DN), T, 1024, DFF}; pg8::StaticOrder S; S.init(T, 1024, F.G, bx);
              pg8::EpiF32 E{F.X, 1024, F.X};
              pg8::gemm_phase<pg8::EpiF32, pg8::StaticOrder, true, true>(ring, g, S, E, F.tid); }
            SEAM();
#else
            n_ffn_up(F, INP(I_WGU), DFF, -1); SEAM();
            n_ffn_down(F, INP(I_WDN), DFF, -1); SEAM();
#endif
        } else {
#if FAST_MOE
            norm_phase<2>(F, F.X, INP(I_FFNG) + l * D, INP(I_WR), NE, INP(I_BR), (bf16*)(ws + WS_H2)); SEAM();
            moe_scatter_phase(F, (const bf16*)(ws + WS_H2)); SEAM();
            const int ntile = __builtin_amdgcn_readfirstlane(((const int*)(ws + WS_META))[0]); const int* tile_e = (const int*)(ws + WS_META) + 16;
            { pg8::Gemm g{(const bf16*)(ws + WS_HS), (const bf16*)(ws + W_EGU), ntile * 256, 2 * DEXP, D}; pg8::GroupedOrder S; S.so.init(ntile * 256, 2 * DEXP, F.G, bx); S.tile_e = tile_e; S.bstride = (size_t)2 * DEXP * D * 2;
              pg8::EpiSwiGLU E{(bf16*)(ws + WS_ACTE), DEXP};
              pg8::gemm_phase<pg8::EpiSwiGLU, pg8::GroupedOrder, true, true>(ring, g, S, E, F.tid); }
            SEAM();
            { pg8::Gemm g{(const bf16*)(ws + WS_ACTE), (const bf16*)(ws + W_EDN), ntile * 256, 1024, DEXP}; pg8::GroupedOrder S; S.so.init(ntile * 256, 1024, F.G, bx); S.tile_e = tile_e; S.bstride = (size_t)DEXP * D * 2;
              pg8::EpiBf16P E{(bf16*)(ws + WS_YB), 1024};
              pg8::gemm_phase<pg8::EpiBf16P, pg8::GroupedOrder, true, true>(ring, g, S, E, F.tid); }
            SEAM();
            moe_combine_phase(F);
#else
            norm_phase<2>(F, F.X, INP(I_FFNG) + l * D, INP(I_WR), NE, INP(I_BR), (bf16*)(ws + WS_H)); SEAM();
#pragma unroll 1
            for (int e = 0; e < NE; ++e) {
                n_ffn_up(F, INP(I_WEGU) + (size_t)e * D * 2 * DEXP, DEXP, e); SEAM();
                n_ffn_down(F, INP(I_WEDN) + (size_t)e * DEXP * D, DEXP, e); SEAM();
            }
#endif
        }
    }
}

extern "C" void kernel_launch(void* const* d_in, const int* in_sizes, int n_in, void* d_out, int out_size, void* d_ws, size_t ws_size, hipStream_t stream) {
    static int grid = 0;
    if (grid == 0) {
        if (n_in != N_IN_ || in_sizes[0] != T * D || out_size != T * D || ws_size < WS_END) {
            fprintf(stderr, "kernel_launch: unexpected shapes: n_in %d in0 %d out %d ws %zu (need %zu)\n", n_in, n_in > 0 ? in_sizes[0] : -1, out_size, ws_size, (size_t)WS_END); grid = -1; return; }
        int dev = 0, cus = 0, per_cu = 0;
        if (hipGetDevice(&dev) != hipSuccess || hipDeviceGetAttribute(&cus, hipDeviceAttributeMultiprocessorCount, dev) != hipSuccess) { grid = -1; return; }
        if (hipFuncSetAttribute((const void*)mk_fwd, hipFuncAttributeMaxDynamicSharedMemorySize, LDS_BYTES) != hipSuccess) { fprintf(stderr, "kernel_launch: hipFuncSetAttribute failed\n"); grid = -1; return; }
        if (hipOccupancyMaxActiveBlocksPerMultiprocessor(&per_cu, (const void*)mk_fwd, NTHREADS, LDS_BYTES) != hipSuccess || per_cu < 1) { fprintf(stderr, "kernel_launch: occupancy query says %d\n", per_cu); }
        (void)hipGetLastError();
        if (cus < 256) { fprintf(stderr, "kernel_launch: built for 256 CUs, found %d\n", cus); grid = -1; return; }
        grid = 256;
    }
    if (grid < 0) return;
    if (hipMemsetAsync((char*)d_ws + WS_CTL, 0, CTL_ZERO_BYTES, stream) != hipSuccess) return;
    Args a{};
    for (int i = 0; i < N_IN_; ++i) a.in[i] = (const float*)d_in[i];
    a.out = (float*)d_out; a.ws = (unsigned char*)d_ws; a.ph_lo = 0; a.ph_hi = 0;
    hipLaunchKernelGGL(mk_fwd, dim3(grid), dim3(NTHREADS), LDS_BYTES, stream, a);
}
```

```cpp
#include <hip/hip_runtime.h>
#include <hip/hip_bf16.h>
#include <cstdio>
#include <cstdint>

constexpr int D = 1024, BATCH = 8, SEQ = 4096, T = BATCH * SEQ, DEPTH = 2;
constexpr int NMEM = 256, MROWS = BATCH * NMEM;
constexpr int FH = 8, FD = 64, MH = 4, MD = 128;
constexpr int DFF = 2816, NE = 8, DEXP = 3584;
constexpr int OFF_POOL = 0, OFF_Q = 512, OFF_K = 1024, OFF_V = 1536, OFF_F = 2048, OFF_MQ = 2056, OFF_G = 2568, NIN = 5640;
constexpr float EPS = 1e-6f;
constexpr float LOG2E = 1.4426950408889634f;
constexpr float C2F = 0.125f * LOG2E;
constexpr float C2M = 0.08838834764831845f * LOG2E;
constexpr int NWAVES = 8, NTHREADS = 512;

enum { I_X = 0, I_MEM, I_MIXG, I_WIN, I_BF, I_FQG, I_FKG, I_POOLW, I_POOLS, I_MEMG, I_WKV, I_MQG, I_MKG, I_WPBR, I_WFBR, I_WMBR, I_WOUT, I_FFNG, I_WGU, I_WDN, I_WR, I_BR, I_WEGU, I_WEDN, N_IN_ };

constexpr size_t MiB = 1u << 20;
constexpr size_t WS_CTL = 0, CTL_ZERO_BYTES = 1 * MiB;
constexpr size_t WS_LOGF = 1 * MiB, WS_CL = 2 * MiB, WS_CHOICE = 3 * MiB, WS_WCNT = 3 * MiB + 512 * 1024;
constexpr size_t WS_W = 8 * MiB;
constexpr size_t WS_MEMN = 232 * MiB, WS_KVF = 240 * MiB, WS_KM = 256 * MiB, WS_VM = 260 * MiB;
constexpr size_t WS_H = 264 * MiB;
constexpr size_t WS_AR = 328 * MiB;
constexpr size_t AR_U = 0, AR_Q = 32 * MiB, AR_K = 64 * MiB, AR_V = 96 * MiB, AR_MQ = 128 * MiB, AR_G = 192 * MiB, AR_PD = 384 * MiB, AR_MO = 416 * MiB, AR_PO = 448 * MiB, AR_FO = 480 * MiB;
constexpr size_t AR_ACT = 0;
constexpr size_t WS_END = 896 * MiB;

constexpr int CW_TMO = 0, CW_CODE = 1, CW_BAR = 4096;

#define GAS __attribute__((address_space(1)))
#define LAS __attribute__((address_space(3)))
typedef unsigned short bf16;
typedef unsigned v4u __attribute__((ext_vector_type(4)));
typedef unsigned v2u __attribute__((ext_vector_type(2)));
typedef float f32x4 __attribute__((ext_vector_type(4)));
typedef GAS unsigned gu32;
#define RLX_AGENT __ATOMIC_RELAXED, __HIP_MEMORY_SCOPE_AGENT
__device__ __forceinline__ float bf2f(unsigned v) { return __uint_as_float(v << 16); }
__device__ __forceinline__ unsigned f2bf(float f) { unsigned u = __float_as_uint(f); return (u + 0x7fffu + ((u >> 16) & 1u)) >> 16; }
__device__ __forceinline__ unsigned pk2(float lo, float hi) { return f2bf(lo) | (f2bf(hi) << 16); }
__device__ __forceinline__ float shx(float v, int mask, int lane) { return __int_as_float(__builtin_amdgcn_ds_bpermute((lane ^ mask) << 2, __float_as_int(v))); }
__device__ __forceinline__ int shxi(int v, int mask, int lane) { return __builtin_amdgcn_ds_bpermute((lane ^ mask) << 2, v); }
__device__ __forceinline__ float shl(float v, int src) { return __int_as_float(__builtin_amdgcn_ds_bpermute(src << 2, __float_as_int(v))); }
__device__ __forceinline__ int shli(int v, int src) { return __builtin_amdgcn_ds_bpermute(src << 2, v); }
__device__ __forceinline__ float wave_sum(float v, int lane) {
#pragma unroll
    for (int o = 1; o < 64; o <<= 1) v += shx(v, o, lane);
    return v;
}
__device__ __forceinline__ float log_sigmoid_f(float x) { return fminf(x, 0.f) - 0.6931471805599453f * __builtin_amdgcn_logf(1.0f + __builtin_amdgcn_exp2f(fabsf(x) * -1.4426950408889634f)); }
__device__ __forceinline__ float sigmoid_f(float x) { return 1.0f / (1.0f + expf(-x)); }

#define XB_TMO      128
#define XB_XCNT(j)  (256  + 64 * (j))
#define XB_XSUB(j)  (1280 + 64 * (j))
#define XB_XGEN(j)  (2304 + 64 * (j))
#define XB_TOP      3328
#define XB_TOPGEN   3392
#define XCD_BAR_WORDS 3456
#define XB_SPIN_CAP (1u << 22)

__device__ __forceinline__ unsigned xb_ld(unsigned* p)              { return __hip_atomic_load(p, __ATOMIC_RELAXED, __HIP_MEMORY_SCOPE_AGENT); }
__device__ __forceinline__ unsigned xb_add(unsigned* p, unsigned v) { return __hip_atomic_fetch_add(p, v, __ATOMIC_RELAXED, __HIP_MEMORY_SCOPE_AGENT); }
__device__ __forceinline__ unsigned xb_xcc_id() { return (unsigned)__builtin_amdgcn_s_getreg((3 << 11) | 20) & 0xFu; }
#define XB_SPIN(cond, bar) do { unsigned _sp = 0; while (cond) { __builtin_amdgcn_s_sleep(1); \
    if ((++_sp & 255u) == 0u) { if (xb_ld(&(bar)[XB_TMO])) break; if (_sp > XB_SPIN_CAP) { atomicAdd(&(bar)[XB_TMO], 1u); break; } } } } while (0)

struct XcdBarrier { unsigned* bar; unsigned x; volatile LAS unsigned* st; };

__device__ __forceinline__ XcdBarrier xcd_barrier_post(unsigned* bar, volatile LAS unsigned* st) {
    XcdBarrier b; b.bar = bar; b.x = xb_xcc_id(); b.st = st;
    if (threadIdx.x == 0) (void)xb_add(&bar[XB_XCNT(b.x)], 1u);
    return b;
}
__device__ __forceinline__ void xcd_barrier_complete(unsigned* bar, unsigned x, unsigned& nloc, unsigned& nx) {
    const unsigned G = gridDim.x * gridDim.y * gridDim.z;
    unsigned sum, cnt, mine, sp = 0u;
    for (;;) {
        sum = 0u; cnt = 0u; mine = 0u;
#pragma unroll
        for (unsigned j = 0; j < 16; ++j) { const unsigned c = xb_ld(&bar[XB_XCNT(j)]); sum += c; cnt += (c > 0u) ? 1u : 0u; mine = (j == x) ? c : mine; }
        if (sum == G) break;
        __builtin_amdgcn_s_sleep(1);
        if ((++sp & 255u) == 0u) { if (xb_ld(&bar[XB_TMO])) break; if (sp > XB_SPIN_CAP) { atomicAdd(&bar[XB_TMO], 1u); break; } }
    }
    nloc = mine > 0u ? mine : 1u; nx = cnt > 0u ? cnt : 1u;
}
__device__ __forceinline__ void xcd_barrier(const XcdBarrier& b) {
    asm volatile("s_waitcnt vmcnt(0)" ::: "memory");
    __syncthreads();
    if (threadIdx.x == 0) {
        unsigned* bar = b.bar;
        __builtin_amdgcn_s_waitcnt(0);
        unsigned nloc = b.st[0], nx = b.st[1];
        if (nloc == 0u) { xcd_barrier_complete(bar, b.x, nloc, nx); b.st[0] = nloc; b.st[1] = nx; }
        const unsigned old = xb_add(&bar[XB_XSUB(b.x)], 1u);
        const unsigned gen = old / nloc;
        if (old + 1u == (gen + 1u) * nloc) {
            __builtin_amdgcn_fence(__ATOMIC_RELEASE, "agent");
            asm volatile("s_waitcnt vmcnt(0)" ::: "memory");
            const unsigned og = xb_add(&bar[XB_TOP], 1u);
            const unsigned tg = og / nx;
            if (og + 1u == (tg + 1u) * nx) xb_add(&bar[XB_TOPGEN], 1u);
            else XB_SPIN(xb_ld(&bar[XB_TOPGEN]) == tg, bar);
            __builtin_amdgcn_fence(__ATOMIC_ACQUIRE, "agent");
            xb_add(&bar[XB_XGEN(b.x)], 1u);
            asm volatile("s_waitcnt vmcnt(0)" ::: "memory");
        } else {
            XB_SPIN(xb_ld(&bar[XB_XGEN(b.x)]) == gen, bar);
            __builtin_amdgcn_fence(__ATOMIC_ACQUIRE, "agent");
            asm volatile("s_waitcnt vmcnt(0)" ::: "memory");
        }
    }
    __syncthreads();
}

constexpr int RING_OFF = 0, RING_BYTES = 131072;
constexpr int LDSCTL_OFF = RING_BYTES, MISC_OFF = LDSCTL_OFF + 320;
constexpr int LDS_BYTES = 147456;

struct Args { const float* in[N_IN_]; float* out; unsigned char* ws; int ph_lo, ph_hi; };
struct Frame {
    LAS unsigned char* lds; volatile LAS unsigned* MISC; gu32* ctl;
    int tid, lane, wave, vcu, G;
    float* X; unsigned char* ws;
};
struct Choice { int e1, e2; float w1, w2; };
constexpr int PTR_OFF = LDSCTL_OFF + 1024;
__device__ __forceinline__ const float* inptr(const Frame& F, int i) {
    int z = 0; asm volatile("" : "+v"(z));
    const volatile LAS unsigned* p = (const volatile LAS unsigned*)(F.lds + PTR_OFF + z) + 2 * i;
    const unsigned lo = __builtin_amdgcn_readfirstlane(p[0]), hi = __builtin_amdgcn_readfirstlane(p[1]);
    return (const float*)(const GAS float*)(uintptr_t)(((unsigned long long)hi << 32) | lo);
}

template <int MODE>
__device__ __forceinline__ void norm_phase(Frame& F, const float* xin, const float* g, const float* W8, int ldw8, const float* b8, bf16* Hout) {
    const int lane = F.lane, gw = F.vcu * NWAVES + F.wave, NGW = F.G * NWAVES;
    f32x4 gv[4];
#pragma unroll
    for (int j = 0; j < 4; ++j) gv[j] = *(const f32x4*)(g + 256 * j + 4 * lane);
    LAS f32x4* tab = (LAS f32x4*)(F.lds + RING_OFF);
    if (MODE != 0) {
        for (int q = F.tid; q < 2048; q += NTHREADS) { const int ln = q & 63, hf = (q >> 6) & 1, ji = q >> 7; const int k = 256 * (ji >> 2) + 4 * ln + (ji & 3);
            tab[q] = *(const f32x4*)(W8 + (size_t)k * ldw8 + 4 * hf); }
        __syncthreads();
    }
    int cnt[8];
#pragma unroll
    for (int e = 0; e < 8; ++e) cnt[e] = 0;
    for (int m = gw; m < T; m += NGW) {
        const f32x4* xr = (const f32x4*)(xin + (size_t)m * D) + lane;
        f32x4 v[4]; float ss = 0.f;
#pragma unroll
        for (int j = 0; j < 4; ++j) { v[j] = xr[64 * j]; ss += (v[j][0] * v[j][0] + v[j][1] * v[j][1]) + (v[j][2] * v[j][2] + v[j][3] * v[j][3]); }
        ss = wave_sum(ss, lane);
        const float rstd = 1.0f / sqrtf(ss * (1.0f / D) + EPS);
        unsigned long long* o8 = (unsigned long long*)(Hout + (size_t)m * D) + lane;
#pragma unroll
        for (int j = 0; j < 4; ++j) { v[j] = v[j] * rstd * gv[j]; o8[64 * j] = (unsigned long long)pk2(v[j][0], v[j][1]) | ((unsigned long long)pk2(v[j][2], v[j][3]) << 32); }
        if (MODE != 0) {
            float p[8];
#pragma unroll
            for (int e = 0; e < 8; ++e) p[e] = 0.f;
#pragma unroll
            for (int j = 0; j < 4; ++j)
#pragma unroll
                for (int i = 0; i < 4; ++i) { const f32x4 wa = tab[((j * 4 + i) * 2 + 0) * 64 + lane], wb = tab[((j * 4 + i) * 2 + 1) * 64 + lane]; const float hv = v[j][i];
                    p[0] = fmaf(hv, wa[0], p[0]); p[1] = fmaf(hv, wa[1], p[1]); p[2] = fmaf(hv, wa[2], p[2]); p[3] = fmaf(hv, wa[3], p[3]);
                    p[4] = fmaf(hv, wb[0], p[4]); p[5] = fmaf(hv, wb[1], p[5]); p[6] = fmaf(hv, wb[2], p[6]); p[7] = fmaf(hv, wb[3], p[7]);
                    if (i == 3) asm volatile("" ::: "memory"); }
            float k4[4];
            { const bool hi = (lane & 32) != 0;
#pragma unroll
              for (int i = 0; i < 4; ++i) { const float keep = hi ? p[4 + i] : p[i], send = hi ? p[i] : p[4 + i]; k4[i] = keep + shx(send, 32, lane); } }
            float k2[2];
            { const bool hi = (lane & 16) != 0;
#pragma unroll
              for (int i = 0; i < 2; ++i) { const float keep = hi ? k4[2 + i] : k4[i], send = hi ? k4[i] : k4[2 + i]; k2[i] = keep + shx(send, 16, lane); } }
            float k1;
            { const bool hi = (lane & 8) != 0; const float keep = hi ? k2[1] : k2[0], send = hi ? k2[0] : k2[1]; k1 = keep + shx(send, 8, lane); }
            k1 += shx(k1, 4, lane); k1 += shx(k1, 2, lane); k1 += shx(k1, 1, lane);
            const int e_mine = ((lane >> 5) & 1) * 4 + ((lane >> 4) & 1) * 2 + ((lane >> 3) & 1);
            const float val = k1 + b8[e_mine];
            if (MODE == 1) {
                if ((lane & 7) == 0) { const int b = m / SEQ, s = m % SEQ; ((float*)(F.ws + WS_LOGF))[(size_t)(b * FH + e_mine) * SEQ + s] = log_sigmoid_f(val); }
            } else {
                float lg[8];
#pragma unroll
                for (int e = 0; e < 8; ++e) lg[e] = shl(val, ((e >> 2) & 1) * 32 + ((e >> 1) & 1) * 16 + (e & 1) * 8);
                float b1 = -INFINITY, b2 = -INFINITY; int i1 = 0, i2 = 0;
#pragma unroll
                for (int e = 0; e < 8; ++e) { if (lg[e] > b1) { b2 = b1; i2 = i1; b1 = lg[e]; i1 = e; } else if (lg[e] > b2) { b2 = lg[e]; i2 = e; } }
                const float ex = __builtin_amdgcn_exp2f((b2 - b1) * 1.4426950408889634f), w1 = 1.0f / (1.0f + ex), w2 = ex / (1.0f + ex);
                if (lane == 0) { Choice c; c.e1 = i1; c.e2 = i2; c.w1 = w1; c.w2 = w2; ((Choice*)(F.ws + WS_CHOICE))[m] = c; }
#pragma unroll
                for (int e = 0; e < 8; ++e) cnt[e] += (i1 == e) + (i2 == e);
            }
        }
    }
    if (MODE != 0) __syncthreads();
    if (MODE == 2) {
        int mine = 0;
#pragma unroll
        for (int e = 0; e < 8; ++e) mine = (lane == e) ? cnt[e] : mine;
        if (lane < 8) ((int*)(F.ws + WS_WCNT))[gw * 8 + lane] = mine;
    }
}

__device__ __forceinline__ void cumsum_phase(Frame& F) {
    if (F.vcu >= BATCH * FH || F.wave != 0) return;
    const float* lf = (const float*)(F.ws + WS_LOGF) + (size_t)F.vcu * SEQ + 64 * F.lane;
    float* cl = (float*)(F.ws + WS_CL) + (size_t)F.vcu * SEQ + 64 * F.lane;
    double tot = 0.0;
    for (int i = 0; i < 64; ++i) tot += (double)lf[i];
    double inc = tot;
#pragma unroll
    for (int o = 1; o < 64; o <<= 1) { const int src = (F.lane >= o ? F.lane - o : F.lane); const unsigned long long bits = __builtin_bit_cast(unsigned long long, inc);
        const unsigned lo_ = (unsigned)shli((int)(unsigned)bits, src), hi_ = (unsigned)shli((int)(unsigned)(bits >> 32), src); const double t = __builtin_bit_cast(double, ((unsigned long long)hi_ << 32) | lo_); if (F.lane >= o) inc += t; }
    double run = inc - tot;
    for (int i = 0; i < 64; ++i) { run += (double)lf[i]; cl[i] = (float)(run * 1.4426950408889634); }
}

__device__ __forceinline__ void pool_phase(Frame& F) {
    const bf16* U = (const bf16*)(F.ws + WS_AR + AR_U); bf16* PD = (bf16*)(F.ws + WS_AR + AR_PD);
    const int lane = F.lane, gw = F.vcu * NWAVES + F.wave, NGW = F.G * NWAVES;
    const int w = 2 << (lane >> 4);
    for (int m = gw; m < T; m += NGW) {
        const int t = m % SEQ; const int n = (t + 1 < w) ? (t + 1) : w;
        float s[8];
#pragma unroll
        for (int i = 0; i < 8; ++i) s[i] = 0.f;
        v4u cur = (v4u){0u, 0u, 0u, 0u};
        for (int j = 0; j < n; ++j) { const v4u x = *(const v4u*)(U + (size_t)(m - j) * 512 + 8 * lane); if (j == 0) cur = x;
#pragma unroll
            for (int i = 0; i < 4; ++i) { s[2 * i] += bf2f(x[i] & 0xffffu); s[2 * i + 1] += bf2f(x[i] >> 16); } }
        const float inv = 1.0f / (float)n; v4u o;
#pragma unroll
        for (int i = 0; i < 4; ++i) o[i] = pk2(s[2 * i] * inv - bf2f(cur[i] & 0xffffu), s[2 * i + 1] * inv - bf2f(cur[i] >> 16));
        *(v4u*)(PD + (size_t)m * 512 + 8 * lane) = o;
    }
}

__device__ __forceinline__ void memnorm_phase(Frame& F, const float* mem, const float* memg) {
    const int lane = F.lane, gw = F.vcu * NWAVES + F.wave, NGW = F.G * NWAVES;
    for (int it = gw; it < DEPTH * MROWS; it += NGW) {
        const int l = it / MROWS, r = it % MROWS;
        const f32x4* xr = (const f32x4*)(mem + (size_t)r * D) + lane; const float* g = memg + l * D;
        f32x4 v[4]; float ss = 0.f;
#pragma unroll
        for (int j = 0; j < 4; ++j) { v[j] = xr[64 * j]; ss += (v[j][0] * v[j][0] + v[j][1] * v[j][1]) + (v[j][2] * v[j][2] + v[j][3] * v[j][3]); }
        ss = wave_sum(ss, lane); const float rstd = 1.0f / sqrtf(ss * (1.0f / D) + EPS);
        unsigned long long* o8 = (unsigned long long*)((bf16*)(F.ws + WS_MEMN) + (size_t)it * D) + lane;
#pragma unroll
        for (int j = 0; j < 4; ++j) { const f32x4 h = v[j] * rstd * *(const f32x4*)(g + 256 * j + 4 * lane); o8[64 * j] = (unsigned long long)pk2(h[0], h[1]) | ((unsigned long long)pk2(h[2], h[3]) << 32); }
    }
}
__device__ __forceinline__ void kvfin_phase(Frame& F, const float* mkg) {
    const int lane = F.lane, gw = F.vcu * NWAVES + F.wave, NGW = F.G * NWAVES;
    for (int it = gw; it < DEPTH * MROWS; it += NGW) {
        const int l = it / MROWS;
        const f32x4* xr = (const f32x4*)((const float*)(F.ws + WS_KVF) + (size_t)it * 1024) + lane;
        f32x4 v[4];
#pragma unroll
        for (int j = 0; j < 4; ++j) v[j] = xr[64 * j];
        unsigned long long* ok = (unsigned long long*)((bf16*)(F.ws + WS_KM) + (size_t)it * 512) + lane;
        unsigned long long* ov = (unsigned long long*)((bf16*)(F.ws + WS_VM) + (size_t)it * 512) + lane;
#pragma unroll
        for (int j = 0; j < 2; ++j) {
            float ss = (v[j][0] * v[j][0] + v[j][1] * v[j][1]) + (v[j][2] * v[j][2] + v[j][3] * v[j][3]);
#pragma unroll
            for (int o = 1; o < 32; o <<= 1) ss += shx(ss, o, lane);
            const float rstd = 1.0f / sqrtf(ss * (1.0f / MD) + EPS);
            const f32x4 gg = *(const f32x4*)(mkg + l * MD + 4 * (lane & 31));
            const f32x4 h = v[j] * rstd * gg; ok[64 * j] = (unsigned long long)pk2(h[0], h[1]) | ((unsigned long long)pk2(h[2], h[3]) << 32);
        }
#pragma unroll
        for (int j = 0; j < 2; ++j) { const f32x4 h = v[2 + j]; ov[64 * j] = (unsigned long long)pk2(h[0], h[1]) | ((unsigned long long)pk2(h[2], h[3]) << 32); }
    }
}

__device__ __forceinline__ void rb2(float (&acc)[16], const bf16* A, int lda, int K, const float* W, int ldw) {
    for (int k = 0; k < K; k += 8) {
        float w[8];
#pragma unroll
        for (int kk = 0; kk < 8; ++kk) w[kk] = W[(size_t)(k + kk) * ldw];
#pragma unroll
        for (int r = 0; r < 16; ++r) { const v4u a = *(const v4u*)(A + (size_t)r * lda + k);
#pragma unroll
            for (int i = 0; i < 4; ++i) { acc[r] = fmaf(bf2f(a[i] & 0xffffu), w[2 * i], acc[r]); acc[r] = fmaf(bf2f(a[i] >> 16), w[2 * i + 1], acc[r]); } }
    }
}
#define WITEM_LOOP(NRG, NBLK) for (long it_ = (long)F.vcu * NWAVES + F.wave; it_ < (long)(NRG) * (NBLK); it_ += (long)F.G * NWAVES)
#define WITEM_RB(NRG, row0, blk) const int row0 = 16 * (int)(it_ % (NRG)); const int blk = (int)(it_ / (NRG))
#define ZERO16(a) _Pragma("unroll") for (int r_ = 0; r_ < 16; ++r_) a[r_] = 0.f

__device__ __forceinline__ void n_inproj(Frame& F, const float* win, const float* fqg, const float* fkg) {
    const bf16* H = (const bf16*)(F.ws + WS_H); unsigned char* ar = F.ws + WS_AR; const int lane = F.lane;
    WITEM_LOOP(T / 16, 88) { WITEM_RB(T / 16, row0, blk);
        float acc[16]; ZERO16(acc);
        const int col0 = blk < 32 ? 64 * blk : (blk < 40 ? OFF_MQ + 64 * (blk - 32) : OFF_G + 64 * (blk - 40));
        rb2(acc, H + (size_t)row0 * D, D, D, win + col0 + lane, NIN);
        if (blk < 8) { bf16* o = (bf16*)(ar + AR_U) + (size_t)row0 * 512 + 64 * blk + lane;
#pragma unroll
            for (int r = 0; r < 16; ++r) o[(size_t)r * 512] = (bf16)f2bf(acc[r]); }
        else if (blk < 24) { const bool isq = blk < 16; const int h = isq ? blk - 8 : blk - 16; const float gg = (isq ? fqg : fkg)[lane] * (isq ? C2F : 1.0f);
            bf16* o = (bf16*)(ar + (isq ? AR_Q : AR_K)) + (size_t)row0 * 512 + 64 * h + lane;
#pragma unroll
            for (int r = 0; r < 16; ++r) { const float ss = wave_sum(acc[r] * acc[r], lane); const float rstd = 1.0f / sqrtf(ss * (1.0f / FD) + EPS); o[(size_t)r * 512] = (bf16)f2bf(acc[r] * rstd * gg); } }
        else if (blk < 32) { bf16* o = (bf16*)(ar + AR_V) + (size_t)row0 * 512 + 64 * (blk - 24) + lane;
#pragma unroll
            for (int r = 0; r < 16; ++r) o[(size_t)r * 512] = (bf16)f2bf(acc[r]); }
        else if (blk < 40) { float* o = (float*)(ar + AR_MQ) + (size_t)row0 * 512 + 64 * (blk - 32) + lane;
#pragma unroll
            for (int r = 0; r < 16; ++r) o[(size_t)r * 512] = acc[r]; }
        else { bf16* o = (bf16*)(ar + AR_G) + (size_t)row0 * 3072 + 64 * (blk - 40) + lane;
#pragma unroll
            for (int r = 0; r < 16; ++r) o[(size_t)r * 3072] = (bf16)f2bf(sigmoid_f(acc[r])); }
    }
}
__device__ __forceinline__ void n_memkv(Frame& F, const float* wkv) {
    const int lane = F.lane;
    WITEM_LOOP(DEPTH * MROWS / 16, 16) { WITEM_RB(DEPTH * MROWS / 16, row0, blk);
        const int l = row0 / MROWS;
        float acc[16]; ZERO16(acc);
        rb2(acc, (const bf16*)(F.ws + WS_MEMN) + (size_t)row0 * D, D, D, wkv + (size_t)l * D * 1024 + 64 * blk + lane, 1024);
        float* o = (float*)(F.ws + WS_KVF) + (size_t)row0 * 1024 + 64 * blk + lane;
#pragma unroll
        for (int r = 0; r < 16; ++r) o[(size_t)r * 1024] = acc[r];
    }
}
__device__ __forceinline__ void n_poolo(Frame& F, const float* pw, const float* ps) {
    const bf16* PD = (const bf16*)(F.ws + WS_AR + AR_PD); bf16* PO = (bf16*)(F.ws + WS_AR + AR_PO); const int lane = F.lane;
    WITEM_LOOP(T / 16, 8) { WITEM_RB(T / 16, row0, blk);
        const int g = blk >> 1, c0 = (blk & 1) * 64;
        float acc[16]; ZERO16(acc);
        rb2(acc, PD + (size_t)row0 * 512 + g * 128, 512, 128, pw + (size_t)g * 128 * 128 + c0 + lane, 128);
        const float sc = ps[g * 128 + c0 + lane]; bf16* o = PO + (size_t)row0 * 512 + g * 128 + c0 + lane;
#pragma unroll
        for (int r = 0; r < 16; ++r) o[(size_t)r * 512] = (bf16)f2bf(acc[r] * sc);
    }
}
__device__ __forceinline__ void n_fox(Frame& F) {
    bf16* Q = (bf16*)(F.ws + WS_AR + AR_Q); const bf16* K = (const bf16*)(F.ws + WS_AR + AR_K); const bf16* V = (const bf16*)(F.ws + WS_AR + AR_V);
    bf16* FO = (bf16*)(F.ws + WS_AR + AR_FO);
    const float* CL = (const float*)(F.ws + WS_CL);
    for (long it_ = (long)F.vcu * NTHREADS + F.tid; it_ < (long)BATCH * FH * SEQ * 2; it_ += (long)F.G * NTHREADS) {
        const int hf = (int)((it_ / SEQ) & 1), bh = (int)(it_ / (2 * SEQ)), qi = (int)(it_ % SEQ); const int b = bh / FH, h = bh % FH;
        float q[64], o[32];
        { const bf16* qp = Q + ((size_t)b * SEQ + qi) * 512 + h * 64;
#pragma unroll
          for (int c = 0; c < 64; c += 8) { const v4u x = *(const v4u*)(qp + c);
#pragma unroll
            for (int i = 0; i < 4; ++i) { q[c + 2 * i] = bf2f(x[i] & 0xffffu); q[c + 2 * i + 1] = bf2f(x[i] >> 16); } } }
#pragma unroll
        for (int c = 0; c < 32; ++c) o[c] = 0.f;
        float mx = -INFINITY, l = 0.f; const float clq = CL[(size_t)bh * SEQ + qi];
        const int jend = __builtin_amdgcn_readfirstlane(qi | 63);
        for (int j = 0; j <= jend; ++j) {
            const bf16* kp = K + ((size_t)b * SEQ + j) * 512 + h * 64; const bf16* vp = V + ((size_t)b * SEQ + j) * 512 + h * 64 + hf * 32;
            float s = 0.f;
#pragma unroll
            for (int c = 0; c < 64; c += 8) { const v4u x = *(const v4u*)(kp + c);
#pragma unroll
                for (int i = 0; i < 4; ++i) { s = fmaf(q[c + 2 * i], bf2f(x[i] & 0xffffu), s); s = fmaf(q[c + 2 * i + 1], bf2f(x[i] >> 16), s); } }
            asm volatile("" ::: "memory");
            s += clq - CL[(size_t)bh * SEQ + j];
            if (j <= qi) {
                const float mn = fmaxf(mx, s), sc = exp2f(mx - mn), p = exp2f(s - mn);
                l = l * sc + p; mx = mn;
#pragma unroll
                for (int c = 0; c < 32; c += 8) { const v4u x = *(const v4u*)(vp + c);
#pragma unroll
                    for (int i = 0; i < 4; ++i) { o[c + 2 * i] = o[c + 2 * i] * sc + p * bf2f(x[i] & 0xffffu); o[c + 2 * i + 1] = o[c + 2 * i + 1] * sc + p * bf2f(x[i] >> 16); } }
            }
        }
        const float il = 1.0f / l;
        bf16* op = FO + ((size_t)b * SEQ + qi) * 512 + h * 64 + hf * 32;
#pragma unroll
        for (int c = 0; c < 32; c += 8) *(v4u*)(op + c) = (v4u){pk2(o[c] * il, o[c + 1] * il), pk2(o[c + 2] * il, o[c + 3] * il), pk2(o[c + 4] * il, o[c + 5] * il), pk2(o[c + 6] * il, o[c + 7] * il)};
    }
}
__device__ __forceinline__ void n_memattn(Frame& F, int l, const float* mqg) {
    const float* MQ = (const float*)(F.ws + WS_AR + AR_MQ); bf16* MO = (bf16*)(F.ws + WS_AR + AR_MO);
    const bf16* KM = (const bf16*)(F.ws + WS_KM) + (size_t)l * MROWS * 512; const bf16* VM = (const bf16*)(F.ws + WS_VM) + (size_t)l * MROWS * 512;
    LAS float* qs = (LAS float*)(F.lds + RING_OFF) + F.wave * 512; LAS float* psh = qs + 128; const int lane = F.lane;
    for (long it_ = (long)F.vcu * NWAVES + F.wave; it_ < (long)T * MH; it_ += (long)F.G * NWAVES) {
        const int row = (int)(it_ >> 2), head = (int)(it_ & 3), b = row / SEQ;
        const float x0 = MQ[(size_t)row * 512 + head * 128 + 2 * lane], x1 = MQ[(size_t)row * 512 + head * 128 + 2 * lane + 1];
        const float ss = wave_sum(x0 * x0 + x1 * x1, lane); const float rstd = 1.0f / sqrtf(ss * (1.0f / MD) + EPS) * C2M;
        qs[2 * lane] = x0 * rstd * mqg[2 * lane]; qs[2 * lane + 1] = x1 * rstd * mqg[2 * lane + 1];
        asm volatile("s_waitcnt lgkmcnt(0)" ::: "memory");
        float sc[4]; float mx = -INFINITY;
#pragma unroll
        for (int i = 0; i < 4; ++i) { const bf16* kp = KM + ((size_t)b * NMEM + lane + 64 * i) * 512 + head * 128; float s = 0.f;
#pragma unroll
            for (int c = 0; c < 128; c += 8) { const v4u x = *(const v4u*)(kp + c); const f32x4 qa = *(const LAS f32x4*)(qs + c), qb = *(const LAS f32x4*)(qs + c + 4);
                s = fmaf(qa[0], bf2f(x[0] & 0xffffu), s); s = fmaf(qa[1], bf2f(x[0] >> 16), s); s = fmaf(qa[2], bf2f(x[1] & 0xffffu), s); s = fmaf(qa[3], bf2f(x[1] >> 16), s);
                s = fmaf(qb[0], bf2f(x[2] & 0xffffu), s); s = fmaf(qb[1], bf2f(x[2] >> 16), s); s = fmaf(qb[2], bf2f(x[3] & 0xffffu), s); s = fmaf(qb[3], bf2f(x[3] >> 16), s); }
            sc[i] = s; mx = fmaxf(mx, s); }
#pragma unroll
        for (int o = 1; o < 64; o <<= 1) mx = fmaxf(mx, shx(mx, o, lane));
        float lsum = 0.f;
#pragma unroll
        for (int i = 0; i < 4; ++i) { const float p = exp2f(sc[i] - mx); lsum += p; psh[lane + 64 * i] = p; }
        lsum = wave_sum(lsum, lane);
        asm volatile("s_waitcnt lgkmcnt(0)" ::: "memory");
        float o0 = 0.f, o1 = 0.f;
        for (int j = 0; j < NMEM; ++j) { const unsigned vv = *(const unsigned*)(VM + ((size_t)b * NMEM + j) * 512 + head * 128 + 2 * lane); const float p = psh[j];
            o0 = fmaf(p, bf2f(vv & 0xffffu), o0); o1 = fmaf(p, bf2f(vv >> 16), o1); }
        const float il = 1.0f / lsum;
        *(unsigned*)(MO + (size_t)row * 512 + head * 128 + 2 * lane) = pk2(o0 * il, o1 * il);
        asm volatile("s_waitcnt lgkmcnt(0)" ::: "memory");
    }
}
__device__ __forceinline__ void n_merge(Frame& F, const float* wp, const float* wf, const float* wm) {
    unsigned char* ar = F.ws + WS_AR; const bf16* G = (const bf16*)(ar + AR_G); bf16* MG = (bf16*)(F.ws + WS_H); const int lane = F.lane;
    WITEM_LOOP(T / 16, 16) { WITEM_RB(T / 16, row0, blk);
        float m[16]; ZERO16(m);
#pragma unroll 1
        for (int b = 0; b < 3; ++b) {
            const bf16* A = (const bf16*)(ar + (b == 0 ? AR_PO : (b == 1 ? AR_FO : AR_MO))); const float* W = b == 0 ? wp : (b == 1 ? wf : wm);
            float acc[16]; ZERO16(acc);
            rb2(acc, A + (size_t)row0 * 512, 512, 512, W + 64 * blk + lane, D);
            const bf16* gp = G + (size_t)row0 * 3072 + b * 1024 + 64 * blk + lane;
#pragma unroll
            for (int r = 0; r < 16; ++r) m[r] = fmaf(bf2f(gp[(size_t)r * 3072]), acc[r], m[r]);
        }
        bf16* o = MG + (size_t)row0 * D + 64 * blk + lane;
#pragma unroll
        for (int r = 0; r < 16; ++r) o[(size_t)r * D] = (bf16)f2bf(m[r]);
    }
}
__device__ __forceinline__ void n_resgemm(Frame& F, const float* base, const bf16* A, int K, const float* W) {
    const int lane = F.lane;
    WITEM_LOOP(T / 16, 16) { WITEM_RB(T / 16, row0, blk);
        float acc[16]; ZERO16(acc);
        rb2(acc, A + (size_t)row0 * K, K, K, W + 64 * blk + lane, D);
        const float* bp = base + (size_t)row0 * D + 64 * blk + lane; float* op = F.X + (size_t)row0 * D + 64 * blk + lane;
#pragma unroll
        for (int r = 0; r < 16; ++r) op[(size_t)r * D] = bp[(size_t)r * D] + acc[r];
    }
}
__device__ __forceinline__ void n_ffn_up(Frame& F, const float* wgu, int FF, int e) {
    const bf16* H = (const bf16*)(F.ws + WS_H); bf16* ACT = (bf16*)(F.ws + WS_AR + AR_ACT); const int lane = F.lane;
    WITEM_LOOP(T / 16, FF / 64) { WITEM_RB(T / 16, row0, blk);
        float g[16], u[16]; ZERO16(g); ZERO16(u);
        rb2(g, H + (size_t)row0 * D, D, D, wgu + 64 * blk + lane, 2 * FF);
        rb2(u, H + (size_t)row0 * D, D, D, wgu + FF + 64 * blk + lane, 2 * FF);
        bf16* o = ACT + (size_t)row0 * FF + 64 * blk + lane;
#pragma unroll
        for (int r = 0; r < 16; ++r) o[(size_t)r * FF] = (bf16)f2bf(g[r] * sigmoid_f(g[r]) * u[r]);
    }
}
__device__ __forceinline__ void n_ffn_down(Frame& F, const float* wd, int FF, int e) {
    const bf16* ACT = (const bf16*)(F.ws + WS_AR + AR_ACT); const int lane = F.lane;
    WITEM_LOOP(T / 16, 16) { WITEM_RB(T / 16, row0, blk);
        float acc[16]; ZERO16(acc);
        rb2(acc, ACT + (size_t)row0 * FF, FF, FF, wd + 64 * blk + lane, D);
        float* op = F.X + (size_t)row0 * D + 64 * blk + lane;
#pragma unroll
        for (int r = 0; r < 16; ++r) { float comb = 1.0f;
            if (e >= 0) { const Choice c = ((const Choice*)(F.ws + WS_CHOICE))[row0 + r]; comb = (c.e1 == e) ? c.w1 : ((c.e2 == e) ? c.w2 : 0.f); }
            if (comb != 0.f) op[(size_t)r * D] += comb * acc[r]; }
    }
}

namespace pg8 {
#define PG8_LAS __attribute__((address_space(3)))
typedef unsigned short bf16_t;
typedef short bf16x8 __attribute__((ext_vector_type(8)));
typedef float f32x4 __attribute__((ext_vector_type(4)));
typedef unsigned u32x4 __attribute__((ext_vector_type(4)));
constexpr int BM = 256, BK = 64, HALF = 128, HTB = HALF * BK * 2  , STAGE_BYTES = 8 * HTB, NXCD = 8, WGM = 8;

__host__ __device__ __forceinline__ int lds_byte(int r, int c) { const int st = (r >> 4) * 2 + (c >> 5), rr = r & 15, cc = c & 31, ob = rr * 64 + cc * 2; return st * 1024 + (ob ^ (((ob >> 9) & 1) << 5)); }
__host__ __device__ __forceinline__ void stage_rc(int b, int& R, int& C) { const int st = b / 1024, sb = b % 1024, swz = sb ^ (((sb >> 9) & 1) << 5); R = (st >> 1) * 16 + swz / 64; C = (st & 1) * 32 + (swz % 64) / 2; }
__host__ __device__ __forceinline__ int perm32(int rho) { const int n = rho >> 4, i = rho & 15; return 8 * (i >> 2) + 4 * n + (i & 3); }

struct Unit { int pm, pn, aux; };
struct Gemm { const bf16_t* A; const bf16_t* Bt; int M, N, K; };

struct StaticOrder {
    int nM, nN, nwg, G, c;
    __host__ __device__ void init(int M, int N, int G_, int c_) { nM = M / BM; nN = N / BM; nwg = nM * nN; G = G_; c = c_; }
    __host__ __device__ bool next(int i, Unit& u) const {
        const long L = (long)i * G + c; if (L >= nwg) return false;
        int wgid = (int)L; { const int q = nwg / NXCD, r = nwg % NXCD, xcd = wgid % NXCD, off = wgid / NXCD; wgid = (xcd < r ? xcd * (q + 1) : r * (q + 1) + (xcd - r) * q) + off; }
        const int nig = WGM * nN, gid = wgid / nig, fm = gid * WGM, gsz = (nM - fm) < WGM ? (nM - fm) : WGM;
        u.pm = fm + ((wgid % nig) % gsz); u.pn = (wgid % nig) / gsz; u.aux = 0; return true;
    }
    __device__ __forceinline__ void ptrs(const Gemm& g, const Unit& u, const char*& a, const char*& b) const { a = (const char*)g.A + (size_t)u.pm * (size_t)(BM * 2) * g.K; b = (const char*)g.Bt + (size_t)u.pn * (size_t)(BM * 2) * g.K; }
    __device__ __forceinline__ void a_ready(const Unit&) const {}
    __device__ __forceinline__ void done(const Unit&) const {}
};

typedef float f32x2_cv __attribute__((ext_vector_type(2))); typedef __bf16 bf16x2_cv __attribute__((ext_vector_type(2)));
__device__ __forceinline__ unsigned cvt_pk_bf16(float lo, float hi) { const f32x2_cv v = {lo, hi}; const bf16x2_cv b = __builtin_convertvector(v, bf16x2_cv); return __builtin_bit_cast(unsigned, b); }

template <class Epi, class Sched, bool ALIGN_EPI = false, bool SP2 = false>
__device__ __forceinline__ void gemm_phase(PG8_LAS unsigned char* lds, const Gemm g, const Sched& S, const Epi& E, const int tid_opaque) {
    const int tid = tid_opaque, wid = __builtin_amdgcn_readfirstlane(tid >> 6), lane = tid & 63, wr = wid >> 2, wc = wid & 3, fr = lane & 15, fq = lane >> 4;
    const int K = g.K, nt = K / BK;
    unsigned voffA[2], voffB[2];
#pragma unroll
    for (int i = 0; i < 2; ++i) { int R, C; stage_rc(tid * 16 + i * 8192, R, C); const int Rb = Epi::PERM ? ((R & ~31) + perm32(R & 31)) : R;
        voffA[i] = (unsigned)(R * K + C) * 2u; voffB[i] = (unsigned)(Rb * K + C) * 2u; }
    const size_t kstep = (size_t)(BK * 2);
    const size_t hstep = (size_t)HALF * K * 2;
    const unsigned ldsw = (unsigned)wid * 1024u;
    const int aoff = lds_byte(wr * 64 + fr, fq * 8), boff = lds_byte(wc * 32 + fr, fq * 8);
#define PG8_SA(b, h) (((b) * 2 + (h)) * HTB)
#define PG8_SB(b, h) ((4 + (b) * 2 + (h)) * HTB)
#define PG8_STAGE(bufoff, gbase, voff) do { _Pragma("unroll") for (int _i = 0; _i < 2; ++_i) \
        __builtin_amdgcn_global_load_lds((const unsigned*)((const char*)(gbase) + (voff)[_i]), (PG8_LAS unsigned*)(lds + (bufoff) + ldsw + _i * 8192), 16, 0, 0); } while (0)
#define PG8_LDA(dst, b, h) do { _Pragma("unroll") for (int m = 0; m < 4; ++m) _Pragma("unroll") for (int k = 0; k < 2; ++k) dst[m][k] = *(const PG8_LAS bf16x8*)(lds + PG8_SA(b, h) + aoff + m * 2048 + k * 1024); } while (0)
#define PG8_LDB(dst, b, h) do { _Pragma("unroll") for (int n = 0; n < 2; ++n) _Pragma("unroll") for (int k = 0; k < 2; ++k) dst[n][k] = *(const PG8_LAS bf16x8*)(lds + PG8_SB(b, h) + boff + n * 2048 + k * 1024); } while (0)
#define PG8_MMA(ai, bj, At, Bt) do { __builtin_amdgcn_s_setprio(1); _Pragma("unroll") for (int m = 0; m < 4; ++m) _Pragma("unroll") for (int n = 0; n < 2; ++n) _Pragma("unroll") for (int k = 0; k < 2; ++k) \
        acc[ai][bj][m][n] = __builtin_amdgcn_mfma_f32_16x16x32_bf16(Bt[n][k], At[m][k], acc[ai][bj][m][n], 0, 0, 0); __builtin_amdgcn_s_setprio(0); } while (0)
#define PG8_WAIT_V(n) asm volatile("s_waitcnt vmcnt(" #n ")" ::: "memory")
#define PG8_WAIT_L(n) asm volatile("s_waitcnt lgkmcnt(" #n ")" ::: "memory")
#define PG8_BAR __builtin_amdgcn_s_barrier()
#define PG8_SCHED __builtin_amdgcn_sched_barrier(0)
    Unit cur, nxt; int ui = 0;
    if (!S.next(0, cur)) return;
    f32x4 acc[2][2][4][2];
#pragma unroll
    for (int a = 0; a < 2; ++a)
#pragma unroll
        for (int b = 0; b < 2; ++b)
#pragma unroll
            for (int m = 0; m < 4; ++m)
#pragma unroll
                for (int n = 0; n < 2; ++n) acc[a][b][m][n] = (f32x4){0.f, 0.f, 0.f, 0.f};
    bf16x8 At[4][2], B0[2][2], B1[2][2];
    const char* cA; const char* cB; S.ptrs(g, cur, cA, cB);
    S.a_ready(cur);
    if constexpr (SP2) {
        PG8_STAGE(PG8_SB(0, 0), cB, voffB); PG8_STAGE(PG8_SB(0, 1), cB + hstep, voffB); PG8_STAGE(PG8_SA(0, 0), cA, voffA); PG8_STAGE(PG8_SA(0, 1), cA + hstep, voffA);
        if (wr == 1) PG8_BAR;
        PG8_WAIT_V(2); PG8_BAR;
        PG8_STAGE(PG8_SB(1, 0), cB + kstep, voffB); PG8_STAGE(PG8_SA(1, 0), cA + kstep, voffA); PG8_STAGE(PG8_SB(1, 1), cB + hstep + kstep, voffB);
        PG8_WAIT_V(6); PG8_BAR;
    } else {
        PG8_STAGE(PG8_SB(0, 0), cB, voffB); PG8_STAGE(PG8_SA(0, 0), cA, voffA); PG8_STAGE(PG8_SB(0, 1), cB + hstep, voffB); PG8_STAGE(PG8_SA(0, 1), cA + hstep, voffA);
        if (wr == 1) PG8_BAR;
        PG8_WAIT_V(4); PG8_BAR;
        PG8_STAGE(PG8_SB(1, 0), cB + kstep, voffB); PG8_STAGE(PG8_SA(1, 0), cA + kstep, voffA); PG8_STAGE(PG8_SB(1, 1), cB + hstep + kstep, voffB);
        PG8_WAIT_V(6); PG8_BAR;
    }
    for (;;) {
        const bool has_next = S.next(ui + 1, nxt);
        const char* nA = cA; const char* nB = cB; if (has_next) S.ptrs(g, nxt, nA, nB);
        for (int t = 0; t < nt; t += 2) {
            const bool last = (t == nt - 2);
            const char* a1 = cA + (size_t)(t + 1) * kstep;
            const char* a2 = last ? nA : cA + (size_t)(t + 2) * kstep; const char* b2 = last ? nB : cB + (size_t)(t + 2) * kstep;
            const char* a3 = a2 + kstep; const char* b3 = b2 + kstep;
            if (last && has_next) S.a_ready(nxt);
            if constexpr (SP2) {
            PG8_LDB(B0, 0, 0); PG8_LDB(B1, 0, 1); PG8_SCHED; PG8_LDA(At, 0, 0); PG8_STAGE(PG8_SA(1, 1), a1 + hstep, voffA);
            PG8_WAIT_V(8); PG8_WAIT_L(0); PG8_BAR; PG8_MMA(0, 0, At, B0); PG8_MMA(0, 1, At, B1); PG8_BAR; PG8_SCHED;
            PG8_LDA(At, 0, 1); PG8_STAGE(PG8_SB(0, 0), b2, voffB); PG8_STAGE(PG8_SB(0, 1), b2 + hstep, voffB); PG8_STAGE(PG8_SA(0, 0), a2, voffA);
            PG8_WAIT_V(8); PG8_WAIT_L(0); PG8_BAR; PG8_MMA(1, 0, At, B0); PG8_MMA(1, 1, At, B1); PG8_BAR; PG8_SCHED;
            PG8_LDB(B0, 1, 0); PG8_LDB(B1, 1, 1); PG8_SCHED; PG8_LDA(At, 1, 0); PG8_STAGE(PG8_SA(0, 1), a2 + hstep, voffA);
            PG8_WAIT_V(8); PG8_WAIT_L(0); PG8_BAR; PG8_MMA(0, 0, At, B0); PG8_MMA(0, 1, At, B1); PG8_BAR; PG8_SCHED;
            PG8_LDA(At, 1, 1); PG8_STAGE(PG8_SB(1, 0), b3, voffB); PG8_STAGE(PG8_SB(1, 1), b3 + hstep, voffB); PG8_STAGE(PG8_SA(1, 0), a3, voffA);
            PG8_WAIT_V(8); PG8_WAIT_L(0); PG8_BAR; PG8_MMA(1, 0, At, B0); PG8_MMA(1, 1, At, B1); PG8_BAR; PG8_SCHED;
            } else {
            PG8_LDB(B0, 0, 0); PG8_SCHED; PG8_LDA(At, 0, 0); PG8_STAGE(PG8_SA(1, 1), a1 + hstep, voffA);
            PG8_WAIT_L(8); PG8_BAR; PG8_WAIT_L(0); PG8_MMA(0, 0, At, B0); PG8_BAR; PG8_SCHED;
            PG8_LDB(B1, 0, 1); PG8_STAGE(PG8_SB(0, 0), b2, voffB);
            PG8_BAR; PG8_WAIT_L(0); PG8_MMA(0, 1, At, B1); PG8_BAR;
            PG8_LDA(At, 0, 1); PG8_STAGE(PG8_SA(0, 0), a2, voffA);
            PG8_BAR; PG8_WAIT_L(0); PG8_MMA(1, 0, At, B0); PG8_BAR; PG8_SCHED;
            PG8_STAGE(PG8_SB(0, 1), b2 + hstep, voffB);
            PG8_WAIT_V(6); PG8_BAR; PG8_MMA(1, 1, At, B1); PG8_BAR;
            PG8_LDB(B0, 1, 0); PG8_SCHED; PG8_LDA(At, 1, 0); PG8_STAGE(PG8_SA(0, 1), a2 + hstep, voffA);
            PG8_WAIT_L(8); PG8_BAR; PG8_WAIT_L(0); PG8_MMA(0, 0, At, B0); PG8_BAR; PG8_SCHED;
            PG8_LDB(B1, 1, 1); PG8_STAGE(PG8_SB(1, 0), b3, voffB);
            PG8_BAR; PG8_WAIT_L(0); PG8_MMA(0, 1, At, B1); PG8_BAR;
            PG8_LDA(At, 1, 1); PG8_STAGE(PG8_SA(1, 0), a3, voffA);
            PG8_BAR; PG8_WAIT_L(0); PG8_MMA(1, 0, At, B0); PG8_BAR; PG8_SCHED;
            PG8_STAGE(PG8_SB(1, 1), b3 + hstep, voffB);
            PG8_WAIT_V(6); PG8_BAR; PG8_MMA(1, 1, At, B1); PG8_BAR;
            }
        }
        if constexpr (ALIGN_EPI) { if (wr == 0) PG8_BAR; }
        if constexpr (!Epi::AFTER_DRAIN) { E(acc, cur, wr, wc, fr, fq); S.done(cur); }
        if (!has_next) break;
        if (E.zero_after(cur))
#pragma unroll
        for (int a = 0; a < 2; ++a)
#pragma unroll
            for (int b = 0; b < 2; ++b)
#pragma unroll
                for (int m = 0; m < 4; ++m)
#pragma unroll
                    for (int n = 0; n < 2; ++n) acc[a][b][m][n] = (f32x4){0.f, 0.f, 0.f, 0.f};
        cur = nxt; cA = nA; cB = nB; ++ui;
        if constexpr (ALIGN_EPI) { if (wr == 1) PG8_BAR; }
    }
    PG8_WAIT_V(0);
    if constexpr (!ALIGN_EPI) { if (wr == 0) PG8_BAR; }
    PG8_BAR;
    if constexpr (Epi::AFTER_DRAIN) { E.fused(acc, cur, wr, wc, fr, fq, lds, wid, lane); S.done(cur); }
#undef PG8_SA
#undef PG8_SB
#undef PG8_STAGE
#undef PG8_LDA
#undef PG8_LDB
#undef PG8_MMA
#undef PG8_WAIT_V
#undef PG8_WAIT_L
#undef PG8_BAR
#undef PG8_SCHED
}
}

namespace pg8 {
typedef unsigned u32x2 __attribute__((ext_vector_type(2)));
__device__ __forceinline__ float fsigmoid(float x) { return __builtin_amdgcn_rcpf(1.0f + __builtin_amdgcn_exp2f(x * -1.4426950408889634f)); }
__device__ __forceinline__ u32x4 pack8(const f32x4& a, const f32x4& b) { u32x4 w; w.x = cvt_pk_bf16(a[0], a[1]); w.y = cvt_pk_bf16(a[2], a[3]); w.z = cvt_pk_bf16(b[0], b[1]); w.w = cvt_pk_bf16(b[2], b[3]); return w; }

struct EpiF32 {
    static constexpr bool PERM = false, AFTER_DRAIN = false;
    float* C; int ldc; const float* base;
    __device__ __forceinline__ bool zero_after(const Unit&) const { return true; }
    __device__ __forceinline__ void operator()(f32x4 (&acc)[2][2][4][2], const Unit& u, int wr, int wc, int fr, int fq) const {
        const int row0 = u.pm * BM + wr * 64 + fr, col0 = u.pn * BM + wc * 32 + 4 * fq;
#pragma unroll
        for (int ai = 0; ai < 2; ++ai)
#pragma unroll
            for (int m = 0; m < 4; ++m) { const size_t off = (size_t)(row0 + ai * HALF + m * 16) * ldc + col0;
#pragma unroll
                for (int bj = 0; bj < 2; ++bj)
#pragma unroll
                    for (int n = 0; n < 2; ++n) { f32x4 v = acc[ai][bj][m][n]; if (base) v += *(const f32x4*)(base + off + bj * HALF + n * 16); *(f32x4*)(C + off + bj * HALF + n * 16) = v; } }
    }
};
struct EpiBf16P {
    static constexpr bool PERM = true, AFTER_DRAIN = false;
    bf16_t* O; int ldc;
    __device__ __forceinline__ bool zero_after(const Unit&) const { return true; }
    __device__ __forceinline__ void operator()(f32x4 (&acc)[2][2][4][2], const Unit& u, int wr, int wc, int fr, int fq) const {
        const int row0 = u.pm * BM + wr * 64 + fr, col0 = u.pn * BM + wc * 32 + 8 * fq;
#pragma unroll
        for (int ai = 0; ai < 2; ++ai)
#pragma unroll
            for (int m = 0; m < 4; ++m) { bf16_t* rowp = O + (size_t)(row0 + ai * HALF + m * 16) * ldc + col0;
#pragma unroll
                for (int bj = 0; bj < 2; ++bj) *(u32x4*)(rowp + bj * HALF) = pack8(acc[ai][bj][m][0], acc[ai][bj][m][1]); }
    }
};
struct EpiSwiGLU {
    static constexpr bool PERM = true, AFTER_DRAIN = false;
    bf16_t* O; int ldc;
    __device__ __forceinline__ bool zero_after(const Unit&) const { return true; }
    __device__ __forceinline__ void operator()(f32x4 (&acc)[2][2][4][2], const Unit& u, int wr, int wc, int fr, int fq) const {
        const int row0 = u.pm * BM + wr * 64 + fr, col0 = u.pn * HALF + wc * 32 + 8 * fq;
#pragma unroll
        for (int ai = 0; ai < 2; ++ai)
#pragma unroll
            for (int m = 0; m < 4; ++m) { bf16_t* rowp = O + (size_t)(row0 + ai * HALF + m * 16) * ldc + col0; f32x4 r[2];
#pragma unroll
                for (int n = 0; n < 2; ++n) { const f32x4 g = acc[ai][0][m][n], up = acc[ai][1][m][n];
#pragma unroll
                    for (int i = 0; i < 4; ++i) r[n][i] = g[i] * up[i] * fsigmoid(g[i]); }
                *(u32x4*)rowp = pack8(r[0], r[1]); }
    }
};
struct EpiInProj {
    static constexpr bool PERM = true, AFTER_DRAIN = false;
    bf16_t *U, *Q, *K, *V, *G; float* MQ; const float *qg, *kg;
    __device__ __forceinline__ bool zero_after(const Unit&) const { return true; }
    __device__ __forceinline__ void operator()(f32x4 (&acc)[2][2][4][2], const Unit& u, int wr, int wc, int fr, int fq) const {
        const int row0 = u.pm * BM + wr * 64 + fr, pn = u.pn;
        if (pn < 2 || (pn >= 6 && pn < 8)) {
            bf16_t* base = (pn < 2 ? U + 256 * pn : V + 256 * (pn - 6)) + wc * 32 + 8 * fq;
#pragma unroll
            for (int ai = 0; ai < 2; ++ai)
#pragma unroll
                for (int m = 0; m < 4; ++m) { bf16_t* rowp = base + (size_t)(row0 + ai * HALF + m * 16) * 512;
#pragma unroll
                    for (int bj = 0; bj < 2; ++bj) *(u32x4*)(rowp + bj * HALF) = pack8(acc[ai][bj][m][0], acc[ai][bj][m][1]); }
        } else if (pn < 6) {
            const bool isq = pn < 4; const int head = 4 * (pn - (isq ? 2 : 4)) + wc; const float* gg = isq ? qg : kg; const float sc = isq ? C2F : 1.0f;
            f32x4 gv[2][2];
#pragma unroll
            for (int bj = 0; bj < 2; ++bj)
#pragma unroll
                for (int n = 0; n < 2; ++n) gv[bj][n] = *(const f32x4*)(gg + 32 * bj + 8 * fq + 4 * n) * sc;
            bf16_t* base = (isq ? Q : K) + head * 64 + 8 * fq;
#pragma unroll
            for (int ai = 0; ai < 2; ++ai)
#pragma unroll
                for (int m = 0; m < 4; ++m) { float ss = 0.f;
#pragma unroll
                    for (int bj = 0; bj < 2; ++bj)
#pragma unroll
                        for (int n = 0; n < 2; ++n) { const f32x4 x = acc[ai][bj][m][n]; ss += (x[0] * x[0] + x[1] * x[1]) + (x[2] * x[2] + x[3] * x[3]); }
                    ss += shx(ss, 16, fq * 16 + fr); ss += shx(ss, 32, fq * 16 + fr);
                    const float rstd = 1.0f / sqrtf(ss * (1.0f / 64.0f) + EPS);
                    bf16_t* rowp = base + (size_t)(row0 + ai * HALF + m * 16) * 512;
#pragma unroll
                    for (int bj = 0; bj < 2; ++bj) *(u32x4*)(rowp + 32 * bj) = pack8(acc[ai][bj][m][0] * rstd * gv[bj][0], acc[ai][bj][m][1] * rstd * gv[bj][1]); }
        } else if (pn < 10) {
            float* base = MQ + 256 * (pn - 8) + wc * 32 + 8 * fq;
#pragma unroll
            for (int ai = 0; ai < 2; ++ai)
#pragma unroll
                for (int m = 0; m < 4; ++m) { float* rowp = base + (size_t)(row0 + ai * HALF + m * 16) * 512;
#pragma unroll
                    for (int bj = 0; bj < 2; ++bj)
#pragma unroll
                        for (int n = 0; n < 2; ++n) *(f32x4*)(rowp + bj * HALF + 4 * n) = acc[ai][bj][m][n]; }
        } else {
            bf16_t* base = G + 256 * (pn - 10) + wc * 32 + 8 * fq;
#pragma unroll
            for (int ai = 0; ai < 2; ++ai)
#pragma unroll
                for (int m = 0; m < 4; ++m) { bf16_t* rowp = base + (size_t)(row0 + ai * HALF + m * 16) * 3072;
#pragma unroll
                    for (int bj = 0; bj < 2; ++bj) { f32x4 r[2];
#pragma unroll
                        for (int n = 0; n < 2; ++n)
#pragma unroll
                            for (int i = 0; i < 4; ++i) r[n][i] = fsigmoid(acc[ai][bj][m][n][i]);
                        *(u32x4*)(rowp + bj * HALF) = pack8(r[0], r[1]); } }
        }
    }
};
struct EpiMerge {
    static constexpr bool PERM = true, AFTER_DRAIN = false;
    const bf16_t* G; bf16_t* O;
    __device__ __forceinline__ bool zero_after(const Unit& u) const { return u.aux == 2; }
    __device__ __forceinline__ void operator()(f32x4 (&acc)[2][2][4][2], const Unit& u, int wr, int wc, int fr, int fq) const {
        const int row0 = u.pm * BM + wr * 64 + fr, col0 = u.pn * BM + wc * 32 + 8 * fq, seg = u.aux;
#pragma unroll
        for (int ai = 0; ai < 2; ++ai)
#pragma unroll
            for (int m = 0; m < 4; ++m) { const size_t row = (size_t)(row0 + ai * HALF + m * 16);
#pragma unroll
                for (int bj = 0; bj < 2; ++bj) { const bf16_t* gp = G + row * 3072 + col0 + bj * HALF + seg * 1024;
                    const u32x4 ga = *(const u32x4*)gp; float f[8];
#pragma unroll
                    for (int i = 0; i < 4; ++i) { f[2 * i] = fmaxf(__uint_as_float(ga[i] << 16), 1e-30f); f[2 * i + 1] = fmaxf(__uint_as_float(ga[i] & 0xffff0000u), 1e-30f); }
                    if (seg < 2) { const u32x4 gb = *(const u32x4*)(gp + 1024);
#pragma unroll
                        for (int i = 0; i < 4; ++i) { f[2 * i] *= __builtin_amdgcn_rcpf(fmaxf(__uint_as_float(gb[i] << 16), 1e-30f)); f[2 * i + 1] *= __builtin_amdgcn_rcpf(fmaxf(__uint_as_float(gb[i] & 0xffff0000u), 1e-30f)); } }
#pragma unroll
                    for (int i = 0; i < 4; ++i) { acc[ai][bj][m][0][i] *= f[i]; acc[ai][bj][m][1][i] *= f[4 + i]; }
                    if (seg == 2) *(u32x4*)(O + row * 1024 + col0 + bj * HALF) = pack8(acc[ai][bj][m][0], acc[ai][bj][m][1]); } }
    }
};
template <size_t O0, size_t O1, size_t O2>
struct MergeOrder {
    StaticOrder so; const char* arena; const char* Bbase;
    __device__ __forceinline__ bool next(int i, Unit& u) const { const int ti = i / 3; if (!so.next(ti, u)) return false; u.aux = i - 3 * ti; return true; }
    __device__ __forceinline__ void ptrs(const Gemm& g, const Unit& u, const char*& a, const char*& b) const {
        const size_t oa = u.aux == 0 ? O0 : (u.aux == 1 ? O1 : O2);
        a = arena + oa + (size_t)u.pm * (size_t)(BM * 2) * g.K; b = Bbase + (size_t)u.aux * (size_t)(1024 * 512 * 2) + (size_t)u.pn * (size_t)(BM * 2) * g.K; }
    __device__ __forceinline__ void a_ready(const Unit&) const {}
    __device__ __forceinline__ void done(const Unit&) const {}
};
struct GroupedOrder {
    StaticOrder so; const int* tile_e; size_t bstride;
    __device__ __forceinline__ bool next(int i, Unit& u) const { if (!so.next(i, u)) return false; u.aux = __builtin_amdgcn_readfirstlane(tile_e[u.pm]); return true; }
    __device__ __forceinline__ void ptrs(const Gemm& g, const Unit& u, const char*& a, const char*& b) const {
        a = (const char*)g.A + (size_t)u.pm * (size_t)(BM * 2) * g.K; b = (const char*)g.Bt + (size_t)u.aux * bstride + (size_t)u.pn * (size_t)(BM * 2) * g.K; }
    __device__ __forceinline__ void a_ready(const Unit&) const {}
    __device__ __forceinline__ void done(const Unit&) const {}
};
}

constexpr size_t W_IN = 8 * MiB, W_KV = 30 * MiB, W_BR = 34 * MiB, W_OUT = 40 * MiB, W_GU = 44 * MiB, W_DN = 55 * MiB, W_EGU = 64 * MiB, W_EDN = 176 * MiB;
constexpr size_t WS_SLOT = 4 * MiB, WS_META = 4 * MiB + 512 * 1024;
constexpr size_t WS_HS = 264 * MiB, WS_YB = WS_HS, WS_ACTE = 434 * MiB, WS_H2 = 434 * MiB;
constexpr int MAXTILES = 264;

template <class Map>
__device__ __forceinline__ void tr_job(Frame& F, const float* W, int K, int ldw, bf16* WT, int nblk, Map map) {
    LAS float* scr = (LAS float*)(F.lds + RING_OFF + F.wave * 16384);
    const int lane = F.lane, gw = F.vcu * NWAVES + F.wave, NGW = F.G * NWAVES, nitems = (K / 64) * nblk;
    for (int it = gw; it < nitems; it += NGW) {
        const int kb = it / nblk, nb = it % nblk, k0 = 64 * kb, n0 = map(nb);
#pragma unroll 8
        for (int i = 0; i < 32; ++i) { const int kk = 2 * i + (lane >> 5); scr[kk * 33 + (lane & 31)] = W[(size_t)(k0 + kk) * ldw + n0 + (lane & 31)]; }
        asm volatile("s_waitcnt lgkmcnt(0)" ::: "memory");
        const int c = lane & 7;
#pragma unroll
        for (int j = 0; j < 4; ++j) { const int n = (lane >> 3) + 8 * j; const LAS float* s = scr + (8 * c) * 33 + n;
            v4u o; o.x = pk2(s[0 * 33], s[1 * 33]); o.y = pk2(s[2 * 33], s[3 * 33]); o.z = pk2(s[4 * 33], s[5 * 33]); o.w = pk2(s[6 * 33], s[7 * 33]);
            *(v4u*)(WT + (size_t)(32 * nb + n) * K + k0 + 8 * c) = o; }
        asm volatile("s_waitcnt lgkmcnt(0)" ::: "memory");
    }
}
struct MapId { __device__ __forceinline__ int operator()(int nb) const { return 32 * nb; } };
struct MapIn { __device__ __forceinline__ int operator()(int nb) const { const int pn = nb >> 3, q = nb & 7;
    if (pn < 2) return 256 * pn + 32 * q;
    if (pn < 4) return OFF_Q + 64 * (4 * (pn - 2) + (q & 3)) + 32 * (q >> 2);
    if (pn < 6) return OFF_K + 64 * (4 * (pn - 4) + (q & 3)) + 32 * (q >> 2);
    if (pn < 8) return OFF_V + 256 * (pn - 6) + 32 * q;
    if (pn < 10) return OFF_MQ + 256 * (pn - 8) + 32 * q;
    return OFF_G + 256 * (pn - 10) + 32 * q; } };
struct MapGU { int FF; __device__ __forceinline__ int operator()(int nb) const { const int pn = nb >> 3, q = nb & 7; return q < 4 ? 128 * pn + 32 * q : FF + 128 * pn + 32 * (q - 4); } };

__device__ __forceinline__ void conv_phase(Frame& F) {
    unsigned char* ws = F.ws;
#pragma unroll 1
    for (int l = 0; l < DEPTH; ++l) {
        tr_job(F, inptr(F, I_WIN) + (size_t)l * D * NIN, D, NIN, (bf16*)(ws + W_IN) + (size_t)l * 5632 * 1024, 176, MapIn{});
        tr_job(F, inptr(F, I_WKV) + (size_t)l * D * 1024, D, 1024, (bf16*)(ws + W_KV) + (size_t)l * 1024 * 1024, 32, MapId{});
        tr_job(F, inptr(F, I_WFBR) + (size_t)l * 512 * D, 512, D, (bf16*)(ws + W_BR) + (size_t)(l * 3 + 1) * 1024 * 512, 32, MapId{});
        tr_job(F, inptr(F, I_WMBR) + (size_t)l * 512 * D, 512, D, (bf16*)(ws + W_BR) + (size_t)(l * 3 + 2) * 1024 * 512, 32, MapId{});
        tr_job(F, inptr(F, I_WOUT) + (size_t)l * D * D, D, D, (bf16*)(ws + W_OUT) + (size_t)l * 1024 * 1024, 32, MapId{});
        { const float* pw = inptr(F, I_POOLW) + (size_t)l * 4 * 128 * 128; const float* ps = inptr(F, I_POOLS) + l * 512; const float* wb = inptr(F, I_WPBR) + (size_t)l * 512 * D;
          bf16* WT = (bf16*)(ws + W_BR) + (size_t)(l * 3) * 1024 * 512; const int lane = F.lane;
          for (int it = F.vcu * NWAVES + F.wave; it < 512 * 16; it += F.G * NWAVES) { const int k = it >> 4, nb = it & 15, g = k >> 7; const int n = 64 * nb + lane;
              const float* pr = pw + (size_t)k * 128; float acc = 0.f;
              for (int d = 0; d < 128; ++d) acc = fmaf(pr[d] * ps[g * 128 + d], wb[(size_t)(g * 128 + d) * D + n], acc);
              WT[(size_t)n * 512 + k] = (bf16)f2bf(acc); } }
    }
    tr_job(F, inptr(F, I_WGU), D, 2 * DFF, (bf16*)(ws + W_GU), 176, MapGU{DFF});
    tr_job(F, inptr(F, I_WDN), DFF, D, (bf16*)(ws + W_DN), 32, MapId{});
#pragma unroll 1
    for (int e = 0; e < NE; ++e) {
        tr_job(F, inptr(F, I_WEGU) + (size_t)e * D * 2 * DEXP, D, 2 * DEXP, (bf16*)(ws + W_EGU) + (size_t)e * 7168 * 1024, 224, MapGU{DEXP});
        tr_job(F, inptr(F, I_WEDN) + (size_t)e * DEXP * D, DEXP, D, (bf16*)(ws + W_EDN) + (size_t)e * 1024 * DEXP, 32, MapId{});
    }
}

__device__ __forceinline__ void moe_scatter_phase(Frame& F, const bf16* H2) {
    const int* WC = (const int*)(F.ws + WS_WCNT); LAS int* sh = (LAS int*)(F.lds + RING_OFF);
    const int tid = F.tid, lane = F.lane, wave = F.wave;
    int before[8], total[8];
    { int s[8];
#pragma unroll
      for (int e = 0; e < 8; ++e) s[e] = 0;
      for (int w = 0; w < 4; ++w) { const int gwv = 4 * tid + w;
#pragma unroll
          for (int e = 0; e < 8; ++e) s[e] += WC[gwv * 8 + e]; }
      const bool isb = tid < 2 * F.vcu;
#pragma unroll
      for (int e = 0; e < 8; ++e) { int t = s[e], b = isb ? s[e] : 0;
#pragma unroll
          for (int o = 1; o < 64; o <<= 1) { t += shxi(t, o, lane); b += shxi(b, o, lane); }
          if (lane == 0) { sh[wave * 16 + e] = b; sh[wave * 16 + 8 + e] = t; } }
      __syncthreads();
#pragma unroll
      for (int e = 0; e < 8; ++e) { int b = 0, t = 0;
#pragma unroll
          for (int w = 0; w < 8; ++w) { b += sh[w * 16 + e]; t += sh[w * 16 + 8 + e]; }
          before[e] = b; total[e] = t; } }
    int seg[8]; int ntile = 0;
#pragma unroll
    for (int e = 0; e < 8; ++e) { seg[e] = ntile * 256; ntile += (total[e] + 255) >> 8; }
    if (F.vcu == 0) { int* meta = (int*)(F.ws + WS_META); if (tid == 0) meta[0] = ntile;
        int te = 0;
#pragma unroll
        for (int e = 1; e < 8; ++e) te += (tid * 256 >= seg[e]) ? 1 : 0;
        if (tid < MAXTILES) meta[16 + tid] = te; }
    int base[8];
#pragma unroll
    for (int e = 0; e < 8; ++e) { int b = before[e]; for (int w = 0; w < wave; ++w) b += WC[(F.vcu * NWAVES + w) * 8 + e]; base[e] = seg[e] + b; }
    const int gw = F.vcu * NWAVES + wave, NGW = F.G * NWAVES;
    const int m = gw + (lane & 15) * NGW; const bool act = lane < 16 && m < T;
    Choice c; c.e1 = -1; c.e2 = -1; c.w1 = 0.f; c.w2 = 0.f;
    if (act) c = ((const Choice*)(F.ws + WS_CHOICE))[m];
    int s1 = 0, s2 = 0;
    const unsigned long long lt = (1ull << lane) - 1ull;
#pragma unroll
    for (int e = 0; e < 8; ++e) { const unsigned long long m1 = __ballot(act && c.e1 == e), m2 = __ballot(act && c.e2 == e);
        if (c.e1 == e) s1 = base[e] + __popcll(m1 & lt);
        if (c.e2 == e) s2 = base[e] + __popcll(m1) + __popcll(m2 & lt); }
    if (act) { int* sl = (int*)(F.ws + WS_SLOT) + 2 * m; sl[0] = s1; sl[1] = s2; }
    bf16* HS = (bf16*)(F.ws + WS_HS);
    for (int i = 0; i < 16; ++i) { const int mi = gw + i * NGW; if (mi >= T) break;
        const int d1 = shli(s1, i), d2 = shli(s2, i);
        const v4u x0 = *(const v4u*)(H2 + (size_t)mi * D + 8 * lane), x1 = *(const v4u*)(H2 + (size_t)mi * D + 512 + 8 * lane);
        *(v4u*)(HS + (size_t)d1 * D + 8 * lane) = x0; *(v4u*)(HS + (size_t)d1 * D + 512 + 8 * lane) = x1;
        *(v4u*)(HS + (size_t)d2 * D + 8 * lane) = x0; *(v4u*)(HS + (size_t)d2 * D + 512 + 8 * lane) = x1; }
    __syncthreads();
}
__device__ __forceinline__ void moe_combine_phase(Frame& F) {
    const bf16* YB = (const bf16*)(F.ws + WS_YB); const int lane = F.lane;
    for (int m = F.vcu * NWAVES + F.wave; m < T; m += F.G * NWAVES) {
        const Choice c = ((const Choice*)(F.ws + WS_CHOICE))[m]; const int* sl = (const int*)(F.ws + WS_SLOT) + 2 * m; const int s1 = sl[0], s2 = sl[1];
#pragma unroll
        for (int h = 0; h < 2; ++h) { const v4u a = *(const v4u*)(YB + (size_t)s1 * D + 512 * h + 8 * lane), b = *(const v4u*)(YB + (size_t)s2 * D + 512 * h + 8 * lane);
            float* xp = F.X + (size_t)m * D + 512 * h + 8 * lane; f32x4 x0 = *(const f32x4*)xp, x1 = *(const f32x4*)(xp + 4);
#pragma unroll
            for (int i = 0; i < 2; ++i) { x0[2 * i] += c.w1 * bf2f(a[i] & 0xffffu) + c.w2 * bf2f(b[i] & 0xffffu); x0[2 * i + 1] += c.w1 * bf2f(a[i] >> 16) + c.w2 * bf2f(b[i] >> 16);
                x1[2 * i] += c.w1 * bf2f(a[2 + i] & 0xffffu) + c.w2 * bf2f(b[2 + i] & 0xffffu); x1[2 * i + 1] += c.w1 * bf2f(a[2 + i] >> 16) + c.w2 * bf2f(b[2 + i] >> 16); }
            *(f32x4*)xp = x0; *(f32x4*)(xp + 4) = x1; }
    }
}

namespace attn_body {
using bf16=__hip_bfloat16;
using bf16x8=__attribute__((ext_vector_type(8)))short;
using s16x4=__attribute__((ext_vector_type(4)))short;
using f32x16=__attribute__((ext_vector_type(16)))float;
using u32x4=__attribute__((ext_vector_type(4)))unsigned;
constexpr int BATCH=8,NHEAD=8,SEQ=4096,D=64,DM=NHEAD*D;
constexpr int NW=8,QBLK=32,QB=QBLK*NW,KVBLK=64,NQB=SEQ/QB;
constexpr int ATTN_PITCH=DM, ATTN_UNIT_ROWS=QB;
__device__ __forceinline__ int crow(int r,int hi){return (r&3)+8*(r>>2)+4*hi;}
#define SBAR() __builtin_amdgcn_sched_barrier(0)
__device__ __forceinline__ void cmask(f32x16&p0,f32x16&p1,int jb,int qrel,int hi){
  const float NEG=-INFINITY; int kb=64*jb+4*hi;
  #pragma unroll
  for(int r=0;r<16;++r){int kv=kb+(r&3)+8*(r>>2); if(kv>qrel)p0[r]=NEG; if(kv+32>qrel)p1[r]=NEG;}
}

constexpr int NSLOT=3, SLOTB=8192;
constexpr int LDS_K=0, LDS_V=NSLOT*SLOTB, LDS_WS=2*NSLOT*SLOTB, LDS_OST=LDS_WS+NW*64*4, LDS_BYTES=LDS_OST+NW*4096, LDS_CL=LDS_BYTES, LDS_BYTES_ALL=LDS_CL+SEQ*4;
constexpr float C2=0.125f*1.4426950408889634f;
__device__ __forceinline__ void glds16(const void*gsrc,unsigned lds_dst){unsigned keep;
  asm volatile("s_mov_b32 %0, m0\n\ts_mov_b32 m0, %2\n\ts_nop 0\n\tglobal_load_lds_dwordx4 %1, off\n\ts_mov_b32 m0, %0":"=&s"(keep):"v"(gsrc),"s"(lds_dst):"memory");}
__device__ __forceinline__ float max3f(float a,float b,float c){float r;asm("v_max3_f32 %0, %1, %2, %3":"=v"(r):"v"(a),"v"(b),"v"(c));return r;}
__device__ __forceinline__ float max2f(float a,float b){float r;asm("v_max_f32_e32 %0, %1, %2":"=v"(r):"v"(a),"v"(b));return r;}
__device__ __forceinline__ float fadd_s(float a,float b){float r;asm("v_add_f32_e32 %0, %1, %2":"=v"(r):"v"(a),"v"(b));return r;}
__device__ __forceinline__ float fsub_s(float a,float b){float r;asm("v_sub_f32_e32 %0, %1, %2":"=v"(r):"v"(a),"v"(b));return r;}
typedef float f32x2_t __attribute__((ext_vector_type(2))); typedef __bf16 bf16x2_t __attribute__((ext_vector_type(2)));
__device__ __forceinline__ unsigned cvtpk_s(float lo,float hi){f32x2_t v={lo,hi};bf16x2_t b=__builtin_convertvector(v,bf16x2_t);return __builtin_bit_cast(unsigned,b);}
#define WAIT_BAR(N) asm volatile("s_waitcnt vmcnt(" #N ") lgkmcnt(0)\n\ts_barrier":::"memory")

__device__ __forceinline__ void qkt(f32x16&p0,f32x16&p1,const char*Kslot,const bf16x8*qr,const f32x16&ci0,const f32x16&ci1,int r32,int hi){
  const char*kb=Kslot+hi*1024+r32*16;
  #pragma unroll
  for(int d0=0;d0<4;++d0){
    const bf16x8 b0=*reinterpret_cast<const bf16x8*>(kb+d0*2048);
    const bf16x8 b1=*reinterpret_cast<const bf16x8*>(kb+d0*2048+512);
    if(d0==0){p0=__builtin_amdgcn_mfma_f32_32x32x16_bf16(b0,qr[0],ci0,0,0,0);p1=__builtin_amdgcn_mfma_f32_32x32x16_bf16(b1,qr[0],ci1,0,0,0);}
    else{p0=__builtin_amdgcn_mfma_f32_32x32x16_bf16(b0,qr[d0],p0,0,0,0);p1=__builtin_amdgcn_mfma_f32_32x32x16_bf16(b1,qr[d0],p1,0,0,0);}}
}
typedef __attribute__((address_space(3))) const char* lds_cptr;
typedef short v4i16_t __attribute__((ext_vector_type(4)));
__device__ __forceinline__ void kload8(bf16x8*kf,lds_cptr kp){
  kf[0]=*(const __attribute__((address_space(3))) bf16x8*)(kp);      kf[1]=*(const __attribute__((address_space(3))) bf16x8*)(kp+512);
  kf[2]=*(const __attribute__((address_space(3))) bf16x8*)(kp+2048); kf[3]=*(const __attribute__((address_space(3))) bf16x8*)(kp+2560);
  kf[4]=*(const __attribute__((address_space(3))) bf16x8*)(kp+4096); kf[5]=*(const __attribute__((address_space(3))) bf16x8*)(kp+4608);
  kf[6]=*(const __attribute__((address_space(3))) bf16x8*)(kp+6144); kf[7]=*(const __attribute__((address_space(3))) bf16x8*)(kp+6656);
}
__device__ __forceinline__ void kload2(bf16x8*kf,lds_cptr kp,int j){ kf[2*j]=*(const __attribute__((address_space(3))) bf16x8*)(kp+j*2048); kf[2*j+1]=*(const __attribute__((address_space(3))) bf16x8*)(kp+j*2048+512); }
__device__ __forceinline__ s16x4 vtr(lds_cptr p){ return __builtin_bit_cast(s16x4,__builtin_amdgcn_ds_read_tr16_b64_v4i16((__attribute__((address_space(3))) v4i16_t*)p)); }
__device__ __forceinline__ float rowmax(const f32x16&p0,const f32x16&p1){
  float a=max3f(p0[0],p0[1],p1[0]),b=max3f(p0[2],p0[3],p1[1]);a=max3f(a,p1[2],p1[3]);
  #pragma unroll
  for(int r=4;r<16;r+=4){a=max3f(a,p0[r],p0[r+1]);b=max3f(b,p0[r+2],p0[r+3]);a=max3f(a,p1[r],p1[r+1]);b=max3f(b,p1[r+2],p1[r+3]);}
  const float m=max2f(a,b);
  auto rr=__builtin_amdgcn_permlane32_swap(__float_as_uint(m),__float_as_uint(m),false,false);
  return max2f(__uint_as_float(rr[0]),__uint_as_float(rr[1]));
}
__device__ __forceinline__ void pv(f32x16*o,int vb,bf16x8 pa0,bf16x8 pa1,bf16x8 pa2,bf16x8 pa3){
  #pragma unroll
  for(int d0=0;d0<2;++d0){s16x4 lo[4],hi[4];
    #pragma unroll
    for(int ks=0;ks<4;++ks){
      asm volatile("ds_read_b64_tr_b16 %0,%1 offset:%c2":"=&v"(lo[ks]):"v"(vb),"i"(d0*4096+ks*1024):"memory");
      asm volatile("ds_read_b64_tr_b16 %0,%1 offset:%c2":"=&v"(hi[ks]):"v"(vb),"i"(d0*4096+ks*1024+512):"memory");}
    asm volatile("s_waitcnt lgkmcnt(0)":::"memory");SBAR();
    #define PK(k) (bf16x8){lo[k][0],lo[k][1],lo[k][2],lo[k][3],hi[k][0],hi[k][1],hi[k][2],hi[k][3]}
    o[d0]=__builtin_amdgcn_mfma_f32_32x32x16_bf16(pa0,PK(0),o[d0],0,0,0);
    o[d0]=__builtin_amdgcn_mfma_f32_32x32x16_bf16(pa1,PK(1),o[d0],0,0,0);
    o[d0]=__builtin_amdgcn_mfma_f32_32x32x16_bf16(pa2,PK(2),o[d0],0,0,0);
    o[d0]=__builtin_amdgcn_mfma_f32_32x32x16_bf16(pa3,PK(3),o[d0],0,0,0);
    #undef PK
  }
}

#ifndef ATTN_STORE16
#define ATTN_STORE16(p,v) (*(u32x4*)(p)=(v))
#endif
__device__ __forceinline__ void attn_unit(int b,int h,int qb,const bf16*Q,const bf16*K,const bf16*V,bf16*O,const float*CLh,const int T0,char*shm,const int tid){
  const int lane=tid&63,r32=lane&31,hi=lane>>5; const int wid=__builtin_amdgcn_readfirstlane(tid>>6);
  const long rowbase=(long)b*SEQ; const int q0=qb*QB;
  const bf16*Qw=Q+(rowbase+q0+wid*QBLK)*DM+h*D;
  const bf16*Kh=K+(rowbase+(long)T0*KVBLK)*DM+h*D,*Vh=V+(rowbase+(long)T0*KVBLK)*DM+h*D;
  const unsigned lds0=(unsigned)(uintptr_t)shm;
  float*wsf=(float*)(shm+LDS_WS)+wid*64;
  const bf16*ksrc=Kh+(long)lane*DM+wid*8;
  const bf16*vsrc=Vh+(long)(16*(wid&3)+(lane>>2))*DM+(wid>>2)*32+(lane&3)*8;
  const unsigned kdst=lds0+LDS_K+wid*1024, vdst=lds0+LDS_V+wid*1024;
  #define DMA_K(t,slot) glds16(ksrc+(long)(t)*KVBLK*DM,(unsigned)__builtin_amdgcn_readfirstlane(kdst+(slot)))
  #define DMA_V(t,slot) glds16(vsrc+(long)(t)*KVBLK*DM,(unsigned)__builtin_amdgcn_readfirstlane(vdst+(slot)))
  const int vb0=(int)(lds0+LDS_V)+((lane>>4)&1)*32+(lane&3)*8+(4*hi+((lane&15)>>2))*64;
  const char*Kbase=shm+LDS_K; bf16x8 kf[8];
  const lds_cptr shm3=(lds_cptr)shm; const lds_cptr kp0=shm3+LDS_K+hi*1024+r32*16; const lds_cptr vp0=shm3+LDS_V+((lane>>4)&1)*32+(lane&3)*8+(4*hi+((lane&15)>>2))*64;
  const int NT=(q0+QB)/KVBLK-T0;
  typedef __attribute__((address_space(3))) const float* lds_fptr; const lds_fptr clt=(lds_fptr)(shm3+LDS_CL)+T0*KVBLK;
  { const int np=qb+1; if(wid<np)glds16(CLh+256*wid+4*lane,(unsigned)__builtin_amdgcn_readfirstlane(lds0+LDS_CL+1024*wid)); if(wid+8<np)glds16(CLh+256*(wid+8)+4*lane,(unsigned)__builtin_amdgcn_readfirstlane(lds0+LDS_CL+1024*(wid+8))); }
  DMA_K(0,0);DMA_V(0,0);DMA_K(1,SLOTB);
  bf16x8 qr[4];
  #pragma unroll
  for(int d0=0;d0<4;++d0)qr[d0]=*reinterpret_cast<const bf16x8*>(&Qw[(long)r32*DM+d0*16+hi*8]);
  float l_reg=0.f;f32x16 o[2];o[0]=f32x16{};o[1]=f32x16{};
  const float clq=CLh[q0+wid*QBLK+r32]; const float bq=hi?clq:1.0f;
  #define CINIT(c0,c1,t) do{ const float k0_=clt[(t)*KVBLK+r32],k1_=clt[(t)*KVBLK+32+r32]; c0=__builtin_amdgcn_mfma_f32_32x32x2f32(hi?1.0f:-k0_,bq,f32x16{},0,0,0); c1=__builtin_amdgcn_mfma_f32_32x32x2f32(hi?1.0f:-k1_,bq,f32x16{},0,0,0); }while(0)
  const int qrel=wid*QBLK+r32;
  #define CMASK(P0,P1,t) do{int jb_=(t)-(NT-4); if(jb_>=0)cmask(P0,P1,jb_,qrel,hi);}while(0)
  f32x16 pA0,pA1,pB0,pB1;
  int sl_prev=0,sl_cur=0,sl_next=SLOTB;
  #define ROT() do{sl_prev=sl_cur;sl_cur=sl_next;sl_next=(sl_next==(NSLOT-1)*SLOTB)?0:sl_next+SLOTB;}while(0)
  DMA_K(2,2*SLOTB);
  WAIT_BAR(3);
  { f32x16 ci0,ci1; CINIT(ci0,ci1,0); qkt(pA0,pA1,Kbase,qr,ci0,ci1,r32,hi); } asm volatile("s_nop 15\n\ts_nop 7":"+v"(pA0),"+v"(pA1));CMASK(pA0,pA1,0);
  _Pragma("unroll") for(int r=0;r<16;++r)pA0[r]=__builtin_amdgcn_exp2f(pA0[r]);
  _Pragma("unroll") for(int r=0;r<16;++r)pA1[r]=__builtin_amdgcn_exp2f(pA1[r]);
  WAIT_BAR(0);
  DMA_K(3,0);DMA_V(1,SLOTB);
  ROT();
  kload8(kf,kp0+sl_cur);
  WAIT_BAR(2);
  s16x4 vlo[8],vhi[8]; u32x4 pw0,pw1,pw2,pw3;
  #define PKW(P,B) cvtpk_s(P[B],P[B+1])
  #define PAF(k) __builtin_bit_cast(bf16x8,pw##k)
  #define VFR(i) (bf16x8){vlo[i][0],vlo[i][1],vlo[i][2],vlo[i][3],vhi[i][0],vhi[i][1],vhi[i][2],vhi[i][3]}
  #define PIN(x) asm volatile("":"+v"(x))
  #define MX3(a,b,c) __builtin_fmaxf(__builtin_fmaxf((a),(b)),(c))
  #define GAPA(MF,A0,A1,A2,A3,W0,W1,PW) do{ MF; sacc+=A0; sacc+=A1; sacc+=A2; sacc+=A3; PIN(sacc); W0; W1; PIN(PW); SBAR(); }while(0)
  #define EX(v) __builtin_amdgcn_exp2f(v)
  #define GAPB(MF,X,B) do{ MF; X[B]=EX(X[B]); X[B+1]=EX(X[B+1]); X[B+2]=EX(X[B+2]); X[B+3]=EX(X[B+3]); PIN(X); SBAR(); }while(0)
  #define VRD(i) do{ vlo[i]=vtr(vp_+(((i)>>2)*4096+((i)&3)*1024)); vhi[i]=vtr(vp_+(((i)>>2)*4096+((i)&3)*1024+512)); }while(0)
  #define KRD(G,j) do{ if(G){ kload2(kf,kp0+sl_next,j); SBAR(); } }while(0)
  #define STEP(C0,C1,P0,P1,t,GK,GV,GL) do{ SBAR(); \
    const lds_cptr vp_=vp0+sl_prev; \
    CINIT(C0,C1,t); SBAR(); \
    VRD(0); SBAR(); float sacc=(P0[0]+P0[1]); \
    GAPA(C0=__builtin_amdgcn_mfma_f32_32x32x16_bf16(kf[0],qr[0],C0,0,0,0), P0[2],P0[3],P0[4],P0[5],     pw0[0]=PKW(P0,0), pw0[1]=PKW(P0,2), pw0); \
    VRD(4); SBAR(); GAPA(C1=__builtin_amdgcn_mfma_f32_32x32x16_bf16(kf[1],qr[0],C1,0,0,0), P0[6],P0[7],P0[8],P0[9],     pw0[2]=PKW(P0,4), pw0[3]=PKW(P0,6), pw0); \
    VRD(1); SBAR(); GAPA(C0=__builtin_amdgcn_mfma_f32_32x32x16_bf16(kf[2],qr[1],C0,0,0,0),   P0[10],P0[11],P0[12],P0[13], pw1[0]=PKW(P0,8), pw1[1]=PKW(P0,10), pw1); \
    VRD(5); SBAR(); GAPA(C1=__builtin_amdgcn_mfma_f32_32x32x16_bf16(kf[3],qr[1],C1,0,0,0),   P0[14],P0[15],P1[0],P1[1],   pw1[2]=PKW(P0,12),pw1[3]=PKW(P0,14), pw1); \
    VRD(2); SBAR(); GAPA(C0=__builtin_amdgcn_mfma_f32_32x32x16_bf16(kf[4],qr[2],C0,0,0,0),   P1[2],P1[3],P1[4],P1[5],     pw2[0]=PKW(P1,0), pw2[1]=PKW(P1,2), pw2); \
    VRD(6); SBAR(); GAPA(C1=__builtin_amdgcn_mfma_f32_32x32x16_bf16(kf[5],qr[2],C1,0,0,0),   P1[6],P1[7],P1[8],P1[9],     pw2[2]=PKW(P1,4), pw2[3]=PKW(P1,6), pw2); \
    VRD(3); SBAR(); GAPA(C0=__builtin_amdgcn_mfma_f32_32x32x16_bf16(kf[6],qr[3],C0,0,0,0),   P1[10],P1[11],P1[12],P1[13], pw3[0]=PKW(P1,8), pw3[1]=PKW(P1,10), pw3); \
    VRD(7); SBAR(); GAPA(C1=__builtin_amdgcn_mfma_f32_32x32x16_bf16(kf[7],qr[3],C1,0,0,0),   P1[14],P1[15],0.f,0.f,       pw3[2]=PKW(P1,12),pw3[3]=PKW(P1,14), pw3); \
    l_reg+=sacc; \
    if(GK){DMA_K((t)+3,sl_cur);} if(GV){DMA_V((t)+1,sl_next);} \
    CMASK(C0,C1,t); \
    SBAR(); \
    GAPB(o[0]=__builtin_amdgcn_mfma_f32_32x32x16_bf16(PAF(0),VFR(0),o[0],0,0,0), C0,0); \
    GAPB(o[1]=__builtin_amdgcn_mfma_f32_32x32x16_bf16(PAF(0),VFR(4),o[1],0,0,0), C0,4); \
    KRD(GL,0); GAPB(o[0]=__builtin_amdgcn_mfma_f32_32x32x16_bf16(PAF(1),VFR(1),o[0],0,0,0), C0,8); \
    KRD(GL,1); GAPB(o[1]=__builtin_amdgcn_mfma_f32_32x32x16_bf16(PAF(1),VFR(5),o[1],0,0,0), C0,12); \
    KRD(GL,2); GAPB(o[0]=__builtin_amdgcn_mfma_f32_32x32x16_bf16(PAF(2),VFR(2),o[0],0,0,0), C1,0); \
    KRD(GL,3); GAPB(o[1]=__builtin_amdgcn_mfma_f32_32x32x16_bf16(PAF(2),VFR(6),o[1],0,0,0), C1,4); \
    GAPB(o[0]=__builtin_amdgcn_mfma_f32_32x32x16_bf16(PAF(3),VFR(3),o[0],0,0,0), C1,8); \
    GAPB(o[1]=__builtin_amdgcn_mfma_f32_32x32x16_bf16(PAF(3),VFR(7),o[1],0,0,0), C1,12); \
    }while(0)
  int t=1;
  #undef CMASK
  #define CMASK(P0,P1,t) do{}while(0)
  for(;t+5<NT;t+=2){
    STEP(pB0,pB1,pA0,pA1,t,true,true,true);     WAIT_BAR(2); ROT();
    STEP(pA0,pA1,pB0,pB1,t+1,true,true,true);   WAIT_BAR(2); ROT();
  }
  #undef CMASK
  #define CMASK(P0,P1,t) do{int jb_=(t)-(NT-4); if(jb_>=0)cmask(P0,P1,jb_,qrel,hi);}while(0)
  #define ENDW(tt) do{ if((tt)+3<NT){WAIT_BAR(2);} else if((tt)+2<NT){WAIT_BAR(1);} else {WAIT_BAR(0);} }while(0)
  for(;t+1<NT;t+=2){
    STEP(pB0,pB1,pA0,pA1,t,(t+3<NT),(t+1<NT),(t+1<NT));       ENDW(t);   ROT();
    STEP(pA0,pA1,pB0,pB1,t+1,(t+4<NT),(t+2<NT),(t+2<NT));     ENDW(t+1); ROT();
  }
  STEP(pB0,pB1,pA0,pA1,NT-1,false,false,false);
  { float sacc=pB0[0]+pB0[1]; _Pragma("unroll") for(int r=2;r<16;++r)sacc+=pB0[r]; _Pragma("unroll") for(int r=0;r<16;++r)sacc+=pB1[r]; l_reg+=sacc;
    pw0=(u32x4){PKW(pB0,0),PKW(pB0,2),PKW(pB0,4),PKW(pB0,6)};pw1=(u32x4){PKW(pB0,8),PKW(pB0,10),PKW(pB0,12),PKW(pB0,14)};pw2=(u32x4){PKW(pB1,0),PKW(pB1,2),PKW(pB1,4),PKW(pB1,6)};pw3=(u32x4){PKW(pB1,8),PKW(pB1,10),PKW(pB1,12),PKW(pB1,14)};
    SBAR(); pv(o,vb0+sl_cur,PAF(0),PAF(1),PAF(2),PAF(3)); }
  #undef PKW
  #undef PAF
  #undef VFR
  #undef PIN
  #undef MX3
  #undef GAPA
  #undef GAPB
  #undef EX
  #undef VRD
  #undef KRD
  #undef STEP
  #undef ENDW
  {auto rr=__builtin_amdgcn_permlane32_swap(__float_as_uint(l_reg),__float_as_uint(l_reg),false,false);l_reg=__uint_as_float(rr[0])+__uint_as_float(rr[1]);}
  if(hi==0)wsf[32+r32]=l_reg;asm volatile("s_waitcnt lgkmcnt(0)":::"memory");
  float rli[16];
  #pragma unroll
  for(int r=0;r<16;++r)rli[r]=__builtin_amdgcn_rcpf(wsf[32+crow(r,hi)]);
  bf16*Ow=O+(rowbase+q0+wid*QBLK)*DM+h*D;
  { bf16*stg=(bf16*)(shm+LDS_OST)+wid*2048;
    #pragma unroll
    for(int r=0;r<16;++r){const int orow=crow(r,hi);
      #pragma unroll
      for(int d0=0;d0<2;++d0)stg[orow*64+d0*32+r32]=__float2bfloat16(o[d0][r]*rli[r]);}
    asm volatile("s_waitcnt lgkmcnt(0)":::"memory");
    #pragma unroll
    for(int i=0;i<4;++i){const int row=i*8+(lane>>3),ch=lane&7; const u32x4 v=*(const u32x4*)(stg+row*64+ch*8); ATTN_STORE16(Ow+(long)row*DM+ch*8,v);} }
  asm volatile("s_waitcnt lgkmcnt(0)\n\ts_barrier":::"memory");
  #undef DMA_K
  #undef DMA_V
  #undef CMASK
  #undef CINIT
  #undef ROT
}
constexpr int ATTN_LDS_BYTES=LDS_BYTES;
struct AttnTensors { const bf16* Q; const bf16* K; const bf16* V; bf16* O; const float* CL; };
struct AttnUnit { int bh; int qb; };
struct StaticOrder {
  int vcu;
  __device__ __forceinline__ explicit StaticOrder(int v):vcu(v){}
  __device__ __forceinline__ bool next(int i,AttnUnit&u)const{ if(i>=4)return false; const int s=vcu&3; u.bh=vcu>>2; u.qb=(i==0)?15-s:(i==1)?8+s:(i==2)?7-s:s; return true; }
};
template<class Sched> __device__ __forceinline__ void attn_phase(char*lds,const AttnTensors&T,const Sched&S,const int tid){
  AttnUnit u;
  for(int i=0;S.next(i,u);++i){ const float*CLh=T.CL+(size_t)u.bh*SEQ; const int T0=0; attn_unit(u.bh/NHEAD,u.bh%NHEAD,u.qb,T.Q,T.K,T.V,T.O,CLh,T0,lds,tid); }
}
#undef SBAR
#undef WAIT_BAR
}

namespace memattn {
using namespace attn_body;
typedef float f32x4_t __attribute__((ext_vector_type(4)));
constexpr int MPITCH = 512;
__device__ __forceinline__ void mem_unit(int b, int head, int qb0, int nqb, const float* MQ, const attn_body::bf16* KM, const attn_body::bf16* VM, attn_body::bf16* MO, const float* mqg, char* shm, const int tid) {
    const int lane = tid & 63, r32 = lane & 31, hi = lane >> 5; const int wid = __builtin_amdgcn_readfirstlane(tid >> 6);
    const unsigned lds0 = (unsigned)(uintptr_t)shm;
    const attn_body::bf16* Kh = KM + (size_t)b * 256 * MPITCH + head * 128; const attn_body::bf16* Vh = VM + (size_t)b * 256 * MPITCH + head * 128;
#pragma unroll
    for (int t = 0; t < 4; ++t)
#pragma unroll
        for (int pp = 0; pp < 2; ++pp) { const int p = wid + 8 * pp;
            glds16(Kh + (size_t)(64 * t + lane) * MPITCH + p * 8, (unsigned)__builtin_amdgcn_readfirstlane(lds0 + t * 32768 + p * 1024));
            glds16(Vh + (size_t)(64 * t + 16 * (p & 3) + (lane >> 2)) * MPITCH + (p >> 2) * 32 + (lane & 3) * 8, (unsigned)__builtin_amdgcn_readfirstlane(lds0 + t * 32768 + 16384 + p * 1024)); }
    const lds_cptr shm3 = (lds_cptr)shm;
    const lds_cptr kp0 = shm3 + hi * 1024 + r32 * 16;
    const lds_cptr vp0 = shm3 + 16384 + ((lane >> 4) & 1) * 32 + (lane & 3) * 8 + (4 * hi + ((lane & 15) >> 2)) * 64;
    asm volatile("s_waitcnt vmcnt(0) lgkmcnt(0)\n\ts_barrier" ::: "memory");
    for (int qi = 0; qi < nqb; ++qi) {
        const size_t row0 = (size_t)b * ::SEQ + (size_t)(qb0 + qi) * 256 + wid * 32;
        bf16x8 qr[8];
        { f32x4_t x[8][2]; float ss = 0.f; const float* qp = MQ + (row0 + r32) * MPITCH + head * 128 + 8 * hi;
#pragma unroll
          for (int d0 = 0; d0 < 8; ++d0) { x[d0][0] = *(const f32x4_t*)(qp + 16 * d0); x[d0][1] = *(const f32x4_t*)(qp + 16 * d0 + 4);
#pragma unroll
              for (int j = 0; j < 4; ++j) ss += x[d0][0][j] * x[d0][0][j] + x[d0][1][j] * x[d0][1][j]; }
          { auto rr = __builtin_amdgcn_permlane32_swap(__float_as_uint(ss), __float_as_uint(ss), false, false); ss = __uint_as_float(rr[0]) + __uint_as_float(rr[1]); }
          const float rstd = C2M / sqrtf(ss * (1.0f / 128.0f) + EPS);
#pragma unroll
          for (int d0 = 0; d0 < 8; ++d0) { const f32x4_t a = x[d0][0] * rstd * *(const f32x4_t*)(mqg + 16 * d0 + 8 * hi), c = x[d0][1] * rstd * *(const f32x4_t*)(mqg + 16 * d0 + 8 * hi + 4);
              u32x4 w; w.x = cvtpk_s(a[0], a[1]); w.y = cvtpk_s(a[2], a[3]); w.z = cvtpk_s(c[0], c[1]); w.w = cvtpk_s(c[2], c[3]); qr[d0] = __builtin_bit_cast(bf16x8, w); } }
        f32x16 o[4]; o[0] = f32x16{}; o[1] = f32x16{}; o[2] = f32x16{}; o[3] = f32x16{}; float l_reg = 0.f;
#pragma unroll 1
        for (int t = 0; t < 4; ++t) {
            const lds_cptr kp = kp0 + t * 32768; f32x16 p0 = f32x16{}, p1 = f32x16{};
#pragma unroll
            for (int d0 = 0; d0 < 8; ++d0) { const bf16x8 b0 = *(const __attribute__((address_space(3))) bf16x8*)(kp + d0 * 2048), b1 = *(const __attribute__((address_space(3))) bf16x8*)(kp + d0 * 2048 + 512);
                p0 = __builtin_amdgcn_mfma_f32_32x32x16_bf16(b0, qr[d0], p0, 0, 0, 0); p1 = __builtin_amdgcn_mfma_f32_32x32x16_bf16(b1, qr[d0], p1, 0, 0, 0); }
            float sacc = 0.f;
#pragma unroll
            for (int r = 0; r < 16; ++r) { p0[r] = __builtin_amdgcn_exp2f(p0[r]); p1[r] = __builtin_amdgcn_exp2f(p1[r]); sacc += p0[r] + p1[r]; }
            l_reg += sacc;
            u32x4 pw0, pw1, pw2, pw3;
            pw0 = (u32x4){cvtpk_s(p0[0], p0[1]), cvtpk_s(p0[2], p0[3]), cvtpk_s(p0[4], p0[5]), cvtpk_s(p0[6], p0[7])}; pw1 = (u32x4){cvtpk_s(p0[8], p0[9]), cvtpk_s(p0[10], p0[11]), cvtpk_s(p0[12], p0[13]), cvtpk_s(p0[14], p0[15])};
            pw2 = (u32x4){cvtpk_s(p1[0], p1[1]), cvtpk_s(p1[2], p1[3]), cvtpk_s(p1[4], p1[5]), cvtpk_s(p1[6], p1[7])}; pw3 = (u32x4){cvtpk_s(p1[8], p1[9]), cvtpk_s(p1[10], p1[11]), cvtpk_s(p1[12], p1[13]), cvtpk_s(p1[14], p1[15])};
            const lds_cptr vp = vp0 + t * 32768;
#pragma unroll
            for (int d0 = 0; d0 < 4; ++d0) {
#pragma unroll
                for (int ks = 0; ks < 4; ++ks) { const s16x4 lo = vtr(vp + d0 * 4096 + ks * 1024), hh = vtr(vp + d0 * 4096 + ks * 1024 + 512);
                    const bf16x8 vf = (bf16x8){lo[0], lo[1], lo[2], lo[3], hh[0], hh[1], hh[2], hh[3]};
                    const bf16x8 pa = ks == 0 ? __builtin_bit_cast(bf16x8, pw0) : (ks == 1 ? __builtin_bit_cast(bf16x8, pw1) : (ks == 2 ? __builtin_bit_cast(bf16x8, pw2) : __builtin_bit_cast(bf16x8, pw3)));
                    o[d0] = __builtin_amdgcn_mfma_f32_32x32x16_bf16(pa, vf, o[d0], 0, 0, 0); } }
        }
        { auto rr = __builtin_amdgcn_permlane32_swap(__float_as_uint(l_reg), __float_as_uint(l_reg), false, false); l_reg = __uint_as_float(rr[0]) + __uint_as_float(rr[1]); }
        const float il = __builtin_amdgcn_rcpf(l_reg);
        unsigned short* Ow = (unsigned short*)MO + row0 * MPITCH + head * 128 + r32;
#pragma unroll
        for (int r = 0; r < 16; ++r) { const int q = crow(r, hi); const float ilq = shl(il, q);
#pragma unroll
            for (int d0 = 0; d0 < 4; ++d0) { const float v = o[d0][r] * ilq; Ow[(size_t)q * MPITCH + 32 * d0] = (unsigned short)(cvtpk_s(v, v) & 0xffffu); } }
    }
    asm volatile("s_waitcnt lgkmcnt(0)\n\ts_barrier" ::: "memory");
}
}

#ifndef FAST_MEMKV
#define FAST_MEMKV 1
#endif
#ifndef FAST_INPROJ
#define FAST_INPROJ 1
#endif
#ifndef FAST_MERGE
#define FAST_MERGE 1
#endif
#ifndef FAST_WOUT
#define FAST_WOUT 1
#endif
#ifndef FAST_FFN
#define FAST_FFN 1
#endif
#ifndef FAST_MOE
#define FAST_MOE 1
#endif
#ifndef FAST_FOX
#define FAST_FOX 1
#endif
#ifndef FAST_MEMATTN
#define FAST_MEMATTN 1
#endif
struct MemKvOrder {
    int G, c;
    __device__ __forceinline__ bool next(int i, pg8::Unit& u) const { const int L = i * G + c; if (L >= 64) return false; const int l = L >> 5, r = L & 31; u.pm = 8 * l + (r >> 2); u.pn = r & 3; u.aux = l; return true; }
    __device__ __forceinline__ void ptrs(const pg8::Gemm& g, const pg8::Unit& u, const char*& a, const char*& b) const {
        a = (const char*)g.A + (size_t)u.pm * (size_t)(256 * 2) * g.K; b = (const char*)g.Bt + (size_t)u.aux * (size_t)(1024 * 1024 * 2) + (size_t)u.pn * (size_t)(256 * 2) * g.K; }
    __device__ __forceinline__ void a_ready(const pg8::Unit&) const {}
    __device__ __forceinline__ void done(const pg8::Unit&) const {}
};

__global__ void __launch_bounds__(NTHREADS, 2) mk_fwd(Args args) {
    extern __shared__ __attribute__((aligned(16))) unsigned char lds[];
    Frame F;
    F.lds = (LAS unsigned char*)lds; F.MISC = (volatile LAS unsigned*)(F.lds + MISC_OFF);
    F.tid = threadIdx.x; F.lane = F.tid & 63; F.wave = __builtin_amdgcn_readfirstlane(F.tid >> 6);
    F.G = gridDim.x; { const int bx = blockIdx.x; F.vcu = (F.G % 8 == 0) ? (bx % 8) * (F.G / 8) + bx / 8 : bx; }
    F.ws = args.ws; F.ctl = (gu32*)(args.ws + WS_CTL); F.X = args.out;
    for (int u = F.tid; u < (LDS_BYTES - LDSCTL_OFF) / 4; u += NTHREADS) ((LAS unsigned*)(F.lds + LDSCTL_OFF))[u] = 0u;
    __syncthreads();
    (void)xcd_barrier_post((unsigned*)(F.ctl + CW_BAR), F.MISC + 8);
#define REFRESH() do { int w_ = F.wave; asm volatile("" : "+s"(w_)); F.wave = w_; int l_; asm volatile("v_mbcnt_lo_u32_b32 %0, -1, 0\n\tv_mbcnt_hi_u32_b32 %0, -1, %0" : "=v"(l_)); F.lane = l_; F.tid = w_ * 64 + l_; \
    int v_ = F.vcu; asm volatile("" : "+s"(v_)); F.vcu = v_; \
    GAS unsigned char* g_ = (GAS unsigned char*)F.ws; asm volatile("" : "+s"(g_)); F.ws = (unsigned char*)g_; GAS float* x_ = (GAS float*)F.X; asm volatile("" : "+s"(x_)); F.X = (float*)x_; } while (0)
#define SEAM() do { XcdBarrier b_; b_.bar = (unsigned*)(F.ws + WS_CTL) + CW_BAR; b_.x = xb_xcc_id(); b_.st = (volatile LAS unsigned*)(F.lds + MISC_OFF) + 8; xcd_barrier(b_); REFRESH(); } while (0)
    { volatile LAS unsigned long long* PT = (volatile LAS unsigned long long*)(F.lds + PTR_OFF);
      if (F.tid == 0) {
#define PUT_(i) PT[i] = (unsigned long long)(uintptr_t)args.in[i];
        PUT_(0) PUT_(1) PUT_(2) PUT_(3) PUT_(4) PUT_(5) PUT_(6) PUT_(7) PUT_(8) PUT_(9) PUT_(10) PUT_(11) PUT_(12) PUT_(13) PUT_(14) PUT_(15) PUT_(16) PUT_(17) PUT_(18) PUT_(19) PUT_(20) PUT_(21) PUT_(22) PUT_(23)
#undef PUT_
      }
      __syncthreads(); }
#define INP(i) inptr(F, (i))
#define WSP (F.ws)
#define ARP (F.ws + WS_AR)
    LAS unsigned char* const ring = F.lds + RING_OFF;
    const int bx = (int)blockIdx.x;

    conv_phase(F); REFRESH();
    memnorm_phase(F, INP(I_MEM), INP(I_MEMG)); SEAM();
#if FAST_MEMKV
    { pg8::Gemm g{(const bf16*)(WSP + WS_MEMN), (const bf16*)(WSP + W_KV), DEPTH * MROWS, 1024, D}; MemKvOrder S{F.G, bx};
      pg8::EpiF32 E{(float*)(WSP + WS_KVF), 1024, nullptr};
      pg8::gemm_phase<pg8::EpiF32, MemKvOrder, true, true>(ring, g, S, E, F.tid); }
#else
    n_memkv(F, INP(I_WKV));
#endif
    SEAM();
    kvfin_phase(F, INP(I_MKG)); SEAM();

#pragma unroll 1
    for (int l = 0; l < DEPTH; ++l) {
        const float* xin = (l == 0) ? INP(I_X) : (const float*)F.X;
        norm_phase<1>(F, xin, INP(I_MIXG) + l * D, INP(I_WIN) + (size_t)l * D * NIN + OFF_F, NIN, INP(I_BF) + l * FH, (bf16*)(WSP + WS_H)); SEAM();
        cumsum_phase(F); REFRESH();
#if FAST_INPROJ
        { pg8::Gemm g{(const bf16*)(WSP + WS_H), (const bf16*)(WSP + W_IN) + (size_t)l * 5632 * 1024, T, 5632, D}; pg8::StaticOrder S; S.init(T, 5632, F.G, bx);
          pg8::EpiInProj E{(bf16*)(ARP + AR_U), (bf16*)(ARP + AR_Q), (bf16*)(ARP + AR_K), (bf16*)(ARP + AR_V), (bf16*)(ARP + AR_G), (float*)(ARP + AR_MQ), INP(I_FQG) + l * FD, INP(I_FKG) + l * FD};
          pg8::gemm_phase<pg8::EpiInProj, pg8::StaticOrder, true, true>(ring, g, S, E, F.tid); }
#else
        n_inproj(F, INP(I_WIN) + (size_t)l * D * NIN, INP(I_FQG) + l * FD, INP(I_FKG) + l * FD);
#endif
        SEAM();
        pool_phase(F); REFRESH();
#if FAST_MEMATTN
        { const int combo = F.vcu >> 3;
          memattn::mem_unit(combo >> 2, combo & 3, 2 * (F.vcu & 7), 2, (const float*)(ARP + AR_MQ), (const attn_body::bf16*)(WSP + WS_KM) + (size_t)l * MROWS * 512, (const attn_body::bf16*)(WSP + WS_VM) + (size_t)l * MROWS * 512,
                            (attn_body::bf16*)(ARP + AR_MO), INP(I_MQG) + l * MD, (char*)lds + RING_OFF, F.tid); }
#else
        n_memattn(F, l, INP(I_MQG) + l * MD); __syncthreads();
#endif
        REFRESH();
#if FAST_FOX
        { static_assert(attn_body::LDS_BYTES_ALL <= RING_BYTES, "attention LDS");
          const attn_body::AttnTensors AT{(const attn_body::bf16*)(ARP + AR_Q), (const attn_body::bf16*)(ARP + AR_K), (const attn_body::bf16*)(ARP + AR_V), (attn_body::bf16*)(ARP + AR_Q), (const float*)(WSP + WS_CL)};
          const attn_body::StaticOrder S(F.vcu);
          attn_body::attn_phase<attn_body::StaticOrder>((char*)lds + RING_OFF, AT, S, F.tid); }
#else
        n_fox(F);
#endif
        SEAM();
#if FAST_MERGE
        { pg8::Gemm g{nullptr, nullptr, T, 1024, 512}; typedef pg8::MergeOrder<AR_PD, (FAST_FOX ? AR_Q : AR_FO), AR_MO> MOrd; MOrd S; S.so.init(T, 1024, F.G, bx);
          S.arena = (const char*)ARP; S.Bbase = (const char*)(WSP + W_BR) + (size_t)(l * 3) * 1024 * 512 * 2;
          pg8::EpiMerge E{(const bf16*)(ARP + AR_G), (bf16*)(WSP + WS_H)};
          pg8::gemm_phase<pg8::EpiMerge, MOrd, true, true>(ring, g, S, E, F.tid); }
#else
        n_poolo(F, INP(I_POOLW) + (size_t)l * 4 * 128 * 128, INP(I_POOLS) + l * 512); SEAM();
        n_merge(F, INP(I_WPBR) + (size_t)l * 512 * D, INP(I_WFBR) + (size_t)l * 512 * D, INP(I_WMBR) + (size_t)l * 512 * D);
#endif
        SEAM();
#if FAST_WOUT
        { pg8::Gemm g{(const bf16*)(WSP + WS_H), (const bf16*)(WSP + W_OUT) + (size_t)l * 1024 * 1024, T, 1024, D}; pg8::StaticOrder S; S.init(T, 1024, F.G, bx);
          pg8::EpiF32 E{F.X, 1024, xin};
          pg8::gemm_phase<pg8::EpiF32, pg8::StaticOrder, true, true>(ring, g, S, E, F.tid); }
#else
        n_resgemm(F, xin, (const bf16*)(WSP + WS_H), D, INP(I_WOUT) + (size_t)l * D * D);
#endif
        SEAM();
        if (l == 0) {
            norm_phase<0>(F, F.X, INP(I_FFNG) + l * D, nullptr, 0, nullptr, (bf16*)(WSP + WS_H)); SEAM();
#if FAST_FFN
            { pg8::Gemm g{(const bf16*)(WSP + WS_H), (const bf16*)(WSP + W_GU), T, 2 * DFF, D}; pg8::StaticOrder S; S.init(T, 2 * DFF, F.G, bx);
              pg8::EpiSwiGLU E{(bf16*)(ARP + AR_ACT), DFF};
              pg8::gemm_phase<pg8::EpiSwiGLU, pg8::StaticOrder, true, true>(ring, g, S, E, F.tid); }
            SEAM();
            { pg8::Gemm g{(const bf16*)(ARP + AR_ACT), (const bf16*)(WSP + W_DN), T, 1024, DFF}; pg8::StaticOrder S; S.init(T, 1024, F.G, bx);
              pg8::EpiF32 E{F.X, 1024, F.X};
              pg8::gemm_phase<pg8::EpiF32, pg8::StaticOrder, true, true>(ring, g, S, E, F.tid); }
            SEAM();
#else
            n_ffn_up(F, INP(I_WGU), DFF, -1); SEAM();
            n_ffn_down(F, INP(I_WDN), DFF, -1); SEAM();
#endif
        } else {
#if FAST_MOE
            norm_phase<2>(F, F.X, INP(I_FFNG) + l * D, INP(I_WR), NE, INP(I_BR), (bf16*)(WSP + WS_H2)); SEAM();
            moe_scatter_phase(F, (const bf16*)(WSP + WS_H2)); SEAM();
            const int ntile = __builtin_amdgcn_readfirstlane(((const int*)(WSP + WS_META))[0]); const int* tile_e = (const int*)(WSP + WS_META) + 16;
            { pg8::Gemm g{(const bf16*)(WSP + WS_HS), (const bf16*)(WSP + W_EGU), ntile * 256, 2 * DEXP, D}; pg8::GroupedOrder S; S.so.init(ntile * 256, 2 * DEXP, F.G, bx); S.tile_e = tile_e; S.bstride = (size_t)2 * DEXP * D * 2;
              pg8::EpiSwiGLU E{(bf16*)(WSP + WS_ACTE), DEXP};
              pg8::gemm_phase<pg8::EpiSwiGLU, pg8::GroupedOrder, true, true>(ring, g, S, E, F.tid); }
            SEAM();
            { pg8::Gemm g{(const bf16*)(WSP + WS_ACTE), (const bf16*)(WSP + W_EDN), ntile * 256, 1024, DEXP}; pg8::GroupedOrder S; S.so.init(ntile * 256, 1024, F.G, bx); S.tile_e = tile_e; S.bstride = (size_t)DEXP * D * 2;
              pg8::EpiBf16P E{(bf16*)(WSP + WS_YB), 1024};
              pg8::gemm_phase<pg8::EpiBf16P, pg8::GroupedOrder, true, true>(ring, g, S, E, F.tid); }
            SEAM();
            moe_combine_phase(F);
#else
            norm_phase<2>(F, F.X, INP(I_FFNG) + l * D, INP(I_WR), NE, INP(I_BR), (bf16*)(WSP + WS_H)); SEAM();
#pragma unroll 1
            for (int e = 0; e < NE; ++e) {
                n_ffn_up(F, INP(I_WEGU) + (size_t)e * D * 2 * DEXP, DEXP, e); SEAM();
                n_ffn_down(F, INP(I_WEDN) + (size_t)e * DEXP * D, DEXP, e); SEAM();
            }
#endif
        }
    }
}

#undef WSP
#undef ARP
extern "C" void kernel_launch(void* const* d_in, const int* in_sizes, int n_in, void* d_out, int out_size, void* d_ws, size_t ws_size, hipStream_t stream) {
    static int grid = 0;
    if (grid == 0) {
        if (n_in != N_IN_ || in_sizes[0] != T * D || out_size != T * D || ws_size < WS_END) {
            fprintf(stderr, "kernel_launch: unexpected shapes: n_in %d in0 %d out %d ws %zu (need %zu)\n", n_in, n_in > 0 ? in_sizes[0] : -1, out_size, ws_size, (size_t)WS_END); grid = -1; return; }
        int dev = 0, cus = 0, per_cu = 0;
        if (hipGetDevice(&dev) != hipSuccess || hipDeviceGetAttribute(&cus, hipDeviceAttributeMultiprocessorCount, dev) != hipSuccess) { grid = -1; return; }
        if (hipFuncSetAttribute((const void*)mk_fwd, hipFuncAttributeMaxDynamicSharedMemorySize, LDS_BYTES) != hipSuccess) { fprintf(stderr, "kernel_launch: hipFuncSetAttribute failed\n"); grid = -1; return; }
        if (hipOccupancyMaxActiveBlocksPerMultiprocessor(&per_cu, (const void*)mk_fwd, NTHREADS, LDS_BYTES) != hipSuccess || per_cu < 1) { fprintf(stderr, "kernel_launch: occupancy query says %d\n", per_cu); }
        (void)hipGetLastError();
        if (cus < 256) { fprintf(stderr, "kernel_launch: built for 256 CUs, found %d\n", cus); grid = -1; return; }
        grid = 256;
    }
    if (grid < 0) return;
    if (hipMemsetAsync((char*)d_ws + WS_CTL, 0, CTL_ZERO_BYTES, stream) != hipSuccess) return;
    Args a{};
    for (int i = 0; i < N_IN_; ++i) a.in[i] = (const float*)d_in[i];
    a.out = (float*)d_out; a.ws = (unsigned char*)d_ws; a.ph_lo = 0; a.ph_hi = 0;
    hipLaunchKernelGGL(mk_fwd, dim3(grid), dim3(NTHREADS), LDS_BYTES, stream, a);
}
```

```cpp
#include <hip/hip_runtime.h>
#include <hip/hip_bf16.h>
#include <cstdio>
#include <cstdint>

constexpr int D = 1024, BATCH = 8, SEQ = 4096, T = BATCH * SEQ, DEPTH = 2;
constexpr int NMEM = 256, MROWS = BATCH * NMEM;
constexpr int FH = 8, FD = 64, MH = 4, MD = 128;
constexpr int DFF = 2816, NE = 8, DEXP = 3584;
constexpr int OFF_POOL = 0, OFF_Q = 512, OFF_K = 1024, OFF_V = 1536, OFF_F = 2048, OFF_MQ = 2056, OFF_G = 2568, NIN = 5640;
constexpr float EPS = 1e-6f;
constexpr float LOG2E = 1.4426950408889634f;
constexpr float C2F = 0.125f * LOG2E;
constexpr float C2M = 0.08838834764831845f * LOG2E;
constexpr int NWAVES = 8, NTHREADS = 512;

enum { I_X = 0, I_MEM, I_MIXG, I_WIN, I_BF, I_FQG, I_FKG, I_POOLW, I_POOLS, I_MEMG, I_WKV, I_MQG, I_MKG, I_WPBR, I_WFBR, I_WMBR, I_WOUT, I_FFNG, I_WGU, I_WDN, I_WR, I_BR, I_WEGU, I_WEDN, N_IN_ };

constexpr size_t MiB = 1u << 20;
constexpr size_t WS_CTL = 0, CTL_ZERO_BYTES = 1 * MiB;
constexpr size_t WS_THR = 5 * MiB, WS_SSQ = 6 * MiB;
constexpr size_t WS_LOGF = 1 * MiB, WS_CL = 2 * MiB, WS_CHOICE = 3 * MiB, WS_WCNT = 3 * MiB + 512 * 1024;
constexpr size_t WS_W = 8 * MiB;
constexpr size_t WS_MEMN = 232 * MiB, WS_KVF = 240 * MiB, WS_KM = 256 * MiB, WS_VM = 260 * MiB;
constexpr size_t WS_H = 264 * MiB;
constexpr size_t WS_AR = 328 * MiB;
constexpr size_t AR_U = 0, AR_Q = 32 * MiB, AR_K = 64 * MiB, AR_V = 96 * MiB, AR_MQ = 128 * MiB, AR_G = 192 * MiB, AR_PD = 384 * MiB, AR_MO = 416 * MiB, AR_PO = 448 * MiB, AR_FO = 480 * MiB;
constexpr size_t AR_ACT = 0;
constexpr size_t WS_END = 896 * MiB;

constexpr int CW_TMO = 0, CW_CODE = 1, CW_BAR = 4096, CW_ATTQ = 8192;

#define GAS __attribute__((address_space(1)))
#define LAS __attribute__((address_space(3)))
typedef unsigned short bf16;
typedef unsigned v4u __attribute__((ext_vector_type(4)));
typedef unsigned v2u __attribute__((ext_vector_type(2)));
typedef float f32x4 __attribute__((ext_vector_type(4)));
typedef GAS unsigned gu32;
#define RLX_AGENT __ATOMIC_RELAXED, __HIP_MEMORY_SCOPE_AGENT
__device__ __forceinline__ float bf2f(unsigned v) { return __uint_as_float(v << 16); }
__device__ __forceinline__ unsigned f2bf(float f) { unsigned u = __float_as_uint(f); return (u + 0x7fffu + ((u >> 16) & 1u)) >> 16; }
__device__ __forceinline__ unsigned pk2(float lo, float hi) { return f2bf(lo) | (f2bf(hi) << 16); }
__device__ __forceinline__ unsigned f8x4(float a, float b, float c, float d) {
    a = __builtin_amdgcn_fmed3f(a, -448.f, 448.f); b = __builtin_amdgcn_fmed3f(b, -448.f, 448.f); c = __builtin_amdgcn_fmed3f(c, -448.f, 448.f); d = __builtin_amdgcn_fmed3f(d, -448.f, 448.f);
    int w = 0; w = __builtin_amdgcn_cvt_pk_fp8_f32(a, b, w, false); w = __builtin_amdgcn_cvt_pk_fp8_f32(c, d, w, true); return (unsigned)w; }
constexpr float F8_ACT = 8.0f, F8_WDN = 2048.0f;
constexpr float I8_H = 28.0f, I8_X1 = 24.0f, I8_W = 900.0f, I8_BIAS = 12582912.0f;
__device__ __forceinline__ unsigned i8x4(float a, float b, float c, float d) {
    const float M = 12582912.0f;
    const unsigned ia = __float_as_uint(__builtin_amdgcn_fmed3f(a, -127.f, 127.f) + M), ib = __float_as_uint(__builtin_amdgcn_fmed3f(b, -127.f, 127.f) + M),
                   ic = __float_as_uint(__builtin_amdgcn_fmed3f(c, -127.f, 127.f) + M), id = __float_as_uint(__builtin_amdgcn_fmed3f(d, -127.f, 127.f) + M);
    return (ia & 0xffu) | ((ib & 0xffu) << 8) | ((ic & 0xffu) << 16) | (id << 24); }
__device__ __forceinline__ float shx(float v, int mask, int lane) { return __int_as_float(__builtin_amdgcn_ds_bpermute((lane ^ mask) << 2, __float_as_int(v))); }
__device__ __forceinline__ int shxi(int v, int mask, int lane) { return __builtin_amdgcn_ds_bpermute((lane ^ mask) << 2, v); }
__device__ __forceinline__ float shl(float v, int src) { return __int_as_float(__builtin_amdgcn_ds_bpermute(src << 2, __float_as_int(v))); }
__device__ __forceinline__ int shli(int v, int src) { return __builtin_amdgcn_ds_bpermute(src << 2, v); }
__device__ __forceinline__ float wave_sum(float v, int lane) {
#pragma unroll
    for (int o = 1; o < 64; o <<= 1) v += shx(v, o, lane);
    return v;
}
__device__ __forceinline__ float log_sigmoid_f(float x) { return fminf(x, 0.f) - 0.6931471805599453f * __builtin_amdgcn_logf(1.0f + __builtin_amdgcn_exp2f(fabsf(x) * -1.4426950408889634f)); }
__device__ __forceinline__ float sigmoid_f(float x) { return 1.0f / (1.0f + expf(-x)); }

#define XB_TMO      128
#define XB_XCNT(j)  (256  + 64 * (j))
#define XB_XSUB(j)  (1280 + 64 * (j))
#define XB_XGEN(j)  (2304 + 64 * (j))
#define XB_TOP      3328
#define XB_TOPGEN   3392
#define XCD_BAR_WORDS 3456
#define XB_SPIN_CAP (1u << 22)

__device__ __forceinline__ unsigned xb_ld(unsigned* p)              { return __hip_atomic_load(p, __ATOMIC_RELAXED, __HIP_MEMORY_SCOPE_AGENT); }
__device__ __forceinline__ unsigned xb_add(unsigned* p, unsigned v) { return __hip_atomic_fetch_add(p, v, __ATOMIC_RELAXED, __HIP_MEMORY_SCOPE_AGENT); }
__device__ __forceinline__ unsigned xb_xcc_id() { return (unsigned)__builtin_amdgcn_s_getreg((3 << 11) | 20) & 0xFu; }
#define XB_SPIN(cond, bar) do { unsigned _sp = 0; while (cond) { __builtin_amdgcn_s_sleep(1); \
    if ((++_sp & 255u) == 0u) { if (xb_ld(&(bar)[XB_TMO])) break; if (_sp > XB_SPIN_CAP) { atomicAdd(&(bar)[XB_TMO], 1u); break; } } } } while (0)

struct XcdBarrier { unsigned* bar; unsigned x; volatile LAS unsigned* st; };

__device__ __forceinline__ XcdBarrier xcd_barrier_post(unsigned* bar, volatile LAS unsigned* st) {
    XcdBarrier b; b.bar = bar; b.x = xb_xcc_id(); b.st = st;
    if (threadIdx.x == 0) (void)xb_add(&bar[XB_XCNT(b.x)], 1u);
    return b;
}
__device__ __forceinline__ void xcd_barrier_complete(unsigned* bar, unsigned x, unsigned& nloc, unsigned& nx) {
    const unsigned G = gridDim.x * gridDim.y * gridDim.z;
    unsigned sum, cnt, mine, sp = 0u;
    for (;;) {
        sum = 0u; cnt = 0u; mine = 0u;
#pragma unroll
        for (unsigned j = 0; j < 16; ++j) { const unsigned c = xb_ld(&bar[XB_XCNT(j)]); sum += c; cnt += (c > 0u) ? 1u : 0u; mine = (j == x) ? c : mine; }
        if (sum == G) break;
        __builtin_amdgcn_s_sleep(1);
        if ((++sp & 255u) == 0u) { if (xb_ld(&bar[XB_TMO])) break; if (sp > XB_SPIN_CAP) { atomicAdd(&bar[XB_TMO], 1u); break; } }
    }
    nloc = mine > 0u ? mine : 1u; nx = cnt > 0u ? cnt : 1u;
}
__device__ __forceinline__ void xcd_barrier(const XcdBarrier& b) {
    asm volatile("s_waitcnt vmcnt(0)" ::: "memory");
    __syncthreads();
    if (threadIdx.x == 0) {
        unsigned* bar = b.bar;
        __builtin_amdgcn_s_waitcnt(0);
        unsigned nloc = b.st[0], nx = b.st[1];
        if (nloc == 0u) { xcd_barrier_complete(bar, b.x, nloc, nx); b.st[0] = nloc; b.st[1] = nx; }
        const unsigned old = xb_add(&bar[XB_XSUB(b.x)], 1u);
        const unsigned gen = old / nloc;
        if (old + 1u == (gen + 1u) * nloc) {
            __builtin_amdgcn_fence(__ATOMIC_RELEASE, "agent");
            asm volatile("s_waitcnt vmcnt(0)" ::: "memory");
            const unsigned og = xb_add(&bar[XB_TOP], 1u);
            const unsigned tg = og / nx;
            if (og + 1u == (tg + 1u) * nx) xb_add(&bar[XB_TOPGEN], 1u);
            else XB_SPIN(xb_ld(&bar[XB_TOPGEN]) == tg, bar);
            __builtin_amdgcn_fence(__ATOMIC_ACQUIRE, "agent");
            xb_add(&bar[XB_XGEN(b.x)], 1u);
            asm volatile("s_waitcnt vmcnt(0)" ::: "memory");
        } else {
            XB_SPIN(xb_ld(&bar[XB_XGEN(b.x)]) == gen, bar);
            __builtin_amdgcn_fence(__ATOMIC_ACQUIRE, "agent");
            asm volatile("s_waitcnt vmcnt(0)" ::: "memory");
        }
    }
    __syncthreads();
}

constexpr int RING_OFF = 0, RING_BYTES = 131072;
constexpr int LDSCTL_OFF = RING_BYTES, MISC_OFF = LDSCTL_OFF + 320;
constexpr int TILE_OFF = RING_BYTES + 2048, STG_OFF = RING_BYTES + 4096, LDS_BYTES = 155648;

struct Args { const float* in[N_IN_]; float* out; unsigned char* ws; int ph_lo, ph_hi; };
struct Frame {
    LAS unsigned char* lds; volatile LAS unsigned* MISC; gu32* ctl;
    int tid, lane, wave, vcu, G;
    float* X; unsigned char* ws;
};
struct Choice { int e1, e2; float w1, w2; };
constexpr int PTR_OFF = LDSCTL_OFF + 1024;
__device__ __forceinline__ const float* inptr(const Frame& F, int i) {
    int z = 0; asm volatile("" : "+v"(z));
    const volatile LAS unsigned* p = (const volatile LAS unsigned*)(F.lds + PTR_OFF + z) + 2 * i;
    const unsigned lo = __builtin_amdgcn_readfirstlane(p[0]), hi = __builtin_amdgcn_readfirstlane(p[1]);
    return (const float*)(const GAS float*)(uintptr_t)(((unsigned long long)hi << 32) | lo);
}

template <int MODE, bool XB16 = false>
__device__ __forceinline__ void norm_phase(Frame& F, const float* xin, const float* g, const float* W8, int ldw8, const float* b8, bf16* Hout, const int gw, const int NGW) {
    const int lane = F.lane;
    f32x4 gv[4];
#pragma unroll
    for (int j = 0; j < 4; ++j) gv[j] = *(const f32x4*)(g + 256 * j + 4 * lane);
    LAS f32x4* tab = (LAS f32x4*)(F.lds + RING_OFF);
    if (MODE != 0) {
        for (int q = F.tid; q < 2048; q += NTHREADS) { const int ln = q & 63, hf = (q >> 6) & 1, ji = q >> 7; const int k = 256 * (ji >> 2) + 4 * ln + (ji & 3);
            tab[q] = *(const f32x4*)(W8 + (size_t)k * ldw8 + 4 * hf); }
        __syncthreads();
    }
    f32x4 wt[4][4][2];
    if (MODE != 0) {
#pragma unroll
        for (int j = 0; j < 4; ++j)
#pragma unroll
            for (int i = 0; i < 4; ++i) { wt[j][i][0] = tab[((j * 4 + i) * 2 + 0) * 64 + lane]; wt[j][i][1] = tab[((j * 4 + i) * 2 + 1) * 64 + lane]; }
    }
    int cnt[8];
#pragma unroll
    for (int e = 0; e < 8; ++e) cnt[e] = 0;
    for (int m = gw; m < T; m += NGW) {
        f32x4 v[4]; float ss = 0.f;
        if (XB16) { const v2u* xr = (const v2u*)((const bf16*)xin + (size_t)m * D) + lane;
#pragma unroll
            for (int j = 0; j < 4; ++j) { const v2u w = xr[64 * j]; v[j] = (f32x4){bf2f(w[0] & 0xffffu), bf2f(w[0] >> 16), bf2f(w[1] & 0xffffu), bf2f(w[1] >> 16)}; }
        } else { const f32x4* xr = (const f32x4*)(xin + (size_t)m * D) + lane;
#pragma unroll
            for (int j = 0; j < 4; ++j) v[j] = xr[64 * j]; }
#pragma unroll
        for (int j = 0; j < 4; ++j) ss += (v[j][0] * v[j][0] + v[j][1] * v[j][1]) + (v[j][2] * v[j][2] + v[j][3] * v[j][3]);
        ss = wave_sum(ss, lane);
        const float rstd = 1.0f / sqrtf(ss * (1.0f / D) + EPS);
        if (MODE != 0) {
            unsigned* o4 = (unsigned*)((unsigned char*)Hout + (size_t)m * D) + lane;
#pragma unroll
            for (int j = 0; j < 4; ++j) { v[j] = v[j] * rstd * gv[j]; o4[64 * j] = i8x4(v[j][0] * I8_H, v[j][1] * I8_H, v[j][2] * I8_H, v[j][3] * I8_H); }
        } else {
        unsigned long long* o8 = (unsigned long long*)(Hout + (size_t)m * D) + lane;
#pragma unroll
        for (int j = 0; j < 4; ++j) { v[j] = v[j] * rstd * gv[j]; o8[64 * j] = (unsigned long long)pk2(v[j][0], v[j][1]) | ((unsigned long long)pk2(v[j][2], v[j][3]) << 32); }
        }
        if (MODE != 0) {
            float p[8];
#pragma unroll
            for (int e = 0; e < 8; ++e) p[e] = 0.f;
#pragma unroll
            for (int j = 0; j < 4; ++j)
#pragma unroll
                for (int i = 0; i < 4; ++i) { const f32x4 wa = wt[j][i][0], wb = wt[j][i][1]; const float hv = v[j][i];
                    p[0] = fmaf(hv, wa[0], p[0]); p[1] = fmaf(hv, wa[1], p[1]); p[2] = fmaf(hv, wa[2], p[2]); p[3] = fmaf(hv, wa[3], p[3]);
                    p[4] = fmaf(hv, wb[0], p[4]); p[5] = fmaf(hv, wb[1], p[5]); p[6] = fmaf(hv, wb[2], p[6]); p[7] = fmaf(hv, wb[3], p[7]);
                    }
            float k4[4];
            { const bool hi = (lane & 32) != 0;
#pragma unroll
              for (int i = 0; i < 4; ++i) { const float keep = hi ? p[4 + i] : p[i], send = hi ? p[i] : p[4 + i]; k4[i] = keep + shx(send, 32, lane); } }
            float k2[2];
            { const bool hi = (lane & 16) != 0;
#pragma unroll
              for (int i = 0; i < 2; ++i) { const float keep = hi ? k4[2 + i] : k4[i], send = hi ? k4[i] : k4[2 + i]; k2[i] = keep + shx(send, 16, lane); } }
            float k1;
            { const bool hi = (lane & 8) != 0; const float keep = hi ? k2[1] : k2[0], send = hi ? k2[0] : k2[1]; k1 = keep + shx(send, 8, lane); }
            k1 += shx(k1, 4, lane); k1 += shx(k1, 2, lane); k1 += shx(k1, 1, lane);
            const int e_mine = ((lane >> 5) & 1) * 4 + ((lane >> 4) & 1) * 2 + ((lane >> 3) & 1);
            const float val = k1 + b8[e_mine];
            if (MODE == 1) {
                if ((lane & 7) == 0) { const int b = m / SEQ, s = m % SEQ; ((float*)(F.ws + WS_LOGF))[(size_t)(b * FH + e_mine) * SEQ + s] = log_sigmoid_f(val); }
            } else {
                float lg[8];
#pragma unroll
                for (int e = 0; e < 8; ++e) lg[e] = shl(val, ((e >> 2) & 1) * 32 + ((e >> 1) & 1) * 16 + (e & 1) * 8);
                float b1 = -INFINITY, b2 = -INFINITY; int i1 = 0, i2 = 0;
#pragma unroll
                for (int e = 0; e < 8; ++e) { if (lg[e] > b1) { b2 = b1; i2 = i1; b1 = lg[e]; i1 = e; } else if (lg[e] > b2) { b2 = lg[e]; i2 = e; } }
                const float ex = __builtin_amdgcn_exp2f((b2 - b1) * 1.4426950408889634f), w1 = 1.0f / (1.0f + ex), w2 = ex / (1.0f + ex);
                if (lane == 0) { Choice c; c.e1 = i1; c.e2 = i2; c.w1 = w1; c.w2 = w2; ((Choice*)(F.ws + WS_CHOICE))[m] = c; }
#pragma unroll
                for (int e = 0; e < 8; ++e) cnt[e] += (i1 == e) + (i2 == e);
            }
        }
    }
    if (MODE != 0) __syncthreads();
    if (MODE == 2) {
        int mine = 0;
#pragma unroll
        for (int e = 0; e < 8; ++e) mine = (lane == e) ? cnt[e] : mine;
        if (lane < 8) ((int*)(F.ws + WS_WCNT))[gw * 8 + lane] = mine;
    }
}

__device__ __forceinline__ void cumsum_phase(Frame& F, const float* fqg, const float* fkg) {
    if (F.vcu >= BATCH * FH) return;
    if (F.wave == 0) { float mq = fabsf(fqg[F.lane]), mk = fabsf(fkg[F.lane]);
#pragma unroll
      for (int o = 1; o < 64; o <<= 1) { mq = fmaxf(mq, shx(mq, o, F.lane)); mk = fmaxf(mk, shx(mk, o, F.lane)); }
      if (F.lane == 0) ((float*)(F.ws + WS_THR))[F.vcu] = 2.0f * (8.0f * LOG2E * mq * mk) + 32.0f; }
    const float* lf = (const float*)(F.ws + WS_LOGF) + (size_t)F.vcu * SEQ + 8 * F.tid;
    float* cl = (float*)(F.ws + WS_CL) + (size_t)F.vcu * SEQ + 8 * F.tid;
    const f32x4 a = *(const f32x4*)lf, b = *(const f32x4*)(lf + 4);
    double p[8]; p[0] = (double)a[0]; p[1] = p[0] + (double)a[1]; p[2] = p[1] + (double)a[2]; p[3] = p[2] + (double)a[3];
    p[4] = p[3] + (double)b[0]; p[5] = p[4] + (double)b[1]; p[6] = p[5] + (double)b[2]; p[7] = p[6] + (double)b[3];
    double inc = p[7];
#pragma unroll
    for (int o = 1; o < 64; o <<= 1) { const int src = (F.lane >= o ? F.lane - o : F.lane); const unsigned long long bits = __builtin_bit_cast(unsigned long long, inc);
        const unsigned lo_ = (unsigned)shli((int)(unsigned)bits, src), hi_ = (unsigned)shli((int)(unsigned)(bits >> 32), src); const double t = __builtin_bit_cast(double, ((unsigned long long)hi_ << 32) | lo_); if (F.lane >= o) inc += t; }
    volatile LAS double* wt = (volatile LAS double*)(F.lds + RING_OFF);
    if (F.lane == 63) wt[F.wave] = inc;
    __syncthreads();
    double off = inc - p[7];
    for (int w = 0; w < F.wave; ++w) off += wt[w];
    f32x4 oa, ob;
    oa[0] = (float)((off + p[0]) * 1.4426950408889634); oa[1] = (float)((off + p[1]) * 1.4426950408889634); oa[2] = (float)((off + p[2]) * 1.4426950408889634); oa[3] = (float)((off + p[3]) * 1.4426950408889634);
    ob[0] = (float)((off + p[4]) * 1.4426950408889634); ob[1] = (float)((off + p[5]) * 1.4426950408889634); ob[2] = (float)((off + p[6]) * 1.4426950408889634); ob[3] = (float)((off + p[7]) * 1.4426950408889634);
    *(f32x4*)cl = oa; *(f32x4*)(cl + 4) = ob;
    __syncthreads();
}

__device__ __forceinline__ void pool_phase(Frame& F) {
    const bf16* U = (const bf16*)(F.ws + WS_AR + AR_U); bf16* PD = (bf16*)(F.ws + WS_AR + AR_PD);
    const int lane = F.lane, gw = F.vcu * NWAVES + F.wave, NGW = F.G * NWAVES;
    const int wsel = lane >> 4, w = 2 << wsel;
    for (int chk = gw; chk < T / 16; chk += NGW) {
        const int m0 = chk * 16, t0 = m0 % SEQ;
        v4u x[31];
#pragma unroll
        for (int kk = 0; kk < 31; ++kk) { x[kk] = (v4u){0u, 0u, 0u, 0u}; if (t0 + kk - 15 >= 0 && kk + w > 15) x[kk] = *(const v4u*)(U + (size_t)(m0 - 15 + kk) * 512 + 8 * lane); }
        float s[8];
#pragma unroll
        for (int i = 0; i < 8; ++i) s[i] = 0.f;
#pragma unroll
        for (int j = 0; j < 16; ++j) {
#pragma unroll
            for (int i = 0; i < 4; ++i) { s[2 * i] += bf2f(x[15 - j][i] & 0xffffu); s[2 * i + 1] += bf2f(x[15 - j][i] >> 16); } }
#pragma unroll
        for (int q = 0; q < 16; ++q) {
            if (q > 0) {
                const v4u in = x[15 + q];
                v4u out;
#pragma unroll
                for (int i = 0; i < 4; ++i) out[i] = wsel == 0 ? x[13 + q][i] : (wsel == 1 ? x[11 + q][i] : (wsel == 2 ? x[7 + q][i] : x[q - 1][i]));
#pragma unroll
                for (int i = 0; i < 4; ++i) { s[2 * i] += bf2f(in[i] & 0xffffu) - bf2f(out[i] & 0xffffu); s[2 * i + 1] += bf2f(in[i] >> 16) - bf2f(out[i] >> 16); }
            }
            const int tt = t0 + q; const int n = (tt + 1 < w) ? (tt + 1) : w;
            const float inv = 1.0f / (float)n; const v4u cur = x[15 + q]; v4u o;
#pragma unroll
            for (int i = 0; i < 4; ++i) o[i] = pk2(s[2 * i] * inv - bf2f(cur[i] & 0xffffu), s[2 * i + 1] * inv - bf2f(cur[i] >> 16));
            *(v4u*)(PD + (size_t)(m0 + q) * 512 + 8 * lane) = o;
        }
    }
}

__device__ __forceinline__ void memnorm_phase(Frame& F, const float* mem, const float* memg) {
    const int lane = F.lane, gw = F.vcu * NWAVES + F.wave, NGW = F.G * NWAVES;
    for (int it = gw; it < DEPTH * MROWS; it += NGW) {
        const int l = it / MROWS, r = it % MROWS;
        const f32x4* xr = (const f32x4*)(mem + (size_t)r * D) + lane; const float* g = memg + l * D;
        f32x4 v[4]; float ss = 0.f;
#pragma unroll
        for (int j = 0; j < 4; ++j) { v[j] = xr[64 * j]; ss += (v[j][0] * v[j][0] + v[j][1] * v[j][1]) + (v[j][2] * v[j][2] + v[j][3] * v[j][3]); }
        ss = wave_sum(ss, lane); const float rstd = 1.0f / sqrtf(ss * (1.0f / D) + EPS);
        unsigned long long* o8 = (unsigned long long*)((bf16*)(F.ws + WS_MEMN) + (size_t)it * D) + lane;
#pragma unroll
        for (int j = 0; j < 4; ++j) { const f32x4 h = v[j] * rstd * *(const f32x4*)(g + 256 * j + 4 * lane); o8[64 * j] = (unsigned long long)pk2(h[0], h[1]) | ((unsigned long long)pk2(h[2], h[3]) << 32); }
    }
}
__device__ __forceinline__ void kvfin_phase(Frame& F, const float* mkg) {
    const int lane = F.lane, gw = F.vcu * NWAVES + F.wave, NGW = F.G * NWAVES;
    for (int it = gw; it < DEPTH * MROWS; it += NGW) {
        const int l = it / MROWS;
        const f32x4* xr = (const f32x4*)((const float*)(F.ws + WS_KVF) + (size_t)it * 1024) + lane;
        f32x4 v[4];
#pragma unroll
        for (int j = 0; j < 4; ++j) v[j] = xr[64 * j];
        unsigned long long* ok = (unsigned long long*)((bf16*)(F.ws + WS_KM) + (size_t)it * 512) + lane;
        unsigned long long* ov = (unsigned long long*)((bf16*)(F.ws + WS_VM) + (size_t)it * 512) + lane;
#pragma unroll
        for (int j = 0; j < 2; ++j) {
            float ss = (v[j][0] * v[j][0] + v[j][1] * v[j][1]) + (v[j][2] * v[j][2] + v[j][3] * v[j][3]);
#pragma unroll
            for (int o = 1; o < 32; o <<= 1) ss += shx(ss, o, lane);
            const float rstd = 1.0f / sqrtf(ss * (1.0f / MD) + EPS);
            const f32x4 gg = *(const f32x4*)(mkg + l * MD + 4 * (lane & 31));
            const f32x4 h = v[j] * rstd * gg; ok[64 * j] = (unsigned long long)pk2(h[0], h[1]) | ((unsigned long long)pk2(h[2], h[3]) << 32);
        }
#pragma unroll
        for (int j = 0; j < 2; ++j) { const f32x4 h = v[2 + j]; ov[64 * j] = (unsigned long long)pk2(h[0], h[1]) | ((unsigned long long)pk2(h[2], h[3]) << 32); }
    }
}

namespace pg8 {
#define PG8_LAS __attribute__((address_space(3)))
typedef unsigned short bf16_t;
typedef short bf16x8 __attribute__((ext_vector_type(8)));
typedef float f32x4 __attribute__((ext_vector_type(4)));
typedef unsigned u32x4 __attribute__((ext_vector_type(4)));
constexpr int BM = 256, BK = 64, HALF = 128, HTB = HALF * BK * 2  , STAGE_BYTES = 8 * HTB, NXCD = 8, WGM = 8;

__host__ __device__ __forceinline__ int lds_byte(int r, int c) { const int st = (r >> 4) * 2 + (c >> 5), rr = r & 15, cc = c & 31, ob = rr * 64 + cc * 2; return st * 1024 + (ob ^ (((ob >> 9) & 1) << 5)); }
__host__ __device__ __forceinline__ void stage_rc(int b, int& R, int& C) { const int st = b / 1024, sb = b % 1024, swz = sb ^ (((sb >> 9) & 1) << 5); R = (st >> 1) * 16 + swz / 64; C = (st & 1) * 32 + (swz % 64) / 2; }
__host__ __device__ __forceinline__ int perm32(int rho) { const int n = rho >> 4, i = rho & 15; return 8 * (i >> 2) + 4 * n + (i & 3); }

struct Unit { int pm, pn, aux; };
struct Gemm { const bf16_t* A; const bf16_t* Bt; int M, N, K; int ntk = 0; };

struct StaticOrder {
    int nM, nN, nwg, G, c;
    __host__ __device__ void init(int M, int N, int G_, int c_) { nM = M / BM; nN = N / BM; nwg = nM * nN; G = G_; c = c_; }
    __host__ __device__ bool next(int i, Unit& u) const {
        const long L = (long)i * G + c; if (L >= nwg) return false;
        int wgid = (int)L; { const int q = nwg / NXCD, r = nwg % NXCD, xcd = wgid % NXCD, off = wgid / NXCD; wgid = (xcd < r ? xcd * (q + 1) : r * (q + 1) + (xcd - r) * q) + off; }
        const int nig = WGM * nN, gid = wgid / nig, fm = gid * WGM, gsz = (nM - fm) < WGM ? (nM - fm) : WGM;
        u.pm = fm + ((wgid % nig) % gsz); u.pn = (wgid % nig) / gsz; u.aux = 0; return true;
    }
    __device__ __forceinline__ void ptrs(const Gemm& g, const Unit& u, const char*& a, const char*& b) const { a = (const char*)g.A + (size_t)u.pm * (size_t)(BM * 2) * g.K; b = (const char*)g.Bt + (size_t)u.pn * (size_t)(BM * 2) * g.K; }
    __device__ __forceinline__ void a_ready(const Unit&) const {}
    __device__ __forceinline__ void done(const Unit&) const {}
};

typedef float f32x2_cv __attribute__((ext_vector_type(2))); typedef __bf16 bf16x2_cv __attribute__((ext_vector_type(2)));
__device__ __forceinline__ unsigned cvt_pk_bf16(float lo, float hi) { const f32x2_cv v = {lo, hi}; const bf16x2_cv b = __builtin_convertvector(v, bf16x2_cv); return __builtin_bit_cast(unsigned, b); }

typedef int i32x4_t __attribute__((ext_vector_type(4))); typedef int i32x8_t __attribute__((ext_vector_type(8)));
__device__ __forceinline__ i32x8_t cat8(const bf16x8& a, const bf16x8& b) { return __builtin_shufflevector(__builtin_bit_cast(i32x4_t, a), __builtin_bit_cast(i32x4_t, b), 0, 1, 2, 3, 4, 5, 6, 7); }
template <class Epi, class Sched, bool ALIGN_EPI = false, bool SP2 = false, bool RELAX = false, int OPM = 0>
__device__ __forceinline__ void gemm_phase(PG8_LAS unsigned char* lds, const Gemm g, const Sched& S, const Epi& E, const int tid_opaque) {
    constexpr bool F8 = (OPM == 1), I8 = (OPM == 2);
    constexpr float ACC0 = I8 ? I8_BIAS : 0.0f;
    const int tid = tid_opaque, wid = __builtin_amdgcn_readfirstlane(tid >> 6), lane = tid & 63, wr = wid >> 2, wc = wid & 3, fr = lane & 15, fq = lane >> 4;
    const int K = g.K, nt = g.ntk ? g.ntk : K / BK;
    unsigned voffA[2], voffB[2];
#pragma unroll
    for (int i = 0; i < 2; ++i) { int R, C; stage_rc(tid * 16 + i * 8192, R, C); const int Rb = Epi::PERM ? ((R & ~31) + perm32(R & 31)) : R;
        voffA[i] = (unsigned)(R * K + C) * 2u; voffB[i] = (unsigned)(Rb * K + C) * 2u; }
    const size_t kstep = (size_t)(BK * 2);
    const size_t hstep = (size_t)HALF * K * 2;
    const unsigned ldsw = (unsigned)wid * 1024u;
    const int aoff = lds_byte(wr * 64 + fr, fq * 8), boff = lds_byte(wc * 32 + fr, fq * 8);
#define PG8_SA(b, h) (((b) * 2 + (h)) * HTB)
#define PG8_SB(b, h) ((4 + (b) * 2 + (h)) * HTB)
    const unsigned ldsbase = (unsigned)__builtin_amdgcn_readfirstlane((int)(unsigned)(uintptr_t)lds) + ldsw;
#define PG8_STAGE(bufoff, gbase, voff) do { if constexpr (OPM != 0) { const unsigned long long gb_ = (unsigned long long)(uintptr_t)(gbase); \
        const unsigned long long gbu_ = ((unsigned long long)(unsigned)__builtin_amdgcn_readfirstlane((int)(unsigned)(gb_ >> 32)) << 32) | (unsigned)__builtin_amdgcn_readfirstlane((int)(unsigned)gb_); \
        _Pragma("unroll") for (int _i = 0; _i < 2; ++_i) { const unsigned la_ = ldsbase + (unsigned)(bufoff) + (unsigned)_i * 8192u; \
            asm volatile("s_mov_b32 m0, %0\n\ts_nop 0\n\tglobal_load_lds_dwordx4 %1, %2" :: "s"(la_), "v"((voff)[_i]), "s"(gbu_) : "memory"); } } \
      else { _Pragma("unroll") for (int _i = 0; _i < 2; ++_i) \
        __builtin_amdgcn_global_load_lds((const unsigned*)((const char*)(gbase) + (voff)[_i]), (PG8_LAS unsigned*)(lds + (bufoff) + ldsw + _i * 8192), 16, 0, 0); } } while (0)
#define PG8_LDA(dst, b, h) do { _Pragma("unroll") for (int m = 0; m < 4; ++m) _Pragma("unroll") for (int k = 0; k < 2; ++k) dst[m][k] = *(const PG8_LAS bf16x8*)(lds + PG8_SA(b, h) + aoff + m * 2048 + k * 1024); } while (0)
#define PG8_LDB(dst, b, h) do { _Pragma("unroll") for (int n = 0; n < 2; ++n) _Pragma("unroll") for (int k = 0; k < 2; ++k) dst[n][k] = *(const PG8_LAS bf16x8*)(lds + PG8_SB(b, h) + boff + n * 2048 + k * 1024); } while (0)
#define PG8_MMA(ai, bj, At, Bt) do { __builtin_amdgcn_s_setprio(1); \
        if constexpr (F8) { _Pragma("unroll") for (int m = 0; m < 4; ++m) _Pragma("unroll") for (int n = 0; n < 2; ++n) \
            acc[ai][bj][m][n] = __builtin_amdgcn_mfma_scale_f32_16x16x128_f8f6f4(cat8(Bt[n][0], Bt[n][1]), cat8(At[m][0], At[m][1]), acc[ai][bj][m][n], 0, 0, 0, 0, 0, 0); } \
        else if constexpr (I8) { _Pragma("unroll") for (int m = 0; m < 4; ++m) _Pragma("unroll") for (int n = 0; n < 2; ++n) _Pragma("unroll") for (int k = 0; k < 2; ++k) \
            acc[ai][bj][m][n] = __builtin_bit_cast(f32x4, __builtin_amdgcn_mfma_i32_16x16x64_i8(__builtin_bit_cast(i32x4_t, Bt[n][k]), __builtin_bit_cast(i32x4_t, At[m][k]), __builtin_bit_cast(i32x4_t, acc[ai][bj][m][n]), 0, 0, 0)); } \
        else { _Pragma("unroll") for (int m = 0; m < 4; ++m) _Pragma("unroll") for (int n = 0; n < 2; ++n) _Pragma("unroll") for (int k = 0; k < 2; ++k) \
            acc[ai][bj][m][n] = __builtin_amdgcn_mfma_f32_16x16x32_bf16(Bt[n][k], At[m][k], acc[ai][bj][m][n], 0, 0, 0); } \
        __builtin_amdgcn_s_setprio(0); } while (0)
#define PG8_WAIT_V(n) asm volatile("s_waitcnt vmcnt(" #n ")" ::: "memory")
#define PG8_WAIT_L(n) asm volatile("s_waitcnt lgkmcnt(" #n ")" ::: "memory")
#define PG8_BAR __builtin_amdgcn_s_barrier()
#define PG8_SCHED __builtin_amdgcn_sched_barrier(0)
    Unit cur, nxt; int ui = 0;
    if (!S.next(0, cur)) return;
    f32x4 acc[2][2][4][2];
    float a0_ = ACC0; if constexpr (I8) asm volatile("" : "+s"(a0_));
#pragma unroll
    for (int a = 0; a < 2; ++a)
#pragma unroll
        for (int b = 0; b < 2; ++b)
#pragma unroll
            for (int m = 0; m < 4; ++m)
#pragma unroll
                for (int n = 0; n < 2; ++n) acc[a][b][m][n] = (f32x4){a0_, a0_, a0_, a0_};
    bf16x8 At[4][2], B0[2][2], B1[2][2];
    const char* cA; const char* cB; S.ptrs(g, cur, cA, cB);
    S.a_ready(cur);
    if constexpr (SP2) {
        PG8_STAGE(PG8_SB(0, 0), cB, voffB); PG8_STAGE(PG8_SB(0, 1), cB + hstep, voffB); PG8_STAGE(PG8_SA(0, 0), cA, voffA); PG8_STAGE(PG8_SA(0, 1), cA + hstep, voffA);
        if (wr == 1) PG8_BAR;
        PG8_WAIT_V(2); PG8_BAR;
        PG8_STAGE(PG8_SB(1, 0), cB + kstep, voffB); PG8_STAGE(PG8_SA(1, 0), cA + kstep, voffA); PG8_STAGE(PG8_SB(1, 1), cB + hstep + kstep, voffB);
        PG8_WAIT_V(6); PG8_BAR;
    } else {
        PG8_STAGE(PG8_SB(0, 0), cB, voffB); PG8_STAGE(PG8_SA(0, 0), cA, voffA); PG8_STAGE(PG8_SB(0, 1), cB + hstep, voffB); PG8_STAGE(PG8_SA(0, 1), cA + hstep, voffA);
        if (wr == 1) PG8_BAR;
        PG8_WAIT_V(4); PG8_BAR;
        PG8_STAGE(PG8_SB(1, 0), cB + kstep, voffB); PG8_STAGE(PG8_SA(1, 0), cA + kstep, voffA); PG8_STAGE(PG8_SB(1, 1), cB + hstep + kstep, voffB);
        PG8_WAIT_V(6); PG8_BAR;
    }
    static_assert(SP2, "the relaxed waits are written for the two-super-phase loop");
    constexpr int NV = RELAX ? Epi::NVMEM : 0;
#define PG8_WAIT_VRELAX() do { if constexpr (NV >= 32) PG8_WAIT_V(42); else if constexpr (NV >= 16) PG8_WAIT_V(26); else if constexpr (NV >= 8) PG8_WAIT_V(18); else PG8_WAIT_V(8); } while (0)
#define PG8_WAIT_V8() PG8_WAIT_V(8)
#define PG8_KITER(t, WAITX, STAGE1) do { \
            const bool last = ((t) == nt - 2); \
            const char* a1 = cA + (size_t)((t) + 1) * kstep; \
            const char* a2 = last ? nA : cA + (size_t)((t) + 2) * kstep; const char* b2 = last ? nB : cB + (size_t)((t) + 2) * kstep; \
            const char* a3 = a2 + kstep; const char* b3 = b2 + kstep; \
            if (last && has_next) S.a_ready(nxt); \
              \
            PG8_LDB(B0, 0, 0); PG8_LDB(B1, 0, 1); PG8_SCHED; PG8_LDA(At, 0, 0); if (STAGE1) PG8_STAGE(PG8_SA(1, 1), a1 + hstep, voffA); \
            WAITX(); PG8_WAIT_L(0); PG8_BAR; PG8_MMA(0, 0, At, B0); PG8_MMA(0, 1, At, B1); PG8_BAR; PG8_SCHED; \
              \
            PG8_LDA(At, 0, 1); PG8_STAGE(PG8_SB(0, 0), b2, voffB); PG8_STAGE(PG8_SB(0, 1), b2 + hstep, voffB); PG8_STAGE(PG8_SA(0, 0), a2, voffA); \
            WAITX(); PG8_WAIT_L(0); PG8_BAR; PG8_MMA(1, 0, At, B0); PG8_MMA(1, 1, At, B1); PG8_BAR; PG8_SCHED; \
              \
            PG8_LDB(B0, 1, 0); PG8_LDB(B1, 1, 1); PG8_SCHED; PG8_LDA(At, 1, 0); PG8_STAGE(PG8_SA(0, 1), a2 + hstep, voffA); \
            WAITX(); PG8_WAIT_L(0); PG8_BAR; PG8_MMA(0, 0, At, B0); PG8_MMA(0, 1, At, B1); PG8_BAR; PG8_SCHED; \
              \
            PG8_LDA(At, 1, 1); PG8_STAGE(PG8_SB(1, 0), b3, voffB); PG8_STAGE(PG8_SB(1, 1), b3 + hstep, voffB); PG8_STAGE(PG8_SA(1, 0), a3, voffA); \
            PG8_WAIT_V(8); PG8_WAIT_L(0); PG8_BAR; PG8_MMA(1, 0, At, B0); PG8_MMA(1, 1, At, B1); PG8_BAR; PG8_SCHED; } while (0)
    for (;;) {
        const bool has_next = S.next(ui + 1, nxt);
        const char* nA = cA; const char* nB = cB; if (has_next) S.ptrs(g, nxt, nA, nB);
        int t = 0;
        if constexpr (NV > 0) if (ui > 0) { PG8_KITER(0, PG8_WAIT_VRELAX, true); t = 2; }
#pragma unroll 1
        for (; t < nt; t += 2) PG8_KITER(t, PG8_WAIT_V8, true);
        if constexpr (ALIGN_EPI) { if (wr == 0) PG8_BAR; }
        if (has_next && NV > 0) PG8_STAGE(PG8_SA(1, 1), nA + kstep + hstep, voffA);
        if constexpr (!Epi::AFTER_DRAIN) { int el_; asm volatile("v_mbcnt_lo_u32_b32 %0, -1, 0\n\tv_mbcnt_hi_u32_b32 %0, -1, %0" : "=v"(el_)); const int efr = el_ & 15, efq = el_ >> 4;
            E(acc, cur, wr, wc, efr, efq); S.done(cur); }
        if (!has_next) break;
        float a1_ = ACC0; if constexpr (I8) asm volatile("" : "+s"(a1_));
        if (E.zero_after(cur))
#pragma unroll
        for (int a = 0; a < 2; ++a)
#pragma unroll
            for (int b = 0; b < 2; ++b)
#pragma unroll
                for (int m = 0; m < 4; ++m)
#pragma unroll
                    for (int n = 0; n < 2; ++n) acc[a][b][m][n] = (f32x4){a1_, a1_, a1_, a1_};
        cur = nxt; cA = nA; cB = nB; ++ui;
        if constexpr (ALIGN_EPI) { if (wr == 1) PG8_BAR; }
    }
    PG8_WAIT_V(0);
    if constexpr (!ALIGN_EPI) { if (wr == 0) PG8_BAR; }
    PG8_BAR;
    if constexpr (Epi::AFTER_DRAIN) { E.fused(acc, cur, wr, wc, fr, fq, lds, wid, lane); S.done(cur); }
#undef PG8_SA
#undef PG8_SB
#undef PG8_STAGE
#undef PG8_LDA
#undef PG8_LDB
#undef PG8_MMA
#undef PG8_WAIT_V
#undef PG8_WAIT_VRELAX
#undef PG8_WAIT_V8
#undef PG8_KITER
#undef PG8_WAIT_L
#undef PG8_BAR
#undef PG8_SCHED
}
}

namespace pg8 {
typedef unsigned u32x2 __attribute__((ext_vector_type(2)));
__device__ __forceinline__ float fsigmoid(float x) { return __builtin_amdgcn_rcpf(1.0f + __builtin_amdgcn_exp2f(x * -1.4426950408889634f)); }
__device__ __forceinline__ u32x4 pack8(const f32x4& a, const f32x4& b) { u32x4 w; w.x = cvt_pk_bf16(a[0], a[1]); w.y = cvt_pk_bf16(a[2], a[3]); w.z = cvt_pk_bf16(b[0], b[1]); w.w = cvt_pk_bf16(b[2], b[3]); return w; }

constexpr int STG_ROW = 144, STG_WAVE = 16 * STG_ROW;
template <bool ST = true> __device__ __forceinline__ void st_rows_bf16(PG8_LAS unsigned char* st, int fr, int fq, const u32x4& w0, const u32x4& w1, bf16_t* gdst, size_t ldc) {
    *(PG8_LAS u32x4*)(st + fr * STG_ROW + 16 * fq) = w0; *(PG8_LAS u32x4*)(st + fr * STG_ROW + 64 + 16 * fq) = w1;
    const int lane = fq * 16 + fr, rr = lane >> 3, ch = lane & 7;
    const u32x4 a = *(const PG8_LAS u32x4*)(st + rr * STG_ROW + ch * 16), b = *(const PG8_LAS u32x4*)(st + (rr + 8) * STG_ROW + ch * 16);
    if (ST) { *(u32x4*)(gdst + (size_t)rr * ldc + ch * 8) = a; *(u32x4*)(gdst + (size_t)(rr + 8) * ldc + ch * 8) = b; } else asm volatile("" :: "v"(a), "v"(b));
}
__device__ __forceinline__ void ld_rows_bf16(PG8_LAS unsigned char* st, int fr, int fq, const bf16_t* gsrc, size_t ldc, u32x4& g0, u32x4& g1) {
    const int lane = fq * 16 + fr, rr = lane >> 3, ch = lane & 7;
    const u32x4 a = *(const u32x4*)(gsrc + (size_t)rr * ldc + ch * 8), b = *(const u32x4*)(gsrc + (size_t)(rr + 8) * ldc + ch * 8);
    *(PG8_LAS u32x4*)(st + rr * STG_ROW + ch * 16) = a; *(PG8_LAS u32x4*)(st + (rr + 8) * STG_ROW + ch * 16) = b;
    g0 = *(const PG8_LAS u32x4*)(st + fr * STG_ROW + 16 * fq); g1 = *(const PG8_LAS u32x4*)(st + fr * STG_ROW + 64 + 16 * fq);
}
template <bool ST = true> __device__ __forceinline__ void st_rows_f32(PG8_LAS unsigned char* st, int fr, int fq, int c0, int c1, const f32x4& v0, const f32x4& v1, float* gdst, const float* gbase, size_t ldc) {
    *(PG8_LAS f32x4*)(st + fr * STG_ROW + c0) = v0; *(PG8_LAS f32x4*)(st + fr * STG_ROW + c1) = v1;
    const int lane = fq * 16 + fr, rr = lane >> 3, ch = lane & 7;
    f32x4 a = *(const PG8_LAS f32x4*)(st + rr * STG_ROW + ch * 16), b = *(const PG8_LAS f32x4*)(st + (rr + 8) * STG_ROW + ch * 16);
    if (gbase) { a += *(const f32x4*)(gbase + (size_t)rr * ldc + ch * 4); b += *(const f32x4*)(gbase + (size_t)(rr + 8) * ldc + ch * 4); }
    if (ST) { *(f32x4*)(gdst + (size_t)rr * ldc + ch * 4) = a; *(f32x4*)(gdst + (size_t)(rr + 8) * ldc + ch * 4) = b; } else asm volatile("" :: "v"(a), "v"(b));
}

struct EpiF32 {
    static constexpr int NVMEM = 32;
    static constexpr bool PERM = false, AFTER_DRAIN = false;
    float* C; int ldc; const float* base; PG8_LAS unsigned char* stg; float sc = 1.0f;
    __device__ __forceinline__ bool zero_after(const Unit&) const { return true; }
    __device__ __forceinline__ void operator()(f32x4 (&acc)[2][2][4][2], const Unit& u, int wr, int wc, int fr, int fq) const {
        PG8_LAS unsigned char* st = stg + (wr * 4 + wc) * STG_WAVE;
        const int row0 = u.pm * BM + wr * 64, col0 = u.pn * BM + wc * 64;
        const int lane = fq * 16 + fr, rr = lane >> 3, ch = lane & 7;
#pragma unroll
        for (int ai = 0; ai < 2; ++ai) {
            f32x4 bv[4][2][2];
            if (base) {
#pragma unroll
                for (int m = 0; m < 4; ++m)
#pragma unroll
                    for (int bj = 0; bj < 2; ++bj) { const float* bp = base + (size_t)(row0 + ai * HALF + m * 16 + rr) * ldc + col0 + 32 * bj + ch * 4;
                        bv[m][bj][0] = *(const f32x4*)bp; bv[m][bj][1] = *(const f32x4*)(bp + (size_t)8 * ldc); }
            }
#pragma unroll
            for (int m = 0; m < 4; ++m)
#pragma unroll
                for (int bj = 0; bj < 2; ++bj) {
                    *(PG8_LAS f32x4*)(st + fr * STG_ROW + 16 * fq) = acc[ai][bj][m][0] * sc; *(PG8_LAS f32x4*)(st + fr * STG_ROW + 64 + 16 * fq) = acc[ai][bj][m][1] * sc;
                    f32x4 a = *(const PG8_LAS f32x4*)(st + rr * STG_ROW + ch * 16), b = *(const PG8_LAS f32x4*)(st + (rr + 8) * STG_ROW + ch * 16);
                    if (base) { a += bv[m][bj][0]; b += bv[m][bj][1]; }
                    float* cp = C + (size_t)(row0 + ai * HALF + m * 16 + rr) * ldc + col0 + 32 * bj + ch * 4;
                    *(f32x4*)cp = a; *(f32x4*)(cp + (size_t)8 * ldc) = b; }
        }
    }
};
template <bool BASEF32, bool SSQ = false>
struct EpiResBf16 {
    static constexpr int NVMEM = 16;
    static constexpr bool PERM = true, AFTER_DRAIN = false;
    bf16_t* O; const void* base; PG8_LAS unsigned char* stg; float* ssq; unsigned char* o8; float sc;
    __device__ __forceinline__ bool zero_after(const Unit&) const { return true; }
    __device__ __forceinline__ void operator()(f32x4 (&acc)[2][2][4][2], const Unit& u, int wr, int wc, int fr, int fq) const {
        PG8_LAS unsigned char* st = stg + (wr * 4 + wc) * STG_WAVE;
        const int row0 = u.pm * BM + wr * 64, col0 = u.pn * BM + wc * 64;
        const int lane = fq * 16 + fr, rr = lane >> 3, ch = lane & 7;
#pragma unroll
        for (int ai = 0; ai < 2; ++ai) {
            if (BASEF32) {
                f32x4 bb[4][2][2];
#pragma unroll
                for (int m = 0; m < 4; ++m)
#pragma unroll
                    for (int bj = 0; bj < 2; ++bj) { const float* bp = (const float*)base + (size_t)(row0 + ai * HALF + m * 16 + fr) * 1024 + col0 + 32 * bj + 8 * fq;
                        bb[m][bj][0] = *(const f32x4*)bp; bb[m][bj][1] = *(const f32x4*)(bp + 4); }
#pragma unroll
                for (int m = 0; m < 4; ++m) { const f32x4 x00 = acc[ai][0][m][0] * sc + bb[m][0][0], x01 = acc[ai][0][m][1] * sc + bb[m][0][1], x10 = acc[ai][1][m][0] * sc + bb[m][1][0], x11 = acc[ai][1][m][1] * sc + bb[m][1][1];
                    const u32x4 w0 = pack8(x00, x01), w1 = pack8(x10, x11);
                    if (o8) { unsigned char* p8 = o8 + (size_t)(row0 + ai * HALF + m * 16 + fr) * 1024 + col0 + 8 * fq; u32x2 a8, b8;
                        a8.x = i8x4(x00[0] * I8_X1, x00[1] * I8_X1, x00[2] * I8_X1, x00[3] * I8_X1); a8.y = i8x4(x01[0] * I8_X1, x01[1] * I8_X1, x01[2] * I8_X1, x01[3] * I8_X1);
                        b8.x = i8x4(x10[0] * I8_X1, x10[1] * I8_X1, x10[2] * I8_X1, x10[3] * I8_X1); b8.y = i8x4(x11[0] * I8_X1, x11[1] * I8_X1, x11[2] * I8_X1, x11[3] * I8_X1);
                        *(u32x2*)p8 = a8; *(u32x2*)(p8 + 32) = b8; }
                    if (SSQ) { float s = 0.f;
#pragma unroll
                        for (int i = 0; i < 4; ++i) { const float a0 = __uint_as_float(w0[i] << 16), a1 = __uint_as_float(w0[i] & 0xffff0000u), b0 = __uint_as_float(w1[i] << 16), b1 = __uint_as_float(w1[i] & 0xffff0000u); s += (a0 * a0 + a1 * a1) + (b0 * b0 + b1 * b1); }
                        s += shx(s, 16, lane); s += shx(s, 32, lane);
                        if (fq == 0) ssq[(size_t)(row0 + ai * HALF + m * 16 + fr) * 16 + 4 * u.pn + wc] = s; }
                    st_rows_bf16(st, fr, fq, w0, w1, O + (size_t)(row0 + ai * HALF + m * 16) * 1024 + col0, 1024); }
            } else {
                u32x4 rb[4][2];
#pragma unroll
                for (int m = 0; m < 4; ++m) { const bf16_t* bp = (const bf16_t*)base + (size_t)(row0 + ai * HALF + m * 16 + rr) * 1024 + col0 + ch * 8; rb[m][0] = *(const u32x4*)bp; rb[m][1] = *(const u32x4*)(bp + (size_t)8 * 1024); }
#pragma unroll
                for (int m = 0; m < 4; ++m) { u32x4 g[2];
                    *(PG8_LAS u32x4*)(st + rr * STG_ROW + ch * 16) = rb[m][0]; *(PG8_LAS u32x4*)(st + (rr + 8) * STG_ROW + ch * 16) = rb[m][1];
                    g[0] = *(const PG8_LAS u32x4*)(st + fr * STG_ROW + 16 * fq); g[1] = *(const PG8_LAS u32x4*)(st + fr * STG_ROW + 64 + 16 * fq);
                    f32x4 v[2][2];
#pragma unroll
                    for (int bj = 0; bj < 2; ++bj) { v[bj][0] = acc[ai][bj][m][0] * sc + (f32x4){__uint_as_float(g[bj][0] << 16), __uint_as_float(g[bj][0] & 0xffff0000u), __uint_as_float(g[bj][1] << 16), __uint_as_float(g[bj][1] & 0xffff0000u)};
                        v[bj][1] = acc[ai][bj][m][1] * sc + (f32x4){__uint_as_float(g[bj][2] << 16), __uint_as_float(g[bj][2] & 0xffff0000u), __uint_as_float(g[bj][3] << 16), __uint_as_float(g[bj][3] & 0xffff0000u)}; }
                    st_rows_bf16(st, fr, fq, pack8(v[0][0], v[0][1]), pack8(v[1][0], v[1][1]), O + (size_t)(row0 + ai * HALF + m * 16) * 1024 + col0, 1024); }
            }
        }
    }
};
struct EpiBf16P {
    static constexpr int NVMEM = 16;
    static constexpr bool PERM = true, AFTER_DRAIN = false;
    bf16_t* O; int ldc; PG8_LAS unsigned char* stg; float sc = 1.0f;
    __device__ __forceinline__ bool zero_after(const Unit&) const { return true; }
    __device__ __forceinline__ void operator()(f32x4 (&acc)[2][2][4][2], const Unit& u, int wr, int wc, int fr, int fq) const {
        PG8_LAS unsigned char* st = stg + (wr * 4 + wc) * STG_WAVE;
        const int row0 = u.pm * BM + wr * 64, col0 = u.pn * BM + wc * 64;
#pragma unroll
        for (int ai = 0; ai < 2; ++ai)
#pragma unroll
            for (int m = 0; m < 4; ++m)
                st_rows_bf16(st, fr, fq, pack8(acc[ai][0][m][0] * sc, acc[ai][0][m][1] * sc), pack8(acc[ai][1][m][0] * sc, acc[ai][1][m][1] * sc), O + (size_t)(row0 + ai * HALF + m * 16) * ldc + col0, (size_t)ldc);
    }
};
template <bool RSTD = false, bool F8O = false, int I8A = 0>
struct EpiSwiGLUT {
    static constexpr int NVMEM = 8;
    static constexpr bool PERM = true, AFTER_DRAIN = false;
    bf16_t* O; int ldc; const float* ssq;
    __device__ __forceinline__ bool zero_after(const Unit&) const { return true; }
    __device__ __forceinline__ void operator()(f32x4 (&acc)[2][2][4][2], const Unit& u, int wr, int wc, int fr, int fq) const {
        const int row0 = u.pm * BM + wr * 64 + fr, col0 = u.pn * HALF + wc * 32 + 8 * fq;
        float rsv[2][4];
        if (RSTD) { f32x4 p[2][4];
#pragma unroll
            for (int ai = 0; ai < 2; ++ai)
#pragma unroll
                for (int m = 0; m < 4; ++m) p[ai][m] = *(const f32x4*)(ssq + (size_t)(row0 + ai * HALF + m * 16) * 16 + 4 * fq);
#pragma unroll
            for (int ai = 0; ai < 2; ++ai)
#pragma unroll
                for (int m = 0; m < 4; ++m) { float s = (p[ai][m][0] + p[ai][m][1]) + (p[ai][m][2] + p[ai][m][3]); s += shx(s, 16, fq * 16 + fr); s += shx(s, 32, fq * 16 + fr); rsv[ai][m] = __builtin_amdgcn_rsqf(s * (1.0f / 1024.0f) + EPS); } }
#pragma unroll
        for (int ai = 0; ai < 2; ++ai)
#pragma unroll
            for (int m = 0; m < 4; ++m) { bf16_t* rowp = O + (size_t)(row0 + ai * HALF + m * 16) * ldc + col0; f32x4 r[2]; const float rs = RSTD ? rsv[ai][m] : 1.0f;
#pragma unroll
                for (int n = 0; n < 2; ++n) { constexpr float qa = I8A == 2 ? I8_X1 : I8_H, sg = I8A ? LOG2E / (qa * I8_W) : 1.0f, su = (I8A ? 0.6931471805599453f / (qa * I8_W) : 1.0f) * (F8O ? F8_ACT : 1.0f);
                    const float cg = rs * sg, cu = rs * su, og = I8A ? -I8_BIAS * cg : 0.0f, ou = I8A ? -I8_BIAS * cu : 0.0f;
                    const f32x4 g = acc[ai][0][m][n] * cg + og, up = acc[ai][1][m][n] * cu + ou;
#pragma unroll
                    for (int i = 0; i < 4; ++i) r[n][i] = g[i] * up[i] * __builtin_amdgcn_rcpf(1.0f + __builtin_amdgcn_exp2f(g[i])); }
                if (F8O) { u32x2 w; w.x = f8x4(r[0][0], r[0][1], r[0][2], r[0][3]); w.y = f8x4(r[1][0], r[1][1], r[1][2], r[1][3]); *(u32x2*)((unsigned char*)O + (size_t)(row0 + ai * HALF + m * 16) * ldc + col0) = w; }
                else *(u32x4*)rowp = pack8(r[0], r[1]); }
    }
};
typedef EpiSwiGLUT<false> EpiSwiGLU; typedef EpiSwiGLUT<false, true, 1> EpiSwiGLU8;
template <bool ST = true, bool I8 = false> struct EpiInProjT {
    static constexpr int NVMEM = (ST ? 16 : 0);
    static constexpr bool PERM = true, AFTER_DRAIN = false;
    unsigned char* arena; const float *qg, *kg; PG8_LAS unsigned char* stg;
    __device__ __forceinline__ bool zero_after(const Unit&) const { return true; }
    __device__ __forceinline__ void operator()(f32x4 (&acc)[2][2][4][2], const Unit& u, int wr, int wc, int fr, int fq) const {
        PG8_LAS unsigned char* st = stg + (wr * 4 + wc) * STG_WAVE;
        const int row0 = u.pm * BM + wr * 64, pn = u.pn;
        constexpr float ds = I8 ? 1.0f / (I8_H * I8_W) : 1.0f, dg = I8 ? LOG2E / (I8_H * I8_W) : 1.0f, bs = I8 ? -I8_BIAS * ds : 0.0f, bg = I8 ? -I8_BIAS * dg : 0.0f, b0 = I8 ? I8_BIAS : 0.0f;
        if (pn < 2 || (pn >= 6 && pn < 10)) {
            bf16_t* base = (pn < 2 ? (bf16_t*)(arena + AR_U) + 256 * pn : (pn < 8 ? (bf16_t*)(arena + AR_V) + 256 * (pn - 6) : (bf16_t*)(arena + AR_MQ) + 256 * (pn - 8))) + wc * 64;
#pragma unroll
            for (int ai = 0; ai < 2; ++ai)
#pragma unroll
                for (int m = 0; m < 4; ++m)
                    st_rows_bf16<ST>(st, fr, fq, pack8(acc[ai][0][m][0] * ds + bs, acc[ai][0][m][1] * ds + bs), pack8(acc[ai][1][m][0] * ds + bs, acc[ai][1][m][1] * ds + bs), base + (size_t)(row0 + ai * HALF + m * 16) * 512, 512);
        } else if (pn < 6) {
            const bool isq = pn < 4; const int head = 4 * (pn - (isq ? 2 : 4)) + wc; const float* gg = isq ? qg : kg; const float sc = isq ? C2F : 1.0f;
            f32x4 gv[2][2];
#pragma unroll
            for (int bj = 0; bj < 2; ++bj)
#pragma unroll
                for (int n = 0; n < 2; ++n) gv[bj][n] = *(const f32x4*)(gg + 32 * bj + 8 * fq + 4 * n) * sc;
            bf16_t* base = (bf16_t*)(arena + (isq ? AR_Q : AR_K)) + head * 64;
#pragma unroll
            for (int ai = 0; ai < 2; ++ai)
#pragma unroll
                for (int m = 0; m < 4; ++m) { float ss = 0.f;
#pragma unroll
                    for (int bj = 0; bj < 2; ++bj)
#pragma unroll
                        for (int n = 0; n < 2; ++n) { const f32x4 x = acc[ai][bj][m][n] - b0; acc[ai][bj][m][n] = x; ss += (x[0] * x[0] + x[1] * x[1]) + (x[2] * x[2] + x[3] * x[3]); }
                    ss += shx(ss, 16, fq * 16 + fr); ss += shx(ss, 32, fq * 16 + fr);
                    const float rstd = ds / sqrtf(ss * (ds * ds / 64.0f) + EPS);
                    st_rows_bf16<ST>(st, fr, fq, pack8(acc[ai][0][m][0] * rstd * gv[0][0], acc[ai][0][m][1] * rstd * gv[0][1]), pack8(acc[ai][1][m][0] * rstd * gv[1][0], acc[ai][1][m][1] * rstd * gv[1][1]),
                                 base + (size_t)(row0 + ai * HALF + m * 16) * 512, 512); }
        } else {
            bf16_t* base = (bf16_t*)(arena + AR_G) + 256 * (pn - 10) + wc * 64;
#pragma unroll
            for (int ai = 0; ai < 2; ++ai)
#pragma unroll
                for (int m = 0; m < 4; ++m) { f32x4 r[2][2];
#pragma unroll
                    for (int bj = 0; bj < 2; ++bj)
#pragma unroll
                        for (int n = 0; n < 2; ++n)
#pragma unroll
                            for (int i = 0; i < 4; ++i) r[bj][n][i] = fminf(1.0f + __builtin_amdgcn_exp2f(__builtin_fmaf(acc[ai][bj][m][n][i], dg, bg)), 1e30f);
                    st_rows_bf16<ST>(st, fr, fq, pack8(r[0][0], r[0][1]), pack8(r[1][0], r[1][1]), base + (size_t)(row0 + ai * HALF + m * 16) * 3072, 3072); }
        }
    }
};
typedef EpiInProjT<true> EpiInProj; typedef EpiInProjT<true, true> EpiInProj8;
struct EpiMerge {
    static constexpr int NVMEM = 0;
    static constexpr bool PERM = true, AFTER_DRAIN = false;
    const bf16_t* G; bf16_t* O; PG8_LAS unsigned char* stg;
    __device__ __forceinline__ bool zero_after(const Unit& u) const { return u.aux == 2; }
    __device__ __forceinline__ void operator()(f32x4 (&acc)[2][2][4][2], const Unit& u, int wr, int wc, int fr, int fq) const {
        PG8_LAS unsigned char* st = stg + (wr * 4 + wc) * STG_WAVE;
        const int row0 = u.pm * BM + wr * 64, col0 = u.pn * BM + wc * 64, seg = u.aux;
        const int lane = fq * 16 + fr, rr = lane >> 3, ch = lane & 7;
        u32x4 ra[2][2][2], rb[2][2][2];
#define MRG_LOAD(bf, q) do { _Pragma("unroll") for (int mm = 0; mm < 2; ++mm) { const bf16_t* gp = G + (size_t)(row0 + ((q) >> 1) * HALF + (((q) & 1) * 2 + mm) * 16 + rr) * 3072 + col0 + seg * 1024 + ch * 8; \
            ra[bf][mm][0] = *(const u32x4*)gp; ra[bf][mm][1] = *(const u32x4*)(gp + (size_t)8 * 3072); \
            if (seg < 2) { rb[bf][mm][0] = *(const u32x4*)(gp + 1024); rb[bf][mm][1] = *(const u32x4*)(gp + 1024 + (size_t)8 * 3072); } } } while (0)
        MRG_LOAD(0, 0);
#pragma unroll
        for (int q = 0; q < 4; ++q) { const int ai = q >> 1, bf = q & 1;
            if (q == 0) MRG_LOAD(1, 1); else if (q == 1) MRG_LOAD(0, 2); else if (q == 2) MRG_LOAD(1, 3);
#pragma unroll
            for (int mm = 0; mm < 2; ++mm) { const int m = (q & 1) * 2 + mm; const size_t row = (size_t)(row0 + ai * HALF + m * 16);
                u32x4 ga[2];
                *(PG8_LAS u32x4*)(st + rr * STG_ROW + ch * 16) = ra[bf][mm][0]; *(PG8_LAS u32x4*)(st + (rr + 8) * STG_ROW + ch * 16) = ra[bf][mm][1];
                ga[0] = *(const PG8_LAS u32x4*)(st + fr * STG_ROW + 16 * fq); ga[1] = *(const PG8_LAS u32x4*)(st + fr * STG_ROW + 64 + 16 * fq);
                float f[2][8];
#pragma unroll
                for (int bj = 0; bj < 2; ++bj)
#pragma unroll
                    for (int i = 0; i < 4; ++i) { f[bj][2 * i] = __builtin_amdgcn_rcpf(__uint_as_float(ga[bj][i] << 16)); f[bj][2 * i + 1] = __builtin_amdgcn_rcpf(__uint_as_float(ga[bj][i] & 0xffff0000u)); }
                if (seg < 2) { u32x4 gb[2];
                    *(PG8_LAS u32x4*)(st + rr * STG_ROW + ch * 16) = rb[bf][mm][0]; *(PG8_LAS u32x4*)(st + (rr + 8) * STG_ROW + ch * 16) = rb[bf][mm][1];
                    gb[0] = *(const PG8_LAS u32x4*)(st + fr * STG_ROW + 16 * fq); gb[1] = *(const PG8_LAS u32x4*)(st + fr * STG_ROW + 64 + 16 * fq);
#pragma unroll
                    for (int bj = 0; bj < 2; ++bj)
#pragma unroll
                        for (int i = 0; i < 4; ++i) { f[bj][2 * i] *= __uint_as_float(gb[bj][i] << 16); f[bj][2 * i + 1] *= __uint_as_float(gb[bj][i] & 0xffff0000u); } }
#pragma unroll
                for (int bj = 0; bj < 2; ++bj)
#pragma unroll
                    for (int i = 0; i < 4; ++i) { acc[ai][bj][m][0][i] *= f[bj][i]; acc[ai][bj][m][1][i] *= f[bj][4 + i]; }
                if (seg == 2) st_rows_bf16(st, fr, fq, pack8(acc[ai][0][m][0], acc[ai][0][m][1]), pack8(acc[ai][1][m][0], acc[ai][1][m][1]), O + row * 1024 + col0, 1024); }
        }
#undef MRG_LOAD
    }
};
struct EpiNull {
    static constexpr int NVMEM = 0;
    static constexpr bool PERM = true, AFTER_DRAIN = false;
    __device__ __forceinline__ bool zero_after(const Unit&) const { return true; }
    __device__ __forceinline__ void operator()(f32x4 (&acc)[2][2][4][2], const Unit& u, int wr, int wc, int fr, int fq) const {
#pragma unroll
        for (int ai = 0; ai < 2; ++ai)
#pragma unroll
            for (int m = 0; m < 4; ++m)
#pragma unroll
                for (int bj = 0; bj < 2; ++bj) { asm volatile("" :: "v"(acc[ai][bj][m][0]), "v"(acc[ai][bj][m][1])); }
    }
};
template <size_t O0, size_t O1, size_t O2>
struct MergeOrder {
    StaticOrder so; const char* arena; const char* Bbase;
    __device__ __forceinline__ bool next(int i, Unit& u) const { const int ti = i / 3; if (!so.next(ti, u)) return false; u.aux = i - 3 * ti; return true; }
    __device__ __forceinline__ void ptrs(const Gemm& g, const Unit& u, const char*& a, const char*& b) const {
        const size_t oa = u.aux == 0 ? O0 : (u.aux == 1 ? O1 : O2);
        a = arena + oa + (size_t)u.pm * (size_t)(BM * 2) * g.K; b = Bbase + (size_t)u.aux * (size_t)(1024 * 512 * 2) + (size_t)u.pn * (size_t)(BM * 2) * g.K; }
    __device__ __forceinline__ void a_ready(const Unit&) const {}
    __device__ __forceinline__ void done(const Unit&) const {}
};
struct GroupedOrder {
    StaticOrder so; const volatile PG8_LAS int* tile_e; size_t bstride;
    __device__ __forceinline__ bool next(int i, Unit& u) const { if (!so.next(i, u)) return false; u.aux = __builtin_amdgcn_readfirstlane(tile_e[u.pm]); return true; }
    __device__ __forceinline__ void ptrs(const Gemm& g, const Unit& u, const char*& a, const char*& b) const {
        a = (const char*)g.A + (size_t)u.pm * (size_t)(BM * 2) * g.K; b = (const char*)g.Bt + (size_t)u.aux * bstride + (size_t)u.pn * (size_t)(BM * 2) * g.K; }
    __device__ __forceinline__ void a_ready(const Unit&) const {}
    __device__ __forceinline__ void done(const Unit&) const {}
};
constexpr int TAIL_KS = 7, TAIL_NTK = 4, TAIL_T0 = 256, TAIL_ROWS = 8 * 256;
struct TailOrder {
    int nunits, G, c; const volatile PG8_LAS int* tile_e; size_t bstride;
    __device__ __forceinline__ bool next(int i, Unit& u) const { const int L = i * G + c; if (L >= nunits) return false;
        const int sl = L % TAIL_KS, r = L / TAIL_KS, p = r >> 2; u.pm = sl * 8 + p; u.pn = r & 3; u.aux = __builtin_amdgcn_readfirstlane(tile_e[TAIL_T0 + p]) | (p << 8) | (sl << 16); return true; }
    __device__ __forceinline__ void ptrs(const Gemm& g, const Unit& u, const char*& a, const char*& b) const { const int e = u.aux & 255, p = (u.aux >> 8) & 255, sl = u.aux >> 16;
        a = (const char*)g.A + (size_t)(TAIL_T0 + p) * (size_t)(BM * 2) * g.K + (size_t)sl * (TAIL_NTK * BK * 2); b = (const char*)g.Bt + (size_t)e * bstride + (size_t)u.pn * (size_t)(BM * 2) * g.K + (size_t)sl * (TAIL_NTK * BK * 2); }
    __device__ __forceinline__ void a_ready(const Unit&) const {}
    __device__ __forceinline__ void done(const Unit&) const {}
};
}

constexpr size_t W_IN = 8 * MiB, W_KV = 30 * MiB, W_BR = 34 * MiB, W_OUT = 40 * MiB, W_GU = 44 * MiB, W_DN = 55 * MiB, W_EGU = 64 * MiB, W_EDN = 176 * MiB;
constexpr size_t WS_SLOT = 4 * MiB, WS_META = 4 * MiB + 512 * 1024;
constexpr size_t WS_HS = 264 * MiB, WS_YB = WS_HS, WS_ACTE = 434 * MiB, WS_H2 = 434 * MiB, WS_XB8 = (328 + 192) * MiB;
constexpr int MAXTILES = 264;

struct ConvItem { const float* src; bf16* dst; int K; float sc; bool ok; };
__device__ __forceinline__ int map_w64(int nb) { const int pn = nb >> 3, q = nb & 7; return 256 * pn + 64 * (q & 3) + 32 * (q >> 2); }
__device__ __forceinline__ int map_in(int nb) { const int pn = nb >> 3, q = nb & 7, w = 64 * (q & 3) + 32 * (q >> 2);
    if (pn < 2) return 256 * pn + w;
    if (pn < 4) return OFF_Q + 256 * (pn - 2) + w;
    if (pn < 6) return OFF_K + 256 * (pn - 4) + w;
    if (pn < 8) return OFF_V + 256 * (pn - 6) + w;
    if (pn < 10) return OFF_MQ + 256 * (pn - 8) + w;
    return OFF_G + 256 * (pn - 10) + w; }
__device__ __forceinline__ int map_gu(int nb, int FF) { const int pn = nb >> 3, q = nb & 7; return q < 4 ? 128 * pn + 32 * q : FF + 128 * pn + 32 * (q - 4); }
constexpr int CI_L = 2816 + 512 + 256 + 256 + 512, CI_GU = 2 * CI_L, CI_DN = CI_GU + 2816, CI_E = CI_DN + 1408, CI_PER_E = 3584 + 1792, CI_TOTAL = CI_E + NE * CI_PER_E;
__device__ __forceinline__ void conv_item(Frame& F, int g, const float*& src, int& ldw, unsigned char*& dst, int& K, float& sc, const float*& ksc, int& qk) {
    ksc = nullptr; qk = 0;
    unsigned char* ws = F.ws; int r, nblk, mt = 0, FF = 0; const float* W; bf16* WT;
    if (g < CI_GU) { const int l = g >= CI_L ? 1 : 0; r = g - l * CI_L;
        if (r < 2816) { W = inptr(F, I_WIN) + (size_t)l * D * NIN; ldw = NIN; K = D; nblk = 176; mt = 1; WT = (bf16*)(ws + W_IN + (size_t)l * 5632 * 1024); qk = 2; }
        else if (r < 3328) { r -= 2816; W = inptr(F, I_WKV) + (size_t)l * D * 1024; ldw = 1024; K = D; nblk = 32; WT = (bf16*)(ws + W_KV) + (size_t)l * 1024 * 1024; }
        else if (r < 3584) { r -= 3328; W = inptr(F, I_WFBR) + (size_t)l * 512 * D; ldw = D; K = 512; nblk = 32; WT = (bf16*)(ws + W_BR) + (size_t)(l * 3 + 1) * 1024 * 512; }
        else if (r < 3840) { r -= 3584; W = inptr(F, I_WMBR) + (size_t)l * 512 * D; ldw = D; K = 512; nblk = 32; WT = (bf16*)(ws + W_BR) + (size_t)(l * 3 + 2) * 1024 * 512; }
        else { r -= 3840; W = inptr(F, I_WOUT) + (size_t)l * D * D; ldw = D; K = D; nblk = 32; WT = (bf16*)(ws + W_OUT) + (size_t)l * 1024 * 1024; } }
    else if (g < CI_DN) { r = g - CI_GU; W = inptr(F, I_WGU); ldw = 2 * DFF; K = D; nblk = 176; mt = 2; FF = DFF; WT = (bf16*)(ws + W_GU); ksc = inptr(F, I_FFNG); qk = 2; }
    else if (g < CI_E) { r = g - CI_DN; W = inptr(F, I_WDN); ldw = D; K = DFF; nblk = 32; WT = (bf16*)(ws + W_DN); qk = 1; }
    else { r = g - CI_E; const int e = r / CI_PER_E; r -= e * CI_PER_E;
        if (r < 3584) { W = inptr(F, I_WEGU) + (size_t)e * D * 2 * DEXP; ldw = 2 * DEXP; K = D; nblk = 224; mt = 2; FF = DEXP; WT = (bf16*)(ws + W_EGU + (size_t)e * 7168 * 1024); qk = 2; }
        else { qk = 1; r -= 3584; W = inptr(F, I_WEDN) + (size_t)e * DEXP * D; ldw = D; K = DEXP; nblk = 32; WT = (bf16*)(ws + W_EDN + (size_t)e * 1024 * DEXP); } }
    const int rp = r >> 1, kbp = rp / nblk, nb = rp - kbp * nblk, kb = 2 * kbp + (r & 1);
    const int n0 = mt == 0 ? map_w64(nb) : (mt == 1 ? map_in(nb) : map_gu(nb, FF));
    sc = mt == 1 ? ((nb >> 3) >= 10 ? -LOG2E : 1.0f) : (mt == 2 ? ((nb & 7) < 4 ? -LOG2E : -0.6931471805599453f) : 1.0f);
    if (qk == 2) sc = (sc < 0.f ? -I8_W : I8_W); else if (qk == 1) sc *= F8_WDN;
    const int es = qk ? 1 : 2;
    src = W + (size_t)(64 * kb) * ldw + n0; dst = (unsigned char*)WT + ((size_t)(32 * nb) * K + 64 * kb) * es; if (ksc) ksc += 64 * kb;
}
__device__ __forceinline__ void conv_phase(Frame& F) {
    LAS float* scr = (LAS float*)(F.lds + RING_OFF + F.wave * 16384);
    const int lane = F.lane, gw = F.vcu * NWAVES + F.wave, NGW = F.G * NWAVES;
    const int lr = lane >> 3, lc = (lane & 7) * 4;
    f32x4 v[8]; const float* src; unsigned char* dst; int ldw, K, qk; float sc; const float* ksc;
    int g = 2 * gw;
    if (g < CI_E) { conv_item(F, g, src, ldw, dst, K, sc, ksc, qk);
#pragma unroll
        for (int i = 0; i < 8; ++i) { v[i] = *(const f32x4*)(src + (size_t)(8 * i + lr) * ldw + lc); if (ksc) v[i] *= ksc[8 * i + lr]; } }
    while (g < CI_E) {
#pragma unroll
        for (int i = 0; i < 8; ++i) *(LAS f32x4*)(scr + (8 * i + lr) * 36 + lc) = v[i] * sc;
        unsigned char* const cdst = dst; const int cK = K, cqk = qk;
        g = (g & 1) ? g + 2 * NGW - 1 : g + 1;
        if (g < CI_E) { conv_item(F, g, src, ldw, dst, K, sc, ksc, qk);
#pragma unroll
            for (int i = 0; i < 8; ++i) { v[i] = *(const f32x4*)(src + (size_t)(8 * i + lr) * ldw + lc); if (ksc) v[i] *= ksc[8 * i + lr]; } }
        asm volatile("s_waitcnt lgkmcnt(0)" ::: "memory");
        const int c = lane & 7;
#pragma unroll
        for (int j = 0; j < 4; ++j) { const int n = (lane >> 3) + 8 * j; const LAS float* s = scr + (8 * c) * 36 + n;
            if (cqk == 0) { v4u o; o.x = pk2(s[0 * 36], s[1 * 36]); o.y = pk2(s[2 * 36], s[3 * 36]); o.z = pk2(s[4 * 36], s[5 * 36]); o.w = pk2(s[6 * 36], s[7 * 36]);
                *(v4u*)(cdst + ((size_t)n * cK + 8 * c) * 2) = o; }
            else if (cqk == 1) { v2u o; o.x = f8x4(s[0 * 36], s[1 * 36], s[2 * 36], s[3 * 36]); o.y = f8x4(s[4 * 36], s[5 * 36], s[6 * 36], s[7 * 36]); *(v2u*)(cdst + (size_t)n * cK + 8 * c) = o; }
            else { v2u o; o.x = i8x4(s[0 * 36], s[1 * 36], s[2 * 36], s[3 * 36]); o.y = i8x4(s[4 * 36], s[5 * 36], s[6 * 36], s[7 * 36]); *(v2u*)(cdst + (size_t)n * cK + 8 * c) = o; } }
        asm volatile("s_waitcnt lgkmcnt(0)" ::: "memory");
    }
    for (int it = gw; it < 1024; it += NGW) { const int l = it >> 9, gg = (it >> 7) & 3, nb = (it >> 3) & 15, cb = it & 7;
        const float* pw = inptr(F, I_POOLW) + (size_t)l * 4 * 128 * 128 + (size_t)(gg * 128 + cb * 16) * 128; const float* ps = inptr(F, I_POOLS) + l * 512 + gg * 128;
        const float* wb = inptr(F, I_WPBR) + (size_t)l * 512 * D + (size_t)(gg * 128) * D + 64 * nb + lane;
        asm volatile("s_waitcnt lgkmcnt(0)" ::: "memory");
#pragma unroll
        for (int i = 0; i < 8; ++i) { const int e0 = 4 * (lane + 64 * i), c = e0 >> 7, d0 = e0 & 127; const f32x4 pv = *(const f32x4*)(pw + e0) * *(const f32x4*)(ps + d0);
#pragma unroll
            for (int j = 0; j < 4; ++j) scr[(d0 + j) * 16 + c] = pv[j]; }
        asm volatile("s_waitcnt lgkmcnt(0)" ::: "memory");
        float acc[16];
#pragma unroll
        for (int c = 0; c < 16; ++c) acc[c] = 0.f;
#pragma unroll 1
        for (int d0 = 0; d0 < 128; d0 += 8) { float w[8];
#pragma unroll
            for (int j = 0; j < 8; ++j) w[j] = wb[(size_t)(d0 + j) * D];
#pragma unroll
            for (int j = 0; j < 8; ++j) {
#pragma unroll
                for (int q = 0; q < 4; ++q) { const f32x4 p = *(const LAS f32x4*)(scr + (d0 + j) * 16 + 4 * q);
#pragma unroll
                    for (int i = 0; i < 4; ++i) acc[4 * q + i] = fmaf(p[i], w[j], acc[4 * q + i]); } } }
        const int n = 64 * nb + lane, c = n & 255;
        bf16* wp = (bf16*)(F.ws + W_BR) + (size_t)(l * 3) * 1024 * 512 + (size_t)((n & ~255) + 128 * ((c >> 5) & 1) + 32 * (c >> 6) + (c & 31)) * 512 + gg * 128 + cb * 16;
        v4u o0, o1; o0.x = pk2(acc[0], acc[1]); o0.y = pk2(acc[2], acc[3]); o0.z = pk2(acc[4], acc[5]); o0.w = pk2(acc[6], acc[7]); o1.x = pk2(acc[8], acc[9]); o1.y = pk2(acc[10], acc[11]); o1.z = pk2(acc[12], acc[13]); o1.w = pk2(acc[14], acc[15]);
        *(v4u*)wp = o0; *(v4u*)(wp + 8) = o1; }
}

constexpr int NCV = 48;
struct CvDesc { unsigned char* dst; int K, qk; float sc; bool ok; };
__device__ __forceinline__ void conv_expert_bg(Frame& F, const int gw, const int NGW) {
    LAS float* scr = (LAS float*)(F.lds + RING_OFF + F.wave * 16384);
    const int lane = F.lane, lr = lane >> 3, lc = (lane & 7) * 4;
    const int npair = (CI_TOTAL - CI_E) / 2;
    auto issue = [&](const int j, f32x4 (&v)[8], CvDesc& d) {
        const int p = gw + (j >> 1) * NGW; d.ok = p < npair;
        if (d.ok) { const float* src; int ldw; const float* ksc; conv_item(F, CI_E + 2 * p + (j & 1), src, ldw, d.dst, d.K, d.sc, ksc, d.qk);
#pragma unroll
            for (int i = 0; i < 8; ++i) v[i] = *(const f32x4*)(src + (size_t)(8 * i + lr) * ldw + lc); } };
    auto finish = [&](const f32x4 (&v)[8], const CvDesc& d) {
        if (!d.ok) return;
#pragma unroll
        for (int i = 0; i < 8; ++i) *(LAS f32x4*)(scr + (8 * i + lr) * 36 + lc) = v[i] * d.sc;
        asm volatile("s_waitcnt lgkmcnt(0)" ::: "memory");
        const int c = lane & 7;
#pragma unroll
        for (int j = 0; j < 4; ++j) { const int n = (lane >> 3) + 8 * j; const LAS float* s = scr + (8 * c) * 36 + n; v2u o;
            if (d.qk == 1) { o.x = f8x4(s[0 * 36], s[1 * 36], s[2 * 36], s[3 * 36]); o.y = f8x4(s[4 * 36], s[5 * 36], s[6 * 36], s[7 * 36]); }
            else { o.x = i8x4(s[0 * 36], s[1 * 36], s[2 * 36], s[3 * 36]); o.y = i8x4(s[4 * 36], s[5 * 36], s[6 * 36], s[7 * 36]); }
            *(v2u*)(d.dst + (size_t)n * d.K + 8 * c) = o; }
        asm volatile("s_waitcnt lgkmcnt(0)" ::: "memory"); };
    f32x4 v0[8], v1[8], v2[8]; CvDesc d0, d1, d2;
    issue(0, v0, d0); issue(1, v1, d1); issue(2, v2, d2);
    for (int j = 0; ; j += 3) {
        if (!d0.ok) break;
        finish(v0, d0); issue(j + 3, v0, d0);
        finish(v1, d1); issue(j + 4, v1, d1);
        finish(v2, d2); issue(j + 5, v2, d2);
    }
}

__device__ __forceinline__ void moe_scatter_phase(Frame& F, const unsigned char* H2) {
    const int* WC = (const int*)(F.ws + WS_WCNT); LAS int* sh = (LAS int*)(F.lds + RING_OFF);
    const int tid = F.tid, lane = F.lane, wave = F.wave;
    int before[8], total[8];
    { int s[8];
#pragma unroll
      for (int e = 0; e < 8; ++e) s[e] = 0;
      for (int w = 0; w < 4; ++w) { const int gwv = 4 * tid + w;
#pragma unroll
          for (int e = 0; e < 8; ++e) s[e] += WC[gwv * 8 + e]; }
      const bool isb = tid < 2 * F.vcu;
#pragma unroll
      for (int e = 0; e < 8; ++e) { int t = s[e], b = isb ? s[e] : 0;
#pragma unroll
          for (int o = 1; o < 64; o <<= 1) { t += shxi(t, o, lane); b += shxi(b, o, lane); }
          if (lane == 0) { sh[wave * 16 + e] = b; sh[wave * 16 + 8 + e] = t; } }
      __syncthreads();
#pragma unroll
      for (int e = 0; e < 8; ++e) { int b = 0, t = 0;
#pragma unroll
          for (int w = 0; w < 8; ++w) { b += sh[w * 16 + e]; t += sh[w * 16 + 8 + e]; }
          before[e] = b; total[e] = t; } }
    int seg[8]; int ntile = 0;
#pragma unroll
    for (int e = 0; e < 8; ++e) { seg[e] = ntile * 256; ntile += (total[e] + 255) >> 8; }
    if (F.vcu == 0) { int* meta = (int*)(F.ws + WS_META); if (tid == 0) meta[0] = ntile;
        int te = 0;
#pragma unroll
        for (int e = 1; e < 8; ++e) te += (tid * 256 >= seg[e]) ? 1 : 0;
        if (tid < MAXTILES) meta[16 + tid] = te; }
    int base[8];
#pragma unroll
    for (int e = 0; e < 8; ++e) { int b = before[e]; for (int w = 0; w < wave; ++w) b += WC[(F.vcu * NWAVES + w) * 8 + e]; base[e] = seg[e] + b; }
    const int gw = F.vcu * NWAVES + wave, NGW = F.G * NWAVES;
    const int m = gw + (lane & 15) * NGW; const bool act = lane < 16 && m < T;
    Choice c; c.e1 = -1; c.e2 = -1; c.w1 = 0.f; c.w2 = 0.f;
    if (act) c = ((const Choice*)(F.ws + WS_CHOICE))[m];
    int s1 = 0, s2 = 0;
    const unsigned long long lt = (1ull << lane) - 1ull;
#pragma unroll
    for (int e = 0; e < 8; ++e) { const unsigned long long m1 = __ballot(act && c.e1 == e), m2 = __ballot(act && c.e2 == e);
        if (c.e1 == e) s1 = base[e] + __popcll(m1 & lt);
        if (c.e2 == e) s2 = base[e] + __popcll(m1) + __popcll(m2 & lt); }
    if (act) { int* sl = (int*)(F.ws + WS_SLOT) + 2 * m; sl[0] = s1; sl[1] = s2; }
    unsigned char* HS = F.ws + WS_HS;
    v4u xs[16];
#pragma unroll
    for (int i = 0; i < 16; ++i) { const int mi = gw + i * NGW; xs[i] = (v4u){0u, 0u, 0u, 0u}; if (mi < T) xs[i] = *(const v4u*)(H2 + (size_t)mi * D + 16 * lane); }
#pragma unroll
    for (int i = 0; i < 16; ++i) { const int mi = gw + i * NGW; const int d1 = shli(s1, i), d2 = shli(s2, i);
        if (mi < T) { *(v4u*)(HS + (size_t)d1 * D + 16 * lane) = xs[i]; *(v4u*)(HS + (size_t)d2 * D + 16 * lane) = xs[i]; } }
    __syncthreads();
}
constexpr size_t WS_PART = W_EGU;
__device__ __forceinline__ void yrow(const bf16* YB, const float* PART, int s, int col, f32x4 (&y)[2]) {
    if (s < pg8::TAIL_T0 * 256) { const v4u a = *(const v4u*)(YB + (size_t)s * D + col);
        y[0] = (f32x4){bf2f(a[0] & 0xffffu), bf2f(a[0] >> 16), bf2f(a[1] & 0xffffu), bf2f(a[1] >> 16)}; y[1] = (f32x4){bf2f(a[2] & 0xffffu), bf2f(a[2] >> 16), bf2f(a[3] & 0xffffu), bf2f(a[3] >> 16)}; }
    else { const float* p = PART + (size_t)(s - pg8::TAIL_T0 * 256) * D + col; y[0] = *(const f32x4*)p; y[1] = *(const f32x4*)(p + 4);
#pragma unroll
        for (int sl = 1; sl < pg8::TAIL_KS; ++sl) { y[0] += *(const f32x4*)(p + (size_t)sl * pg8::TAIL_ROWS * D); y[1] += *(const f32x4*)(p + (size_t)sl * pg8::TAIL_ROWS * D + 4); } }
}
__device__ __forceinline__ void moe_combine_phase(Frame& F) {
    const bf16* YB = (const bf16*)(F.ws + WS_YB); const int lane = F.lane;
    for (int m = F.vcu * NWAVES + F.wave; m < T; m += F.G * NWAVES) {
        const Choice c = ((const Choice*)(F.ws + WS_CHOICE))[m]; const int* sl = (const int*)(F.ws + WS_SLOT) + 2 * m; const int s1 = sl[0], s2 = sl[1];
#pragma unroll
        for (int h = 0; h < 2; ++h) { const v4u a = *(const v4u*)(YB + (size_t)s1 * D + 512 * h + 8 * lane), b = *(const v4u*)(YB + (size_t)s2 * D + 512 * h + 8 * lane);
            float* xp = F.X + (size_t)m * D + 512 * h + 8 * lane; f32x4 x0 = *(const f32x4*)xp, x1 = *(const f32x4*)(xp + 4);
#pragma unroll
            for (int i = 0; i < 2; ++i) { x0[2 * i] += c.w1 * bf2f(a[i] & 0xffffu) + c.w2 * bf2f(b[i] & 0xffffu); x0[2 * i + 1] += c.w1 * bf2f(a[i] >> 16) + c.w2 * bf2f(b[i] >> 16);
                x1[2 * i] += c.w1 * bf2f(a[2 + i] & 0xffffu) + c.w2 * bf2f(b[2 + i] & 0xffffu); x1[2 * i + 1] += c.w1 * bf2f(a[2 + i] >> 16) + c.w2 * bf2f(b[2 + i] >> 16); }
            *(f32x4*)xp = x0; *(f32x4*)(xp + 4) = x1; }
    }
}

namespace attn_body {
using bf16=__hip_bfloat16;
using bf16x8=__attribute__((ext_vector_type(8)))short;
using s16x4=__attribute__((ext_vector_type(4)))short;
using f32x16=__attribute__((ext_vector_type(16)))float;
using u32x4=__attribute__((ext_vector_type(4)))unsigned;
constexpr int BATCH=8,NHEAD=8,SEQ=4096,D=64,DM=NHEAD*D;
constexpr int NW=8,QBLK=32,QB=QBLK*NW,KVBLK=64,NQB=SEQ/QB;
constexpr int ATTN_PITCH=DM, ATTN_UNIT_ROWS=QB;
__device__ __forceinline__ int crow(int r,int hi){return (r&3)+8*(r>>2)+4*hi;}
#define SBAR() __builtin_amdgcn_sched_barrier(0)
__device__ __forceinline__ void cmask(f32x16&p0,f32x16&p1,int jb,int qrel,int hi){
  const float NEG=-INFINITY; int kb=64*jb+4*hi;
  #pragma unroll
  for(int r=0;r<16;++r){int kv=kb+(r&3)+8*(r>>2); if(kv>qrel)p0[r]=NEG; if(kv+32>qrel)p1[r]=NEG;}
}

constexpr int NSLOT=3, SLOTB=8192;
constexpr int LDS_K=0, LDS_V=NSLOT*SLOTB, LDS_WS=2*NSLOT*SLOTB, LDS_OST=LDS_WS+NW*64*4, LDS_BYTES=LDS_OST+NW*4096, LDS_CL=LDS_BYTES, LDS_BYTES_ALL=LDS_CL+SEQ*4;
constexpr float C2=0.125f*1.4426950408889634f;
__device__ __forceinline__ void glds16(const void*gsrc,unsigned lds_dst){unsigned keep;
  asm volatile("s_mov_b32 %0, m0\n\ts_mov_b32 m0, %2\n\ts_nop 0\n\tglobal_load_lds_dwordx4 %1, off\n\ts_mov_b32 m0, %0":"=&s"(keep):"v"(gsrc),"s"(lds_dst):"memory");}
__device__ __forceinline__ float max3f(float a,float b,float c){float r;asm("v_max3_f32 %0, %1, %2, %3":"=v"(r):"v"(a),"v"(b),"v"(c));return r;}
__device__ __forceinline__ float max2f(float a,float b){float r;asm("v_max_f32_e32 %0, %1, %2":"=v"(r):"v"(a),"v"(b));return r;}
__device__ __forceinline__ float fadd_s(float a,float b){float r;asm("v_add_f32_e32 %0, %1, %2":"=v"(r):"v"(a),"v"(b));return r;}
__device__ __forceinline__ float fsub_s(float a,float b){float r;asm("v_sub_f32_e32 %0, %1, %2":"=v"(r):"v"(a),"v"(b));return r;}
typedef float f32x2_t __attribute__((ext_vector_type(2))); typedef __bf16 bf16x2_t __attribute__((ext_vector_type(2)));
__device__ __forceinline__ unsigned cvtpk_s(float lo,float hi){f32x2_t v={lo,hi};bf16x2_t b=__builtin_convertvector(v,bf16x2_t);return __builtin_bit_cast(unsigned,b);}
#define WAIT_BAR(N) asm volatile("s_waitcnt vmcnt(" #N ") lgkmcnt(0)\n\ts_barrier":::"memory")

__device__ __forceinline__ void qkt(f32x16&p0,f32x16&p1,const char*Kslot,const bf16x8*qr,const f32x16&ci0,const f32x16&ci1,int r32,int hi){
  const char*kb=Kslot+hi*1024+r32*16;
  #pragma unroll
  for(int d0=0;d0<4;++d0){
    const bf16x8 b0=*reinterpret_cast<const bf16x8*>(kb+d0*2048);
    const bf16x8 b1=*reinterpret_cast<const bf16x8*>(kb+d0*2048+512);
    if(d0==0){p0=__builtin_amdgcn_mfma_f32_32x32x16_bf16(b0,qr[0],ci0,0,0,0);p1=__builtin_amdgcn_mfma_f32_32x32x16_bf16(b1,qr[0],ci1,0,0,0);}
    else{p0=__builtin_amdgcn_mfma_f32_32x32x16_bf16(b0,qr[d0],p0,0,0,0);p1=__builtin_amdgcn_mfma_f32_32x32x16_bf16(b1,qr[d0],p1,0,0,0);}}
}
typedef __attribute__((address_space(3))) const char* lds_cptr;
typedef short v4i16_t __attribute__((ext_vector_type(4)));
__device__ __forceinline__ void kload8(bf16x8*kf,lds_cptr kp){
  kf[0]=*(const __attribute__((address_space(3))) bf16x8*)(kp);      kf[1]=*(const __attribute__((address_space(3))) bf16x8*)(kp+512);
  kf[2]=*(const __attribute__((address_space(3))) bf16x8*)(kp+2048); kf[3]=*(const __attribute__((address_space(3))) bf16x8*)(kp+2560);
  kf[4]=*(const __attribute__((address_space(3))) bf16x8*)(kp+4096); kf[5]=*(const __attribute__((address_space(3))) bf16x8*)(kp+4608);
  kf[6]=*(const __attribute__((address_space(3))) bf16x8*)(kp+6144); kf[7]=*(const __attribute__((address_space(3))) bf16x8*)(kp+6656);
}
__device__ __forceinline__ void kload2(bf16x8*kf,lds_cptr kp,int j){ kf[2*j]=*(const __attribute__((address_space(3))) bf16x8*)(kp+j*2048); kf[2*j+1]=*(const __attribute__((address_space(3))) bf16x8*)(kp+j*2048+512); }
__device__ __forceinline__ s16x4 vtr(lds_cptr p){ return __builtin_bit_cast(s16x4,__builtin_amdgcn_ds_read_tr16_b64_v4i16((__attribute__((address_space(3))) v4i16_t*)p)); }
__device__ __forceinline__ float rowmax(const f32x16&p0,const f32x16&p1){
  float a=max3f(p0[0],p0[1],p1[0]),b=max3f(p0[2],p0[3],p1[1]);a=max3f(a,p1[2],p1[3]);
  #pragma unroll
  for(int r=4;r<16;r+=4){a=max3f(a,p0[r],p0[r+1]);b=max3f(b,p0[r+2],p0[r+3]);a=max3f(a,p1[r],p1[r+1]);b=max3f(b,p1[r+2],p1[r+3]);}
  const float m=max2f(a,b);
  auto rr=__builtin_amdgcn_permlane32_swap(__float_as_uint(m),__float_as_uint(m),false,false);
  return max2f(__uint_as_float(rr[0]),__uint_as_float(rr[1]));
}
__device__ __forceinline__ void pv(f32x16*o,int vb,bf16x8 pa0,bf16x8 pa1,bf16x8 pa2,bf16x8 pa3){
  #pragma unroll
  for(int d0=0;d0<2;++d0){s16x4 lo[4],hi[4];
    #pragma unroll
    for(int ks=0;ks<4;++ks){
      asm volatile("ds_read_b64_tr_b16 %0,%1 offset:%c2":"=&v"(lo[ks]):"v"(vb),"i"(d0*4096+ks*1024):"memory");
      asm volatile("ds_read_b64_tr_b16 %0,%1 offset:%c2":"=&v"(hi[ks]):"v"(vb),"i"(d0*4096+ks*1024+512):"memory");}
    asm volatile("s_waitcnt lgkmcnt(0)":::"memory");SBAR();
    #define PK(k) (bf16x8){lo[k][0],lo[k][1],lo[k][2],lo[k][3],hi[k][0],hi[k][1],hi[k][2],hi[k][3]}
    o[d0]=__builtin_amdgcn_mfma_f32_32x32x16_bf16(pa0,PK(0),o[d0],0,0,0);
    o[d0]=__builtin_amdgcn_mfma_f32_32x32x16_bf16(pa1,PK(1),o[d0],0,0,0);
    o[d0]=__builtin_amdgcn_mfma_f32_32x32x16_bf16(pa2,PK(2),o[d0],0,0,0);
    o[d0]=__builtin_amdgcn_mfma_f32_32x32x16_bf16(pa3,PK(3),o[d0],0,0,0);
    #undef PK
  }
}

#ifndef ATTN_STORE16
#define ATTN_STORE16(p,v) (*(u32x4*)(p)=(v))
#endif
__device__ __forceinline__ void attn_unit(int b,int h,int qb,const bf16*Q,const bf16*K,const bf16*V,bf16*O,const float*CLh,const int T0,char*shm,const int tid){
  const int lane=tid&63,r32=lane&31,hi=lane>>5; const int wid=__builtin_amdgcn_readfirstlane(tid>>6);
  const long rowbase=(long)b*SEQ; const int q0=qb*QB;
  const bf16*Qw=Q+(rowbase+q0+wid*QBLK)*DM+h*D;
  const bf16*Kh=K+(rowbase+(long)T0*KVBLK)*DM+h*D,*Vh=V+(rowbase+(long)T0*KVBLK)*DM+h*D;
  const unsigned lds0=(unsigned)(uintptr_t)shm;
  float*wsf=(float*)(shm+LDS_WS)+wid*64;
  const bf16*ksrc=Kh+(long)lane*DM+wid*8;
  const bf16*vsrc=Vh+(long)(16*(wid&3)+(lane>>2))*DM+(wid>>2)*32+(lane&3)*8;
  const unsigned kdst=lds0+LDS_K+wid*1024, vdst=lds0+LDS_V+wid*1024;
  #define DMA_K(t,slot) glds16(ksrc+(long)(t)*KVBLK*DM,(unsigned)__builtin_amdgcn_readfirstlane(kdst+(slot)))
  #define DMA_V(t,slot) glds16(vsrc+(long)(t)*KVBLK*DM,(unsigned)__builtin_amdgcn_readfirstlane(vdst+(slot)))
  const int vb0=(int)(lds0+LDS_V)+((lane>>4)&1)*32+(lane&3)*8+(4*hi+((lane&15)>>2))*64;
  const char*Kbase=shm+LDS_K; bf16x8 kf[8];
  const lds_cptr shm3=(lds_cptr)shm; const lds_cptr kp0=shm3+LDS_K+hi*1024+r32*16; const lds_cptr vp0=shm3+LDS_V+((lane>>4)&1)*32+(lane&3)*8+(4*hi+((lane&15)>>2))*64;
  const int NT=(q0+QB)/KVBLK-T0;
  typedef __attribute__((address_space(3))) const float* lds_fptr; const lds_fptr clt=(lds_fptr)(shm3+LDS_CL)+T0*KVBLK;
  { const int np=qb+1; if(wid<np)glds16(CLh+256*wid+4*lane,(unsigned)__builtin_amdgcn_readfirstlane(lds0+LDS_CL+1024*wid)); if(wid+8<np)glds16(CLh+256*(wid+8)+4*lane,(unsigned)__builtin_amdgcn_readfirstlane(lds0+LDS_CL+1024*(wid+8))); }
  DMA_K(0,0);DMA_V(0,0);DMA_K(1,SLOTB);
  bf16x8 qr[4];
  #pragma unroll
  for(int d0=0;d0<4;++d0)qr[d0]=*reinterpret_cast<const bf16x8*>(&Qw[(long)r32*DM+d0*16+hi*8]);
  float l_reg=0.f;f32x16 o[2];o[0]=f32x16{};o[1]=f32x16{};
  const float clq=CLh[q0+wid*QBLK+r32]; const float bq=hi?clq:1.0f;
  #define CINIT(c0,c1,t) do{ const float k0_=clt[(t)*KVBLK+r32],k1_=clt[(t)*KVBLK+32+r32]; c0=__builtin_amdgcn_mfma_f32_32x32x2f32(hi?1.0f:-k0_,bq,f32x16{},0,0,0); c1=__builtin_amdgcn_mfma_f32_32x32x2f32(hi?1.0f:-k1_,bq,f32x16{},0,0,0); }while(0)
  const int qrel=wid*QBLK+r32;
  #define CMASK(P0,P1,t) do{int jb_=(t)-(NT-4); if(jb_>=0)cmask(P0,P1,jb_,qrel,hi);}while(0)
  f32x16 pA0,pA1,pB0,pB1;
  int sl_prev=0,sl_cur=0,sl_next=SLOTB;
  #define ROT() do{sl_prev=sl_cur;sl_cur=sl_next;sl_next=(sl_next==(NSLOT-1)*SLOTB)?0:sl_next+SLOTB;}while(0)
  DMA_K(2,2*SLOTB);
  WAIT_BAR(3);
  { f32x16 ci0,ci1; CINIT(ci0,ci1,0); qkt(pA0,pA1,Kbase,qr,ci0,ci1,r32,hi); } asm volatile("s_nop 15\n\ts_nop 7":"+v"(pA0),"+v"(pA1));CMASK(pA0,pA1,0);
  _Pragma("unroll") for(int r=0;r<16;++r)pA0[r]=__builtin_amdgcn_exp2f(pA0[r]);
  _Pragma("unroll") for(int r=0;r<16;++r)pA1[r]=__builtin_amdgcn_exp2f(pA1[r]);
  WAIT_BAR(0);
  DMA_K(3,0);DMA_V(1,SLOTB);
  ROT();
  kload8(kf,kp0+sl_cur);
  WAIT_BAR(2);
  s16x4 vlo[8],vhi[8]; u32x4 pw0,pw1,pw2,pw3;
  #define PKW(P,B) cvtpk_s(P[B],P[B+1])
  #define PAF(k) __builtin_bit_cast(bf16x8,pw##k)
  #define VFR(i) (bf16x8){vlo[i][0],vlo[i][1],vlo[i][2],vlo[i][3],vhi[i][0],vhi[i][1],vhi[i][2],vhi[i][3]}
  #define PIN(x) asm volatile("":"+v"(x))
  #define MX3(a,b,c) __builtin_fmaxf(__builtin_fmaxf((a),(b)),(c))
  #define GAPA(MF,A0,A1,A2,A3,W0,W1,PW) do{ MF; sacc+=A0; sacc+=A1; sacc+=A2; sacc+=A3; PIN(sacc); W0; W1; PIN(PW); SBAR(); }while(0)
  #define EX(v) __builtin_amdgcn_exp2f(v)
  #define GAPB(MF,X,B) do{ MF; X[B]=EX(X[B]); X[B+1]=EX(X[B+1]); X[B+2]=EX(X[B+2]); X[B+3]=EX(X[B+3]); PIN(X); SBAR(); }while(0)
  #define VRD(i) do{ vlo[i]=vtr(vp_+(((i)>>2)*4096+((i)&3)*1024)); vhi[i]=vtr(vp_+(((i)>>2)*4096+((i)&3)*1024+512)); }while(0)
  #define KRD(G,j) do{ if(G){ kload2(kf,kp0+sl_next,j); SBAR(); } }while(0)
  #define STEP(C0,C1,P0,P1,t,GK,GV,GL) do{ SBAR(); \
    const lds_cptr vp_=vp0+sl_prev; \
    CINIT(C0,C1,t); SBAR(); \
    VRD(0); SBAR(); float sacc=(P0[0]+P0[1]); \
    GAPA(C0=__builtin_amdgcn_mfma_f32_32x32x16_bf16(kf[0],qr[0],C0,0,0,0), P0[2],P0[3],P0[4],P0[5],     pw0[0]=PKW(P0,0), pw0[1]=PKW(P0,2), pw0); \
    VRD(4); SBAR(); GAPA(C1=__builtin_amdgcn_mfma_f32_32x32x16_bf16(kf[1],qr[0],C1,0,0,0), P0[6],P0[7],P0[8],P0[9],     pw0[2]=PKW(P0,4), pw0[3]=PKW(P0,6), pw0); \
    VRD(1); SBAR(); GAPA(C0=__builtin_amdgcn_mfma_f32_32x32x16_bf16(kf[2],qr[1],C0,0,0,0),   P0[10],P0[11],P0[12],P0[13], pw1[0]=PKW(P0,8), pw1[1]=PKW(P0,10), pw1); \
    VRD(5); SBAR(); GAPA(C1=__builtin_amdgcn_mfma_f32_32x32x16_bf16(kf[3],qr[1],C1,0,0,0),   P0[14],P0[15],P1[0],P1[1],   pw1[2]=PKW(P0,12),pw1[3]=PKW(P0,14), pw1); \
    VRD(2); SBAR(); GAPA(C0=__builtin_amdgcn_mfma_f32_32x32x16_bf16(kf[4],qr[2],C0,0,0,0),   P1[2],P1[3],P1[4],P1[5],     pw2[0]=PKW(P1,0), pw2[1]=PKW(P1,2), pw2); \
    VRD(6); SBAR(); GAPA(C1=__builtin_amdgcn_mfma_f32_32x32x16_bf16(kf[5],qr[2],C1,0,0,0),   P1[6],P1[7],P1[8],P1[9],     pw2[2]=PKW(P1,4), pw2[3]=PKW(P1,6), pw2); \
    VRD(3); SBAR(); GAPA(C0=__builtin_amdgcn_mfma_f32_32x32x16_bf16(kf[6],qr[3],C0,0,0,0),   P1[10],P1[11],P1[12],P1[13], pw3[0]=PKW(P1,8), pw3[1]=PKW(P1,10), pw3); \
    VRD(7); SBAR(); GAPA(C1=__builtin_amdgcn_mfma_f32_32x32x16_bf16(kf[7],qr[3],C1,0,0,0),   P1[14],P1[15],0.f,0.f,       pw3[2]=PKW(P1,12),pw3[3]=PKW(P1,14), pw3); \
    l_reg+=sacc; \
    if(GK){DMA_K((t)+3,sl_cur);} if(GV){DMA_V((t)+1,sl_next);} \
    CMASK(C0,C1,t); \
    SBAR(); \
    GAPB(o[0]=__builtin_amdgcn_mfma_f32_32x32x16_bf16(PAF(0),VFR(0),o[0],0,0,0), C0,0); \
    GAPB(o[1]=__builtin_amdgcn_mfma_f32_32x32x16_bf16(PAF(0),VFR(4),o[1],0,0,0), C0,4); \
    KRD(GL,0); GAPB(o[0]=__builtin_amdgcn_mfma_f32_32x32x16_bf16(PAF(1),VFR(1),o[0],0,0,0), C0,8); \
    KRD(GL,1); GAPB(o[1]=__builtin_amdgcn_mfma_f32_32x32x16_bf16(PAF(1),VFR(5),o[1],0,0,0), C0,12); \
    KRD(GL,2); GAPB(o[0]=__builtin_amdgcn_mfma_f32_32x32x16_bf16(PAF(2),VFR(2),o[0],0,0,0), C1,0); \
    KRD(GL,3); GAPB(o[1]=__builtin_amdgcn_mfma_f32_32x32x16_bf16(PAF(2),VFR(6),o[1],0,0,0), C1,4); \
    GAPB(o[0]=__builtin_amdgcn_mfma_f32_32x32x16_bf16(PAF(3),VFR(3),o[0],0,0,0), C1,8); \
    GAPB(o[1]=__builtin_amdgcn_mfma_f32_32x32x16_bf16(PAF(3),VFR(7),o[1],0,0,0), C1,12); \
    }while(0)
  int t=1;
  #undef CMASK
  #define CMASK(P0,P1,t) do{}while(0)
  for(;t+5<NT;t+=2){
    STEP(pB0,pB1,pA0,pA1,t,true,true,true);     WAIT_BAR(2); ROT();
    STEP(pA0,pA1,pB0,pB1,t+1,true,true,true);   WAIT_BAR(2); ROT();
  }
  #undef CMASK
  #define CMASK(P0,P1,t) do{int jb_=(t)-(NT-4); if(jb_>=0)cmask(P0,P1,jb_,qrel,hi);}while(0)
  #define ENDW(tt) do{ if((tt)+3<NT){WAIT_BAR(2);} else if((tt)+2<NT){WAIT_BAR(1);} else {WAIT_BAR(0);} }while(0)
  for(;t+1<NT;t+=2){
    STEP(pB0,pB1,pA0,pA1,t,(t+3<NT),(t+1<NT),(t+1<NT));       ENDW(t);   ROT();
    STEP(pA0,pA1,pB0,pB1,t+1,(t+4<NT),(t+2<NT),(t+2<NT));     ENDW(t+1); ROT();
  }
  STEP(pB0,pB1,pA0,pA1,NT-1,false,false,false);
  { float sacc=pB0[0]+pB0[1]; _Pragma("unroll") for(int r=2;r<16;++r)sacc+=pB0[r]; _Pragma("unroll") for(int r=0;r<16;++r)sacc+=pB1[r]; l_reg+=sacc;
    pw0=(u32x4){PKW(pB0,0),PKW(pB0,2),PKW(pB0,4),PKW(pB0,6)};pw1=(u32x4){PKW(pB0,8),PKW(pB0,10),PKW(pB0,12),PKW(pB0,14)};pw2=(u32x4){PKW(pB1,0),PKW(pB1,2),PKW(pB1,4),PKW(pB1,6)};pw3=(u32x4){PKW(pB1,8),PKW(pB1,10),PKW(pB1,12),PKW(pB1,14)};
    SBAR(); pv(o,vb0+sl_cur,PAF(0),PAF(1),PAF(2),PAF(3)); }
  #undef PKW
  #undef PAF
  #undef VFR
  #undef PIN
  #undef MX3
  #undef GAPA
  #undef GAPB
  #undef EX
  #undef VRD
  #undef KRD
  #undef STEP
  #undef ENDW
  {auto rr=__builtin_amdgcn_permlane32_swap(__float_as_uint(l_reg),__float_as_uint(l_reg),false,false);l_reg=__uint_as_float(rr[0])+__uint_as_float(rr[1]);}
  if(hi==0)wsf[32+r32]=l_reg;asm volatile("s_waitcnt lgkmcnt(0)":::"memory");
  float rli[16];
  #pragma unroll
  for(int r=0;r<16;++r)rli[r]=__builtin_amdgcn_rcpf(wsf[32+crow(r,hi)]);
  bf16*Ow=O+(rowbase+q0+wid*QBLK)*DM+h*D;
  { bf16*stg=(bf16*)(shm+LDS_OST)+wid*2048;
    #pragma unroll
    for(int r=0;r<16;++r){const int orow=crow(r,hi);
      #pragma unroll
      for(int d0=0;d0<2;++d0)stg[orow*64+d0*32+r32]=__float2bfloat16(o[d0][r]*rli[r]);}
    asm volatile("s_waitcnt lgkmcnt(0)":::"memory");
    #pragma unroll
    for(int i=0;i<4;++i){const int row=i*8+(lane>>3),ch=lane&7; const u32x4 v=*(const u32x4*)(stg+row*64+ch*8); ATTN_STORE16(Ow+(long)row*DM+ch*8,v);} }
  asm volatile("s_waitcnt lgkmcnt(0)\n\ts_barrier":::"memory");
  #undef DMA_K
  #undef DMA_V
  #undef CMASK
  #undef CINIT
  #undef ROT
}
constexpr int ATTN_LDS_BYTES=LDS_BYTES;
struct AttnTensors { const bf16* Q; const bf16* K; const bf16* V; bf16* O; const float* CL; };
struct AttnUnit { int bh; int qb; };
struct StaticOrder {
  int vcu;
  __device__ __forceinline__ explicit StaticOrder(int v):vcu(v){}
  __device__ __forceinline__ bool next(int i,AttnUnit&u)const{ if(i>=4)return false; const int s=vcu&3; u.bh=vcu>>2; u.qb=(i==0)?15-s:(i==1)?8+s:(i==2)?7-s:s; return true; }
};
__device__ __forceinline__ int first_tile(const float*CLh,int qb,float thr,int lane){
  const float c0=CLh[qb*QB]; const float ct=CLh[lane*KVBLK+KVBLK-1];
  const unsigned long long skip=__ballot((c0-ct)<-thr);
  int t0=(int)__builtin_ctzll(~skip);
  const int cap=4*qb; t0=t0<cap?t0:cap; return __builtin_amdgcn_readfirstlane(t0&~1);
}
struct QueueOrder { unsigned* head; volatile __attribute__((address_space(3))) unsigned* slot; int batch; };
template<class Sched> __device__ __forceinline__ void attn_phase(char*lds,const AttnTensors&T,const float*THR,const Sched&S,const int tid){
  for(;;){
    if(tid==0){ const unsigned u_=__hip_atomic_fetch_add(S.head,1u,__ATOMIC_RELAXED,__HIP_MEMORY_SCOPE_AGENT); S.slot[0]=u_; }
    asm volatile("s_waitcnt vmcnt(0) lgkmcnt(0)\n\ts_barrier":::"memory");
    const unsigned ui=S.slot[0];
    asm volatile("s_waitcnt lgkmcnt(0)\n\ts_barrier":::"memory");
    if(ui>=(unsigned)(NHEAD*NQB))break;
    const int qb=NQB-1-(int)(ui>>3),h=(int)(ui&7),bh=S.batch*NHEAD+h; const float*CLh=T.CL+(size_t)bh*SEQ;
    const int T0=first_tile(CLh,qb,THR[bh],tid&63);
    attn_unit(S.batch,h,qb,T.Q,T.K,T.V,T.O,CLh,T0,lds,tid);
  }
}
#undef SBAR
#undef WAIT_BAR
}

namespace memattn {
using namespace attn_body;
typedef float f32x4_t __attribute__((ext_vector_type(4)));
constexpr int MPITCH = 512;
__device__ __forceinline__ void mem_unit(int b, int head, int qb0, int nqb, const float* MQ, const attn_body::bf16* KM, const attn_body::bf16* VM, attn_body::bf16* MO, const float* mqg, char* shm, const int tid) {
    const int lane = tid & 63, r32 = lane & 31, hi = lane >> 5; const int wid = __builtin_amdgcn_readfirstlane(tid >> 6);
    const unsigned lds0 = (unsigned)(uintptr_t)shm;
    const attn_body::bf16* Kh = KM + (size_t)b * 256 * MPITCH + head * 128; const attn_body::bf16* Vh = VM + (size_t)b * 256 * MPITCH + head * 128;
#pragma unroll
    for (int t = 0; t < 4; ++t)
#pragma unroll
        for (int pp = 0; pp < 2; ++pp) { const int p = wid + 8 * pp;
            glds16(Kh + (size_t)(64 * t + lane) * MPITCH + p * 8, (unsigned)__builtin_amdgcn_readfirstlane(lds0 + t * 32768 + p * 1024));
            glds16(Vh + (size_t)(64 * t + 16 * (p & 3) + (lane >> 2)) * MPITCH + (p >> 2) * 32 + (lane & 3) * 8, (unsigned)__builtin_amdgcn_readfirstlane(lds0 + t * 32768 + 16384 + p * 1024)); }
    const lds_cptr shm3 = (lds_cptr)shm;
    const lds_cptr kp0 = shm3 + hi * 1024 + r32 * 16;
    const lds_cptr vp0 = shm3 + 16384 + ((lane >> 4) & 1) * 32 + (lane & 3) * 8 + (4 * hi + ((lane & 15) >> 2)) * 64;
    asm volatile("s_waitcnt vmcnt(0) lgkmcnt(0)\n\ts_barrier" ::: "memory");
    for (int qi = 0; qi < nqb; ++qi) {
        const size_t row0 = (size_t)b * ::SEQ + (size_t)(qb0 + qi) * 256 + wid * 32;
        bf16x8 qr[8];
        { f32x4_t x[8][2]; float ss = 0.f; const unsigned short* qp = (const unsigned short*)MQ + (row0 + r32) * MPITCH + head * 128 + 8 * hi;
#pragma unroll
          for (int d0 = 0; d0 < 8; ++d0) { const u32x4 w = *(const u32x4*)(qp + 16 * d0);
              x[d0][0] = (f32x4_t){__uint_as_float(w.x << 16), __uint_as_float(w.x & 0xffff0000u), __uint_as_float(w.y << 16), __uint_as_float(w.y & 0xffff0000u)}; x[d0][1] = (f32x4_t){__uint_as_float(w.z << 16), __uint_as_float(w.z & 0xffff0000u), __uint_as_float(w.w << 16), __uint_as_float(w.w & 0xffff0000u)};
#pragma unroll
              for (int j = 0; j < 4; ++j) ss += x[d0][0][j] * x[d0][0][j] + x[d0][1][j] * x[d0][1][j]; }
          { auto rr = __builtin_amdgcn_permlane32_swap(__float_as_uint(ss), __float_as_uint(ss), false, false); ss = __uint_as_float(rr[0]) + __uint_as_float(rr[1]); }
          const float rstd = C2M / sqrtf(ss * (1.0f / 128.0f) + EPS);
#pragma unroll
          for (int d0 = 0; d0 < 8; ++d0) { const f32x4_t a = x[d0][0] * rstd * *(const f32x4_t*)(mqg + 16 * d0 + 8 * hi), c = x[d0][1] * rstd * *(const f32x4_t*)(mqg + 16 * d0 + 8 * hi + 4);
              u32x4 w; w.x = cvtpk_s(a[0], a[1]); w.y = cvtpk_s(a[2], a[3]); w.z = cvtpk_s(c[0], c[1]); w.w = cvtpk_s(c[2], c[3]); qr[d0] = __builtin_bit_cast(bf16x8, w); } }
        f32x16 o[4]; o[0] = f32x16{}; o[1] = f32x16{}; o[2] = f32x16{}; o[3] = f32x16{}; float l_reg = 0.f;
#pragma unroll 1
        for (int t = 0; t < 4; ++t) {
            const lds_cptr kp = kp0 + t * 32768; f32x16 p0 = f32x16{}, p1 = f32x16{};
#pragma unroll
            for (int d0 = 0; d0 < 8; ++d0) { const bf16x8 b0 = *(const __attribute__((address_space(3))) bf16x8*)(kp + d0 * 2048), b1 = *(const __attribute__((address_space(3))) bf16x8*)(kp + d0 * 2048 + 512);
                p0 = __builtin_amdgcn_mfma_f32_32x32x16_bf16(b0, qr[d0], p0, 0, 0, 0); p1 = __builtin_amdgcn_mfma_f32_32x32x16_bf16(b1, qr[d0], p1, 0, 0, 0); }
            float sacc = 0.f;
#pragma unroll
            for (int r = 0; r < 16; ++r) { p0[r] = __builtin_amdgcn_exp2f(p0[r]); p1[r] = __builtin_amdgcn_exp2f(p1[r]); sacc += p0[r] + p1[r]; }
            l_reg += sacc;
            u32x4 pw0, pw1, pw2, pw3;
            pw0 = (u32x4){cvtpk_s(p0[0], p0[1]), cvtpk_s(p0[2], p0[3]), cvtpk_s(p0[4], p0[5]), cvtpk_s(p0[6], p0[7])}; pw1 = (u32x4){cvtpk_s(p0[8], p0[9]), cvtpk_s(p0[10], p0[11]), cvtpk_s(p0[12], p0[13]), cvtpk_s(p0[14], p0[15])};
            pw2 = (u32x4){cvtpk_s(p1[0], p1[1]), cvtpk_s(p1[2], p1[3]), cvtpk_s(p1[4], p1[5]), cvtpk_s(p1[6], p1[7])}; pw3 = (u32x4){cvtpk_s(p1[8], p1[9]), cvtpk_s(p1[10], p1[11]), cvtpk_s(p1[12], p1[13]), cvtpk_s(p1[14], p1[15])};
            const lds_cptr vp = vp0 + t * 32768;
#pragma unroll
            for (int d0 = 0; d0 < 4; ++d0) {
#pragma unroll
                for (int ks = 0; ks < 4; ++ks) { const s16x4 lo = vtr(vp + d0 * 4096 + ks * 1024), hh = vtr(vp + d0 * 4096 + ks * 1024 + 512);
                    const bf16x8 vf = (bf16x8){lo[0], lo[1], lo[2], lo[3], hh[0], hh[1], hh[2], hh[3]};
                    const bf16x8 pa = ks == 0 ? __builtin_bit_cast(bf16x8, pw0) : (ks == 1 ? __builtin_bit_cast(bf16x8, pw1) : (ks == 2 ? __builtin_bit_cast(bf16x8, pw2) : __builtin_bit_cast(bf16x8, pw3)));
                    o[d0] = __builtin_amdgcn_mfma_f32_32x32x16_bf16(pa, vf, o[d0], 0, 0, 0); } }
        }
        { auto rr = __builtin_amdgcn_permlane32_swap(__float_as_uint(l_reg), __float_as_uint(l_reg), false, false); l_reg = __uint_as_float(rr[0]) + __uint_as_float(rr[1]); }
        const float il = __builtin_amdgcn_rcpf(l_reg);
        { const lds_cptr stg = shm3 + STG_OFF + wid * (16 * 144); float ilr[16];
#pragma unroll
          for (int r = 0; r < 16; ++r) ilr[r] = shl(il, crow(r, hi));
          attn_body::bf16* Ob = MO + row0 * MPITCH + head * 128;
#pragma unroll
          for (int rh = 0; rh < 2; ++rh)
#pragma unroll
              for (int chh = 0; chh < 2; ++chh) {
#pragma unroll
                  for (int r8 = 0; r8 < 8; ++r8) { const int r = 8 * rh + r8; const int rowl = crow(r, hi) - 16 * rh;
#pragma unroll
                      for (int dd = 0; dd < 2; ++dd) { const float v = o[2 * chh + dd][r] * ilr[r];
                          *(__attribute__((address_space(3))) unsigned short*)(stg + rowl * 144 + (32 * dd + r32) * 2) = (unsigned short)(cvtpk_s(v, v) & 0xffffu); } }
                  const int rr = lane >> 3, ch = lane & 7;
                  const u32x4 a = *(const __attribute__((address_space(3))) u32x4*)(stg + rr * 144 + ch * 16), b = *(const __attribute__((address_space(3))) u32x4*)(stg + (rr + 8) * 144 + ch * 16);
                  *(u32x4*)(Ob + (size_t)(16 * rh + rr) * MPITCH + 64 * chh + ch * 8) = a; *(u32x4*)(Ob + (size_t)(16 * rh + rr + 8) * MPITCH + 64 * chh + ch * 8) = b; } }
    }
    asm volatile("s_waitcnt lgkmcnt(0)\n\ts_barrier" ::: "memory");
}
}

#ifndef PROBE_PHASE
#define PROBE_PHASE (-1)
#endif
struct MemKvOrder {
    int G, c;
    __device__ __forceinline__ bool next(int i, pg8::Unit& u) const { const int L = i * G + c; if (L >= 64) return false; const int l = L >> 5, r = L & 31; u.pm = 8 * l + (r >> 2); u.pn = r & 3; u.aux = l; return true; }
    __device__ __forceinline__ void ptrs(const pg8::Gemm& g, const pg8::Unit& u, const char*& a, const char*& b) const {
        a = (const char*)g.A + (size_t)u.pm * (size_t)(256 * 2) * g.K; b = (const char*)g.Bt + (size_t)u.aux * (size_t)(1024 * 1024 * 2) + (size_t)u.pn * (size_t)(256 * 2) * g.K; }
    __device__ __forceinline__ void a_ready(const pg8::Unit&) const {}
    __device__ __forceinline__ void done(const pg8::Unit&) const {}
};

__global__ void __launch_bounds__(NTHREADS, 2) mk_fwd(Args args) {
    extern __shared__ __attribute__((aligned(16))) unsigned char lds[];
    Frame F;
    F.lds = (LAS unsigned char*)lds; F.MISC = (volatile LAS unsigned*)(F.lds + MISC_OFF);
    F.tid = threadIdx.x; F.lane = F.tid & 63; F.wave = __builtin_amdgcn_readfirstlane(F.tid >> 6);
    F.G = gridDim.x; { const int bx = blockIdx.x; F.vcu = (F.G % 8 == 0) ? (bx % 8) * (F.G / 8) + bx / 8 : bx; }
    F.ws = args.ws; F.ctl = (gu32*)(args.ws + WS_CTL); F.X = args.out;
    for (int u = F.tid; u < (LDS_BYTES - LDSCTL_OFF) / 4; u += NTHREADS) ((LAS unsigned*)(F.lds + LDSCTL_OFF))[u] = 0u;
    __syncthreads();
    (void)xcd_barrier_post((unsigned*)(F.ctl + CW_BAR), F.MISC + 8);
    unsigned long long t0_ = 0ull;
#define REFRESH() do { int w_ = F.wave; asm volatile("" : "+s"(w_)); F.wave = w_; int l_; asm volatile("v_mbcnt_lo_u32_b32 %0, -1, 0\n\tv_mbcnt_hi_u32_b32 %0, -1, %0" : "=v"(l_)); F.lane = l_; F.tid = w_ * 64 + l_; \
    int v_ = F.vcu; asm volatile("" : "+s"(v_)); F.vcu = v_; \
    GAS unsigned char* g_ = (GAS unsigned char*)F.ws; asm volatile("" : "+s"(g_)); F.ws = (unsigned char*)g_; GAS float* x_ = (GAS float*)F.X; asm volatile("" : "+s"(x_)); F.X = (float*)x_; } while (0)
#define SEAM(k) do { if (PROBE_PHASE >= 0 && PROBE_PHASE == (k)) { const unsigned long long n_ = __builtin_amdgcn_s_memrealtime(), d_ = n_ - t0_; while (__builtin_amdgcn_s_memrealtime() - n_ < d_) __builtin_amdgcn_s_sleep(8); } \
    XcdBarrier b_; b_.bar = (unsigned*)(F.ws + WS_CTL) + CW_BAR; b_.x = xb_xcc_id(); b_.st = (volatile LAS unsigned*)(F.lds + MISC_OFF) + 8; xcd_barrier(b_); REFRESH(); \
    if (PROBE_PHASE >= 0) t0_ = __builtin_amdgcn_s_memrealtime(); } while (0)
    { volatile LAS unsigned long long* PT = (volatile LAS unsigned long long*)(F.lds + PTR_OFF);
      if (F.tid == 0) {
#define PUT_(i) PT[i] = (unsigned long long)(uintptr_t)args.in[i];
        PUT_(0) PUT_(1) PUT_(2) PUT_(3) PUT_(4) PUT_(5) PUT_(6) PUT_(7) PUT_(8) PUT_(9) PUT_(10) PUT_(11) PUT_(12) PUT_(13) PUT_(14) PUT_(15) PUT_(16) PUT_(17) PUT_(18) PUT_(19) PUT_(20) PUT_(21) PUT_(22) PUT_(23)
#undef PUT_
      }
      __syncthreads(); }
#define INP(i) inptr(F, (i))
#ifndef DUP_PHASE
#define DUP_PHASE (-1)
#endif
#define RUN(k, ...) do { __VA_ARGS__ if (DUP_PHASE >= 0 && DUP_PHASE == (k)) { SEAM(99); __VA_ARGS__ } } while (0)
#define WSP (F.ws)
#define XBP ((bf16*)((unsigned char*)F.X + 64 * MiB))
#define ARP (F.ws + WS_AR)
#ifndef STAG_G
#define STAG_G 1
#define STAG_US 8
#endif
#define STAGGER() do { if (STAG_G > 1) { const unsigned long long s0_ = __builtin_amdgcn_s_memrealtime(), sd_ = (unsigned long long)(((bx >> 3) % STAG_G) * STAG_US * 100); while (__builtin_amdgcn_s_memrealtime() - s0_ < sd_) __builtin_amdgcn_s_sleep(4); } } while (0)
    LAS unsigned char* const ring = F.lds + RING_OFF;
    const int bx = (int)blockIdx.x;
    if (PROBE_PHASE >= 0) t0_ = __builtin_amdgcn_s_memrealtime();

    conv_phase(F); REFRESH();
    memnorm_phase(F, INP(I_MEM), INP(I_MEMG)); SEAM(0);

#pragma unroll 1
    for (int l = 0; l < DEPTH; ++l) {
        REFRESH();
        const int pb = 16 * l;
        const float* xin = (l == 0) ? INP(I_X) : (const float*)XBP;
        if (l == 0) {
            if (bx < 64) { pg8::Gemm g{(const bf16*)(WSP + WS_MEMN), (const bf16*)(WSP + W_KV), DEPTH * MROWS, 1024, D}; MemKvOrder S{F.G, bx};
                pg8::EpiF32 E{(float*)(WSP + WS_KVF), 1024, nullptr, F.lds + STG_OFF};
                pg8::gemm_phase<pg8::EpiF32, MemKvOrder, true, true, false>(ring, g, S, E, F.tid); }
            else norm_phase<1>(F, xin, INP(I_MIXG) + l * D, INP(I_WIN) + (size_t)l * D * NIN + OFF_F, NIN, INP(I_BF) + l * FH, (bf16*)(WSP + WS_H), (bx - 64) * NWAVES + F.wave, (F.G - 64) * NWAVES);
        } else
            norm_phase<1, true>(F, xin, INP(I_MIXG) + l * D, INP(I_WIN) + (size_t)l * D * NIN + OFF_F, NIN, INP(I_BF) + l * FH, (bf16*)(WSP + WS_H), F.vcu * NWAVES + F.wave, F.G * NWAVES);
        SEAM(pb + 3);
        if (l == 0) { kvfin_phase(F, INP(I_MKG)); REFRESH(); }
        cumsum_phase(F, INP(I_FQG) + l * FD, INP(I_FKG) + l * FD); REFRESH();
        if (DUP_PHASE == 105 && l == 0) { pg8::Gemm g{(const bf16*)(WSP + WS_H), (const bf16*)(WSP + W_IN) + (size_t)l * 5632 * 1024, T, 5632, D}; pg8::StaticOrder S; S.init(T, 5632, F.G, bx);
          pg8::EpiInProjT<false> E{ARP, INP(I_FQG) + l * FD, INP(I_FKG) + l * FD, F.lds + STG_OFF};
          pg8::gemm_phase<pg8::EpiInProjT<false>, pg8::StaticOrder, true, true>(ring, g, S, E, F.tid); SEAM(99); }
        if (DUP_PHASE == 104 && l == 0) { pg8::Gemm g{(const bf16*)(WSP + WS_H), (const bf16*)(WSP + W_IN) + (size_t)l * 5632 * 1024, T, 5632, D}; pg8::StaticOrder S; S.init(T, 5632, F.G, bx);
          pg8::EpiNull E{}; pg8::gemm_phase<pg8::EpiNull, pg8::StaticOrder, true, true>(ring, g, S, E, F.tid); SEAM(99); }
        if (l == 0 && bx < NCV) { conv_expert_bg(F, bx * NWAVES + F.wave, NCV * NWAVES); REFRESH(); }
        else { RUN(pb + 4, { pg8::Gemm g{(const bf16*)(WSP + WS_H), (const bf16*)(WSP + W_IN + (size_t)l * 5632 * 1024), T, 5632, D / 2}; pg8::StaticOrder S; S.init(T, 5632, l == 0 ? F.G - NCV : F.G, l == 0 ? bx - NCV : bx);
          pg8::EpiInProj8 E{ARP, INP(I_FQG) + l * FD, INP(I_FKG) + l * FD, F.lds + STG_OFF};
          pg8::gemm_phase<pg8::EpiInProj8, pg8::StaticOrder, true, true, true, 2>(ring, g, S, E, F.tid); }); }
        SEAM(pb + 4);
        pool_phase(F); REFRESH();
        { const int combo = F.vcu >> 3;
          memattn::mem_unit(combo >> 2, combo & 3, 2 * (F.vcu & 7), 2, (const float*)(ARP + AR_MQ), (const attn_body::bf16*)(WSP + WS_KM) + (size_t)l * MROWS * 512, (const attn_body::bf16*)(WSP + WS_VM) + (size_t)l * MROWS * 512,
                            (attn_body::bf16*)(ARP + AR_MO), INP(I_MQG) + l * MD, (char*)lds + RING_OFF, F.tid); }
        REFRESH();
        { static_assert(attn_body::LDS_BYTES_ALL <= RING_BYTES, "attention LDS");
          const attn_body::AttnTensors AT{(const attn_body::bf16*)(ARP + AR_Q), (const attn_body::bf16*)(ARP + AR_K), (const attn_body::bf16*)(ARP + AR_V), (attn_body::bf16*)(ARP + AR_Q), (const float*)(WSP + WS_CL)};
          attn_body::QueueOrder S; S.head = (unsigned*)(WSP + WS_CTL) + CW_ATTQ + 64 * (l * 8 + (F.vcu >> 5)); S.slot = (volatile LAS unsigned*)(F.lds + MISC_OFF) + 16; S.batch = F.vcu >> 5;
          attn_body::attn_phase<attn_body::QueueOrder>((char*)lds + RING_OFF, AT, (const float*)(WSP + WS_THR), S, F.tid); }
        SEAM(pb + 5);
        RUN(pb + 6, { pg8::Gemm g{nullptr, nullptr, T, 1024, 512}; typedef pg8::MergeOrder<AR_PD, AR_Q, AR_MO> MOrd; MOrd S; S.so.init(T, 1024, F.G, bx);
          S.arena = (const char*)ARP; S.Bbase = (const char*)(WSP + W_BR) + (size_t)(l * 3) * 1024 * 512 * 2;
          pg8::EpiMerge E{(const bf16*)(ARP + AR_G), (bf16*)(WSP + WS_H), F.lds + STG_OFF};
          pg8::gemm_phase<pg8::EpiMerge, MOrd, true, true>(ring, g, S, E, F.tid); });
        SEAM(pb + 6);
        if (l == 0) { pg8::Gemm g{(const bf16*)(WSP + WS_H), (const bf16*)(WSP + W_OUT) + (size_t)l * 1024 * 1024, T, 1024, D}; pg8::StaticOrder S; S.init(T, 1024, F.G, bx);
          pg8::EpiResBf16<true, true> E{XBP, xin, F.lds + STG_OFF, (float*)(WSP + WS_SSQ), WSP + WS_XB8, 1.0f};
          pg8::gemm_phase<pg8::EpiResBf16<true, true>, pg8::StaticOrder, true, true, false>(ring, g, S, E, F.tid);
        } else { pg8::Gemm g{(const bf16*)(WSP + WS_H), (const bf16*)(WSP + W_OUT) + (size_t)l * 1024 * 1024, T, 1024, D}; pg8::StaticOrder S; S.init(T, 1024, F.G, bx);
          pg8::EpiResBf16<false> E{XBP, XBP, F.lds + STG_OFF, nullptr, nullptr, 1.0f};
          pg8::gemm_phase<pg8::EpiResBf16<false>, pg8::StaticOrder, true, true, false>(ring, g, S, E, F.tid); }
        SEAM(pb + 7);
        if (l == 0) {
            REFRESH();
            STAGGER(); RUN(pb + 9, { pg8::Gemm g{(const bf16*)(WSP + WS_XB8), (const bf16*)(WSP + W_GU), T, 2 * DFF, D / 2}; pg8::StaticOrder S; S.init(T, 2 * DFF, F.G, bx);
              pg8::EpiSwiGLUT<true, true, 2> E{(bf16*)(ARP + AR_ACT), DFF, (const float*)(WSP + WS_SSQ)};
              pg8::gemm_phase<pg8::EpiSwiGLUT<true, true, 2>, pg8::StaticOrder, true, true, true, 2>(ring, g, S, E, F.tid); });
            SEAM(pb + 9);
            { pg8::Gemm g{(const bf16*)(ARP + AR_ACT), (const bf16*)(WSP + W_DN), T, 1024, DFF / 2}; pg8::StaticOrder S; S.init(T, 1024, F.G, bx);
              pg8::EpiResBf16<false> E{XBP, XBP, F.lds + STG_OFF, nullptr, nullptr, 1.0f / (F8_ACT * F8_WDN)};
              pg8::gemm_phase<pg8::EpiResBf16<false>, pg8::StaticOrder, true, true, false, 1>(ring, g, S, E, F.tid); }
            SEAM(pb + 10);
        } else {
            REFRESH();
            norm_phase<2, true>(F, (const float*)XBP, INP(I_FFNG) + l * D, INP(I_WR), NE, INP(I_BR), (bf16*)(WSP + WS_H2), F.vcu * NWAVES + F.wave, F.G * NWAVES); SEAM(pb + 8);
            moe_scatter_phase(F, (const unsigned char*)(WSP + WS_H2)); SEAM(pb + 11);
            const int ntile = __builtin_amdgcn_readfirstlane(((const int*)(WSP + WS_META))[0]);
            { volatile LAS int* te = (volatile LAS int*)(F.lds + TILE_OFF); const int* tg = (const int*)(WSP + WS_META) + 16; if (F.tid < MAXTILES) te[F.tid] = tg[F.tid]; __syncthreads(); }
            const volatile LAS int* tile_e = (const volatile LAS int*)(F.lds + TILE_OFF);
            STAGGER(); RUN(pb + 12, { pg8::Gemm g{(const bf16*)(WSP + WS_HS), (const bf16*)(WSP + W_EGU), ntile * 256, 2 * DEXP, D / 2}; pg8::GroupedOrder S; S.so.init(ntile * 256, 2 * DEXP, F.G, bx); S.tile_e = tile_e; S.bstride = (size_t)2 * DEXP * D;
              pg8::EpiSwiGLU8 E{(bf16*)(WSP + WS_ACTE), DEXP, nullptr};
              pg8::gemm_phase<pg8::EpiSwiGLU8, pg8::GroupedOrder, true, true, true, 2>(ring, g, S, E, F.tid); });
            SEAM(pb + 9);
            RUN(pb + 13, { pg8::Gemm g{(const bf16*)(WSP + WS_ACTE), (const bf16*)(WSP + W_EDN), pg8::TAIL_T0 * 256, 1024, DEXP / 2}; pg8::GroupedOrder S; S.so.init(pg8::TAIL_T0 * 256, 1024, F.G, bx); S.tile_e = tile_e; S.bstride = (size_t)DEXP * D;
              pg8::EpiBf16P E{(bf16*)(WSP + WS_YB), 1024, F.lds + STG_OFF, 1.0f / (F8_ACT * F8_WDN)};
              pg8::gemm_phase<pg8::EpiBf16P, pg8::GroupedOrder, true, true, true, 1>(ring, g, S, E, F.tid); });
            REFRESH();
            { pg8::Gemm g{(const bf16*)(WSP + WS_ACTE), (const bf16*)(WSP + W_EDN), 0, 1024, DEXP / 2, pg8::TAIL_NTK}; pg8::TailOrder S{(ntile - pg8::TAIL_T0) * 4 * pg8::TAIL_KS, F.G, bx, tile_e, (size_t)DEXP * D};
              pg8::EpiF32 E{(float*)(WSP + WS_PART), 1024, nullptr, F.lds + STG_OFF, 1.0f / (F8_ACT * F8_WDN)};
              pg8::gemm_phase<pg8::EpiF32, pg8::TailOrder, true, true, false, 1>(ring, g, S, E, F.tid); }
            REFRESH();
            { const int lane = F.lane, gw = F.vcu * NWAVES + F.wave, NGW = F.G * NWAVES; v4u xr[16][2];
#pragma unroll
              for (int i = 0; i < 16; ++i) { const bf16* xp = XBP + (size_t)(gw + i * NGW) * D + 16 * lane; xr[i][0] = *(const v4u*)xp; xr[i][1] = *(const v4u*)(xp + 8); }
              SEAM(pb + 10);
              const bf16* YB = (const bf16*)(WSP + WS_YB); const float* PART = (const float*)(WSP + WS_PART);
#pragma unroll
              for (int i = 0; i < 16; ++i) { const int m = gw + i * NGW; const Choice c = ((const Choice*)(WSP + WS_CHOICE))[m]; const int* sl = (const int*)(WSP + WS_SLOT) + 2 * m; const int s1 = __builtin_amdgcn_readfirstlane(sl[0]), s2 = __builtin_amdgcn_readfirstlane(sl[1]);
                  float* op = F.X + (size_t)m * D + 16 * lane;
#pragma unroll
                  for (int h = 0; h < 2; ++h) { const v4u x = xr[i][h]; f32x4 ya[2], yb[2];
                      yrow(YB, PART, s1, 16 * lane + 8 * h, ya); yrow(YB, PART, s2, 16 * lane + 8 * h, yb);
                      f32x4 o0, o1;
#pragma unroll
                      for (int q = 0; q < 2; ++q) { o0[2 * q] = bf2f(x[q] & 0xffffu) + c.w1 * ya[0][2 * q] + c.w2 * yb[0][2 * q]; o0[2 * q + 1] = bf2f(x[q] >> 16) + c.w1 * ya[0][2 * q + 1] + c.w2 * yb[0][2 * q + 1];
                          o1[2 * q] = bf2f(x[2 + q] & 0xffffu) + c.w1 * ya[1][2 * q] + c.w2 * yb[1][2 * q]; o1[2 * q + 1] = bf2f(x[2 + q] >> 16) + c.w1 * ya[1][2 * q + 1] + c.w2 * yb[1][2 * q + 1]; }
                      *(f32x4*)(op + 8 * h) = o0; *(f32x4*)(op + 8 * h + 4) = o1; } } }
        }
    }
}

#undef WSP
#undef ARP
extern "C" void kernel_launch(void* const* d_in, const int* in_sizes, int n_in, void* d_out, int out_size, void* d_ws, size_t ws_size, hipStream_t stream) {
    static int grid = 0;
    if (grid == 0) {
        if (n_in != N_IN_ || in_sizes[0] != T * D || out_size != T * D || ws_size < WS_END) {
            fprintf(stderr, "kernel_launch: unexpected shapes: n_in %d in0 %d out %d ws %zu (need %zu)\n", n_in, n_in > 0 ? in_sizes[0] : -1, out_size, ws_size, (size_t)WS_END); grid = -1; return; }
        int dev = 0, cus = 0, per_cu = 0;
        if (hipGetDevice(&dev) != hipSuccess || hipDeviceGetAttribute(&cus, hipDeviceAttributeMultiprocessorCount, dev) != hipSuccess) { grid = -1; return; }
        if (hipFuncSetAttribute((const void*)mk_fwd, hipFuncAttributeMaxDynamicSharedMemorySize, LDS_BYTES) != hipSuccess) { fprintf(stderr, "kernel_launch: hipFuncSetAttribute failed\n"); grid = -1; return; }
        if (hipOccupancyMaxActiveBlocksPerMultiprocessor(&per_cu, (const void*)mk_fwd, NTHREADS, LDS_BYTES) != hipSuccess || per_cu < 1) { fprintf(stderr, "kernel_launch: occupancy query says %d\n", per_cu); }
        (void)hipGetLastError();
        if (cus < 256) { fprintf(stderr, "kernel_launch: built for 256 CUs, found %d\n", cus); grid = -1; return; }
        grid = 256;
    }
    if (grid < 0) return;
    if (hipMemsetAsync((char*)d_ws + WS_CTL, 0, CTL_ZERO_BYTES, stream) != hipSuccess) return;
    Args a{};
    for (int i = 0; i < N_IN_; ++i) a.in[i] = (const float*)d_in[i];
    a.out = (float*)d_out; a.ws = (unsigned char*)d_ws; a.ph_lo = 0; a.ph_hi = 0;
    hipLaunchKernelGGL(mk_fwd, dim3(grid), dim3(NTHREADS), LDS_BYTES, stream, a);
}
```

```cpp
#include <hip/hip_runtime.h>
#include <hip/hip_bf16.h>
#include <cstdio>
#include <cstdint>

constexpr int D = 1024, BATCH = 8, SEQ = 4096, T = BATCH * SEQ, DEPTH = 2;
constexpr int NMEM = 256, MROWS = BATCH * NMEM;
constexpr int FH = 8, FD = 64, MH = 4, MD = 128;
constexpr int DFF = 2816, NE = 8, DEXP = 3584;
constexpr int OFF_POOL = 0, OFF_Q = 512, OFF_K = 1024, OFF_V = 1536, OFF_F = 2048, OFF_MQ = 2056, OFF_G = 2568, NIN = 5640;
constexpr float EPS = 1e-6f;
constexpr float LOG2E = 1.4426950408889634f;
constexpr float C2F = 0.125f * LOG2E;
constexpr float C2M = 0.08838834764831845f * LOG2E;
constexpr int NWAVES = 8, NTHREADS = 512;

enum { I_X = 0, I_MEM, I_MIXG, I_WIN, I_BF, I_FQG, I_FKG, I_POOLW, I_POOLS, I_MEMG, I_WKV, I_MQG, I_MKG, I_WPBR, I_WFBR, I_WMBR, I_WOUT, I_FFNG, I_WGU, I_WDN, I_WR, I_BR, I_WEGU, I_WEDN, N_IN_ };

constexpr size_t MiB = 1u << 20;
constexpr size_t WS_CTL = 0, CTL_ZERO_BYTES = 1 * MiB;
constexpr size_t WS_THR = 5 * MiB, WS_SSQ = 6 * MiB;
constexpr size_t WS_LOGF = 1 * MiB, WS_CL = 2 * MiB, WS_CHOICE = 3 * MiB, WS_WCNT = 3 * MiB + 512 * 1024;
constexpr size_t WS_W = 8 * MiB;
constexpr size_t WS_MEMN = 232 * MiB, WS_KVF = 240 * MiB, WS_KM = 256 * MiB, WS_VM = 260 * MiB;
constexpr size_t WS_H = 264 * MiB;
constexpr size_t WS_AR = 328 * MiB;
constexpr size_t AR_U = 0, AR_Q = 32 * MiB, AR_K = 64 * MiB, AR_V = 96 * MiB, AR_MQ = 128 * MiB, AR_G = 192 * MiB, AR_PD = 384 * MiB, AR_MO = 416 * MiB, AR_PO = 448 * MiB, AR_FO = 480 * MiB;
constexpr size_t AR_ACT = 0;
constexpr size_t WS_END = 896 * MiB;

constexpr int CW_TMO = 0, CW_CODE = 1, CW_BAR = 4096, CW_ATTQ = 8192;

#define GAS __attribute__((address_space(1)))
#define LAS __attribute__((address_space(3)))
typedef unsigned short bf16;
typedef unsigned v4u __attribute__((ext_vector_type(4)));
typedef unsigned v2u __attribute__((ext_vector_type(2)));
typedef float f32x4 __attribute__((ext_vector_type(4)));
typedef GAS unsigned gu32;
#define RLX_AGENT __ATOMIC_RELAXED, __HIP_MEMORY_SCOPE_AGENT
__device__ __forceinline__ float bf2f(unsigned v) { return __uint_as_float(v << 16); }
__device__ __forceinline__ unsigned f2bf(float f) { unsigned u = __float_as_uint(f); return (u + 0x7fffu + ((u >> 16) & 1u)) >> 16; }
__device__ __forceinline__ unsigned pk2(float lo, float hi) { return f2bf(lo) | (f2bf(hi) << 16); }
__device__ __forceinline__ unsigned f8x4(float a, float b, float c, float d) {
    a = __builtin_amdgcn_fmed3f(a, -448.f, 448.f); b = __builtin_amdgcn_fmed3f(b, -448.f, 448.f); c = __builtin_amdgcn_fmed3f(c, -448.f, 448.f); d = __builtin_amdgcn_fmed3f(d, -448.f, 448.f);
    int w = 0; w = __builtin_amdgcn_cvt_pk_fp8_f32(a, b, w, false); w = __builtin_amdgcn_cvt_pk_fp8_f32(c, d, w, true); return (unsigned)w; }
constexpr float F8_ACT = 8.0f, F8_WDN = 2048.0f;
constexpr float I8_H = 28.0f, I8_X1 = 24.0f, I8_W = 900.0f, I8_BIAS = 12582912.0f;
__device__ __forceinline__ unsigned i8x4(float a, float b, float c, float d) {
    const float M = 12582912.0f;
    const unsigned ia = __float_as_uint(__builtin_amdgcn_fmed3f(a, -127.f, 127.f) + M), ib = __float_as_uint(__builtin_amdgcn_fmed3f(b, -127.f, 127.f) + M),
                   ic = __float_as_uint(__builtin_amdgcn_fmed3f(c, -127.f, 127.f) + M), id = __float_as_uint(__builtin_amdgcn_fmed3f(d, -127.f, 127.f) + M);
    return (ia & 0xffu) | ((ib & 0xffu) << 8) | ((ic & 0xffu) << 16) | (id << 24); }
__device__ __forceinline__ float shx(float v, int mask, int lane) { return __int_as_float(__builtin_amdgcn_ds_bpermute((lane ^ mask) << 2, __float_as_int(v))); }
__device__ __forceinline__ int shxi(int v, int mask, int lane) { return __builtin_amdgcn_ds_bpermute((lane ^ mask) << 2, v); }
__device__ __forceinline__ float shl(float v, int src) { return __int_as_float(__builtin_amdgcn_ds_bpermute(src << 2, __float_as_int(v))); }
__device__ __forceinline__ int shli(int v, int src) { return __builtin_amdgcn_ds_bpermute(src << 2, v); }
__device__ __forceinline__ float wave_sum(float v, int lane) {
#pragma unroll
    for (int o = 1; o < 64; o <<= 1) v += shx(v, o, lane);
    return v;
}
__device__ __forceinline__ float log_sigmoid_f(float x) { return fminf(x, 0.f) - 0.6931471805599453f * __builtin_amdgcn_logf(1.0f + __builtin_amdgcn_exp2f(fabsf(x) * -1.4426950408889634f)); }
__device__ __forceinline__ float sigmoid_f(float x) { return 1.0f / (1.0f + expf(-x)); }

#define XB_TMO      128
#define XB_XCNT(j)  (256  + 64 * (j))
#define XB_XSUB(j)  (1280 + 64 * (j))
#define XB_XGEN(j)  (2304 + 64 * (j))
#define XB_TOP      3328
#define XB_TOPGEN   3392
#define XCD_BAR_WORDS 3456
#define XB_SPIN_CAP (1u << 22)

__device__ __forceinline__ unsigned xb_ld(unsigned* p)              { return __hip_atomic_load(p, __ATOMIC_RELAXED, __HIP_MEMORY_SCOPE_AGENT); }
__device__ __forceinline__ unsigned xb_add(unsigned* p, unsigned v) { return __hip_atomic_fetch_add(p, v, __ATOMIC_RELAXED, __HIP_MEMORY_SCOPE_AGENT); }
__device__ __forceinline__ unsigned xb_xcc_id() { return (unsigned)__builtin_amdgcn_s_getreg((3 << 11) | 20) & 0xFu; }
#define XB_SPIN(cond, bar) do { unsigned _sp = 0; while (cond) { __builtin_amdgcn_s_sleep(1); \
    if ((++_sp & 255u) == 0u) { if (xb_ld(&(bar)[XB_TMO])) break; if (_sp > XB_SPIN_CAP) { atomicAdd(&(bar)[XB_TMO], 1u); break; } } } } while (0)

struct XcdBarrier { unsigned* bar; unsigned x; volatile LAS unsigned* st; };

__device__ __forceinline__ XcdBarrier xcd_barrier_post(unsigned* bar, volatile LAS unsigned* st) {
    XcdBarrier b; b.bar = bar; b.x = xb_xcc_id(); b.st = st;
    if (threadIdx.x == 0) (void)xb_add(&bar[XB_XCNT(b.x)], 1u);
    return b;
}
__device__ __forceinline__ void xcd_barrier_complete(unsigned* bar, unsigned x, unsigned& nloc, unsigned& nx) {
    const unsigned G = gridDim.x * gridDim.y * gridDim.z;
    unsigned sum, cnt, mine, sp = 0u;
    for (;;) {
        sum = 0u; cnt = 0u; mine = 0u;
#pragma unroll
        for (unsigned j = 0; j < 16; ++j) { const unsigned c = xb_ld(&bar[XB_XCNT(j)]); sum += c; cnt += (c > 0u) ? 1u : 0u; mine = (j == x) ? c : mine; }
        if (sum == G) break;
        __builtin_amdgcn_s_sleep(1);
        if ((++sp & 255u) == 0u) { if (xb_ld(&bar[XB_TMO])) break; if (sp > XB_SPIN_CAP) { atomicAdd(&bar[XB_TMO], 1u); break; } }
    }
    nloc = mine > 0u ? mine : 1u; nx = cnt > 0u ? cnt : 1u;
}
__device__ __forceinline__ void xcd_barrier(const XcdBarrier& b) {
    asm volatile("s_waitcnt vmcnt(0)" ::: "memory");
    __syncthreads();
    if (threadIdx.x == 0) {
        unsigned* bar = b.bar;
        __builtin_amdgcn_s_waitcnt(0);
        unsigned nloc = b.st[0], nx = b.st[1];
        if (nloc == 0u) { xcd_barrier_complete(bar, b.x, nloc, nx); b.st[0] = nloc; b.st[1] = nx; }
        const unsigned old = xb_add(&bar[XB_XSUB(b.x)], 1u);
        const unsigned gen = old / nloc;
        if (old + 1u == (gen + 1u) * nloc) {
            __builtin_amdgcn_fence(__ATOMIC_RELEASE, "agent");
            asm volatile("s_waitcnt vmcnt(0)" ::: "memory");
            const unsigned og = xb_add(&bar[XB_TOP], 1u);
            const unsigned tg = og / nx;
            if (og + 1u == (tg + 1u) * nx) xb_add(&bar[XB_TOPGEN], 1u);
            else XB_SPIN(xb_ld(&bar[XB_TOPGEN]) == tg, bar);
            __builtin_amdgcn_fence(__ATOMIC_ACQUIRE, "agent");
            xb_add(&bar[XB_XGEN(b.x)], 1u);
            asm volatile("s_waitcnt vmcnt(0)" ::: "memory");
        } else {
            XB_SPIN(xb_ld(&bar[XB_XGEN(b.x)]) == gen, bar);
            __builtin_amdgcn_fence(__ATOMIC_ACQUIRE, "agent");
            asm volatile("s_waitcnt vmcnt(0)" ::: "memory");
        }
    }
    __syncthreads();
}

constexpr int RING_OFF = 0, RING_BYTES = 131072;
constexpr int LDSCTL_OFF = RING_BYTES, MISC_OFF = LDSCTL_OFF + 320;
constexpr int TILE_OFF = RING_BYTES + 2048, STG_OFF = RING_BYTES + 4096, LDS_BYTES = 155648;

struct Args { const float* in[N_IN_]; float* out; unsigned char* ws; int ph_lo, ph_hi; };
struct Frame {
    LAS unsigned char* lds; volatile LAS unsigned* MISC; gu32* ctl;
    int tid, lane, wave, vcu, G;
    float* X; unsigned char* ws;
};
struct Choice { int e1, e2; float w1, w2; };
constexpr int PTR_OFF = LDSCTL_OFF + 1024;
__device__ __forceinline__ const float* inptr(const Frame& F, int i) {
    int z = 0; asm volatile("" : "+v"(z));
    const volatile LAS unsigned* p = (const volatile LAS unsigned*)(F.lds + PTR_OFF + z) + 2 * i;
    const unsigned lo = __builtin_amdgcn_readfirstlane(p[0]), hi = __builtin_amdgcn_readfirstlane(p[1]);
    return (const float*)(const GAS float*)(uintptr_t)(((unsigned long long)hi << 32) | lo);
}

template <int MODE, bool XB16 = false>
__device__ __forceinline__ void norm_phase(Frame& F, const float* xin, const float* g, const float* W8, int ldw8, const float* b8, bf16* Hout, const int gw, const int NGW) {
    const int lane = F.lane;
    f32x4 gv[4];
#pragma unroll
    for (int j = 0; j < 4; ++j) gv[j] = *(const f32x4*)(g + 256 * j + 4 * lane);
    LAS f32x4* tab = (LAS f32x4*)(F.lds + RING_OFF);
    if (MODE != 0) {
        for (int q = F.tid; q < 2048; q += NTHREADS) { const int ln = q & 63, hf = (q >> 6) & 1, ji = q >> 7; const int k = 256 * (ji >> 2) + 4 * ln + (ji & 3);
            tab[q] = *(const f32x4*)(W8 + (size_t)k * ldw8 + 4 * hf); }
        __syncthreads();
    }
    f32x4 wt[4][4][2];
    if (MODE != 0) {
#pragma unroll
        for (int j = 0; j < 4; ++j)
#pragma unroll
            for (int i = 0; i < 4; ++i) { wt[j][i][0] = tab[((j * 4 + i) * 2 + 0) * 64 + lane]; wt[j][i][1] = tab[((j * 4 + i) * 2 + 1) * 64 + lane]; }
    }
    int cnt[8];
#pragma unroll
    for (int e = 0; e < 8; ++e) cnt[e] = 0;
    for (int m = gw; m < T; m += NGW) {
        f32x4 v[4]; float ss = 0.f;
        if (XB16) { const v2u* xr = (const v2u*)((const bf16*)xin + (size_t)m * D) + lane;
#pragma unroll
            for (int j = 0; j < 4; ++j) { const v2u w = xr[64 * j]; v[j] = (f32x4){bf2f(w[0] & 0xffffu), bf2f(w[0] >> 16), bf2f(w[1] & 0xffffu), bf2f(w[1] >> 16)}; }
        } else { const f32x4* xr = (const f32x4*)(xin + (size_t)m * D) + lane;
#pragma unroll
            for (int j = 0; j < 4; ++j) v[j] = xr[64 * j]; }
#pragma unroll
        for (int j = 0; j < 4; ++j) ss += (v[j][0] * v[j][0] + v[j][1] * v[j][1]) + (v[j][2] * v[j][2] + v[j][3] * v[j][3]);
        ss = wave_sum(ss, lane);
        const float rstd = 1.0f / sqrtf(ss * (1.0f / D) + EPS);
        if (MODE != 0) {
            unsigned* o4 = (unsigned*)((unsigned char*)Hout + (size_t)m * D) + lane;
#pragma unroll
            for (int j = 0; j < 4; ++j) { v[j] = v[j] * rstd * gv[j]; o4[64 * j] = i8x4(v[j][0] * I8_H, v[j][1] * I8_H, v[j][2] * I8_H, v[j][3] * I8_H); }
        } else {
        unsigned long long* o8 = (unsigned long long*)(Hout + (size_t)m * D) + lane;
#pragma unroll
        for (int j = 0; j < 4; ++j) { v[j] = v[j] * rstd * gv[j]; o8[64 * j] = (unsigned long long)pk2(v[j][0], v[j][1]) | ((unsigned long long)pk2(v[j][2], v[j][3]) << 32); }
        }
        if (MODE != 0) {
            float p[8];
#pragma unroll
            for (int e = 0; e < 8; ++e) p[e] = 0.f;
#pragma unroll
            for (int j = 0; j < 4; ++j)
#pragma unroll
                for (int i = 0; i < 4; ++i) { const f32x4 wa = wt[j][i][0], wb = wt[j][i][1]; const float hv = v[j][i];
                    p[0] = fmaf(hv, wa[0], p[0]); p[1] = fmaf(hv, wa[1], p[1]); p[2] = fmaf(hv, wa[2], p[2]); p[3] = fmaf(hv, wa[3], p[3]);
                    p[4] = fmaf(hv, wb[0], p[4]); p[5] = fmaf(hv, wb[1], p[5]); p[6] = fmaf(hv, wb[2], p[6]); p[7] = fmaf(hv, wb[3], p[7]);
                    }
            float k4[4];
            { const bool hi = (lane & 32) != 0;
#pragma unroll
              for (int i = 0; i < 4; ++i) { const float keep = hi ? p[4 + i] : p[i], send = hi ? p[i] : p[4 + i]; k4[i] = keep + shx(send, 32, lane); } }
            float k2[2];
            { const bool hi = (lane & 16) != 0;
#pragma unroll
              for (int i = 0; i < 2; ++i) { const float keep = hi ? k4[2 + i] : k4[i], send = hi ? k4[i] : k4[2 + i]; k2[i] = keep + shx(send, 16, lane); } }
            float k1;
            { const bool hi = (lane & 8) != 0; const float keep = hi ? k2[1] : k2[0], send = hi ? k2[0] : k2[1]; k1 = keep + shx(send, 8, lane); }
            k1 += shx(k1, 4, lane); k1 += shx(k1, 2, lane); k1 += shx(k1, 1, lane);
            const int e_mine = ((lane >> 5) & 1) * 4 + ((lane >> 4) & 1) * 2 + ((lane >> 3) & 1);
            const float val = k1 + b8[e_mine];
            if (MODE == 1) {
                if ((lane & 7) == 0) { const int b = m / SEQ, s = m % SEQ; ((float*)(F.ws + WS_LOGF))[(size_t)(b * FH + e_mine) * SEQ + s] = log_sigmoid_f(val); }
            } else {
                float lg[8];
#pragma unroll
                for (int e = 0; e < 8; ++e) lg[e] = shl(val, ((e >> 2) & 1) * 32 + ((e >> 1) & 1) * 16 + (e & 1) * 8);
                float b1 = -INFINITY, b2 = -INFINITY; int i1 = 0, i2 = 0;
#pragma unroll
                for (int e = 0; e < 8; ++e) { if (lg[e] > b1) { b2 = b1; i2 = i1; b1 = lg[e]; i1 = e; } else if (lg[e] > b2) { b2 = lg[e]; i2 = e; } }
                const float ex = __builtin_amdgcn_exp2f((b2 - b1) * 1.4426950408889634f), w1 = 1.0f / (1.0f + ex), w2 = ex / (1.0f + ex);
                if (lane == 0) { Choice c; c.e1 = i1; c.e2 = i2; c.w1 = w1; c.w2 = w2; ((Choice*)(F.ws + WS_CHOICE))[m] = c; }
#pragma unroll
                for (int e = 0; e < 8; ++e) cnt[e] += (i1 == e) + (i2 == e);
            }
        }
    }
    if (MODE != 0) __syncthreads();
    if (MODE == 2) {
        int mine = 0;
#pragma unroll
        for (int e = 0; e < 8; ++e) mine = (lane == e) ? cnt[e] : mine;
        if (lane < 8) ((int*)(F.ws + WS_WCNT))[gw * 8 + lane] = mine;
    }
}

__device__ __forceinline__ void cumsum_phase(Frame& F, const float* fqg, const float* fkg) {
    if (F.vcu >= BATCH * FH) return;
    if (F.wave == 0) { float mq = fabsf(fqg[F.lane]), mk = fabsf(fkg[F.lane]);
#pragma unroll
      for (int o = 1; o < 64; o <<= 1) { mq = fmaxf(mq, shx(mq, o, F.lane)); mk = fmaxf(mk, shx(mk, o, F.lane)); }
      if (F.lane == 0) ((float*)(F.ws + WS_THR))[F.vcu] = 2.0f * (8.0f * LOG2E * mq * mk) + 32.0f; }
    const float* lf = (const float*)(F.ws + WS_LOGF) + (size_t)F.vcu * SEQ + 8 * F.tid;
    float* cl = (float*)(F.ws + WS_CL) + (size_t)F.vcu * SEQ + 8 * F.tid;
    const f32x4 a = *(const f32x4*)lf, b = *(const f32x4*)(lf + 4);
    double p[8]; p[0] = (double)a[0]; p[1] = p[0] + (double)a[1]; p[2] = p[1] + (double)a[2]; p[3] = p[2] + (double)a[3];
    p[4] = p[3] + (double)b[0]; p[5] = p[4] + (double)b[1]; p[6] = p[5] + (double)b[2]; p[7] = p[6] + (double)b[3];
    double inc = p[7];
#pragma unroll
    for (int o = 1; o < 64; o <<= 1) { const int src = (F.lane >= o ? F.lane - o : F.lane); const unsigned long long bits = __builtin_bit_cast(unsigned long long, inc);
        const unsigned lo_ = (unsigned)shli((int)(unsigned)bits, src), hi_ = (unsigned)shli((int)(unsigned)(bits >> 32), src); const double t = __builtin_bit_cast(double, ((unsigned long long)hi_ << 32) | lo_); if (F.lane >= o) inc += t; }
    volatile LAS double* wt = (volatile LAS double*)(F.lds + RING_OFF);
    if (F.lane == 63) wt[F.wave] = inc;
    __syncthreads();
    double off = inc - p[7];
    for (int w = 0; w < F.wave; ++w) off += wt[w];
    f32x4 oa, ob;
    oa[0] = (float)((off + p[0]) * 1.4426950408889634); oa[1] = (float)((off + p[1]) * 1.4426950408889634); oa[2] = (float)((off + p[2]) * 1.4426950408889634); oa[3] = (float)((off + p[3]) * 1.4426950408889634);
    ob[0] = (float)((off + p[4]) * 1.4426950408889634); ob[1] = (float)((off + p[5]) * 1.4426950408889634); ob[2] = (float)((off + p[6]) * 1.4426950408889634); ob[3] = (float)((off + p[7]) * 1.4426950408889634);
    *(f32x4*)cl = oa; *(f32x4*)(cl + 4) = ob;
    __syncthreads();
}

__device__ __forceinline__ void pool_phase(Frame& F) {
    const bf16* U = (const bf16*)(F.ws + WS_AR + AR_U); bf16* PD = (bf16*)(F.ws + WS_AR + AR_PD);
    const int lane = F.lane, gw = F.vcu * NWAVES + F.wave, NGW = F.G * NWAVES;
    const int wsel = lane >> 4, w = 2 << wsel;
    for (int chk = gw; chk < T / 16; chk += NGW) {
        const int m0 = chk * 16, t0 = m0 % SEQ;
        v4u x[31];
#pragma unroll
        for (int kk = 0; kk < 31; ++kk) { x[kk] = (v4u){0u, 0u, 0u, 0u}; if (t0 + kk - 15 >= 0 && kk + w > 15) x[kk] = *(const v4u*)(U + (size_t)(m0 - 15 + kk) * 512 + 8 * lane); }
        float s[8];
#pragma unroll
        for (int i = 0; i < 8; ++i) s[i] = 0.f;
#pragma unroll
        for (int j = 0; j < 16; ++j) {
#pragma unroll
            for (int i = 0; i < 4; ++i) { s[2 * i] += bf2f(x[15 - j][i] & 0xffffu); s[2 * i + 1] += bf2f(x[15 - j][i] >> 16); } }
#pragma unroll
        for (int q = 0; q < 16; ++q) {
            if (q > 0) {
                const v4u in = x[15 + q];
                v4u out;
#pragma unroll
                for (int i = 0; i < 4; ++i) out[i] = wsel == 0 ? x[13 + q][i] : (wsel == 1 ? x[11 + q][i] : (wsel == 2 ? x[7 + q][i] : x[q - 1][i]));
#pragma unroll
                for (int i = 0; i < 4; ++i) { s[2 * i] += bf2f(in[i] & 0xffffu) - bf2f(out[i] & 0xffffu); s[2 * i + 1] += bf2f(in[i] >> 16) - bf2f(out[i] >> 16); }
            }
            const int tt = t0 + q; const int n = (tt + 1 < w) ? (tt + 1) : w;
            const float inv = 1.0f / (float)n; const v4u cur = x[15 + q]; v4u o;
#pragma unroll
            for (int i = 0; i < 4; ++i) o[i] = pk2(s[2 * i] * inv - bf2f(cur[i] & 0xffffu), s[2 * i + 1] * inv - bf2f(cur[i] >> 16));
            *(v4u*)(PD + (size_t)(m0 + q) * 512 + 8 * lane) = o;
        }
    }
}

__device__ __forceinline__ void memnorm_phase(Frame& F, const float* mem, const float* memg) {
    const int lane = F.lane, gw = F.vcu * NWAVES + F.wave, NGW = F.G * NWAVES;
    for (int it = gw; it < DEPTH * MROWS; it += NGW) {
        const int l = it / MROWS, r = it % MROWS;
        const f32x4* xr = (const f32x4*)(mem + (size_t)r * D) + lane; const float* g = memg + l * D;
        f32x4 v[4]; float ss = 0.f;
#pragma unroll
        for (int j = 0; j < 4; ++j) { v[j] = xr[64 * j]; ss += (v[j][0] * v[j][0] + v[j][1] * v[j][1]) + (v[j][2] * v[j][2] + v[j][3] * v[j][3]); }
        ss = wave_sum(ss, lane); const float rstd = 1.0f / sqrtf(ss * (1.0f / D) + EPS);
        unsigned long long* o8 = (unsigned long long*)((bf16*)(F.ws + WS_MEMN) + (size_t)it * D) + lane;
#pragma unroll
        for (int j = 0; j < 4; ++j) { const f32x4 h = v[j] * rstd * *(const f32x4*)(g + 256 * j + 4 * lane); o8[64 * j] = (unsigned long long)pk2(h[0], h[1]) | ((unsigned long long)pk2(h[2], h[3]) << 32); }
    }
}
__device__ __forceinline__ void kvfin_phase(Frame& F, const float* mkg) {
    const int lane = F.lane, gw = F.vcu * NWAVES + F.wave, NGW = F.G * NWAVES;
    for (int it = gw; it < DEPTH * MROWS; it += NGW) {
        const int l = it / MROWS;
        const f32x4* xr = (const f32x4*)((const float*)(F.ws + WS_KVF) + (size_t)it * 1024) + lane;
        f32x4 v[4];
#pragma unroll
        for (int j = 0; j < 4; ++j) v[j] = xr[64 * j];
        unsigned long long* ok = (unsigned long long*)((bf16*)(F.ws + WS_KM) + (size_t)it * 512) + lane;
        unsigned long long* ov = (unsigned long long*)((bf16*)(F.ws + WS_VM) + (size_t)it * 512) + lane;
#pragma unroll
        for (int j = 0; j < 2; ++j) {
            float ss = (v[j][0] * v[j][0] + v[j][1] * v[j][1]) + (v[j][2] * v[j][2] + v[j][3] * v[j][3]);
#pragma unroll
            for (int o = 1; o < 32; o <<= 1) ss += shx(ss, o, lane);
            const float rstd = 1.0f / sqrtf(ss * (1.0f / MD) + EPS);
            const f32x4 gg = *(const f32x4*)(mkg + l * MD + 4 * (lane & 31));
            const f32x4 h = v[j] * rstd * gg; ok[64 * j] = (unsigned long long)pk2(h[0], h[1]) | ((unsigned long long)pk2(h[2], h[3]) << 32);
        }
#pragma unroll
        for (int j = 0; j < 2; ++j) { const f32x4 h = v[2 + j]; ov[64 * j] = (unsigned long long)pk2(h[0], h[1]) | ((unsigned long long)pk2(h[2], h[3]) << 32); }
    }
}

namespace pg8 {
#define PG8_LAS __attribute__((address_space(3)))
typedef unsigned short bf16_t;
typedef short bf16x8 __attribute__((ext_vector_type(8)));
typedef float f32x4 __attribute__((ext_vector_type(4)));
typedef unsigned u32x4 __attribute__((ext_vector_type(4)));
constexpr int BM = 256, BK = 64, HALF = 128, HTB = HALF * BK * 2  , STAGE_BYTES = 8 * HTB, NXCD = 8, WGM = 8;

__host__ __device__ __forceinline__ int lds_byte(int r, int c) { const int st = (r >> 4) * 2 + (c >> 5), rr = r & 15, cc = c & 31, ob = rr * 64 + cc * 2; return st * 1024 + (ob ^ (((ob >> 9) & 1) << 5)); }
__host__ __device__ __forceinline__ void stage_rc(int b, int& R, int& C) { const int st = b / 1024, sb = b % 1024, swz = sb ^ (((sb >> 9) & 1) << 5); R = (st >> 1) * 16 + swz / 64; C = (st & 1) * 32 + (swz % 64) / 2; }
__host__ __device__ __forceinline__ int perm32(int rho) { const int n = rho >> 4, i = rho & 15; return 8 * (i >> 2) + 4 * n + (i & 3); }

struct Unit { int pm, pn, aux; };
struct Gemm { const bf16_t* A; const bf16_t* Bt; int M, N, K; int ntk = 0; };

struct StaticOrder {
    int nM, nN, nwg, G, c;
    __host__ __device__ void init(int M, int N, int G_, int c_) { nM = M / BM; nN = N / BM; nwg = nM * nN; G = G_; c = c_; }
    __host__ __device__ bool next(int i, Unit& u) const {
        const long L = (long)i * G + c; if (L >= nwg) return false;
        int wgid = (int)L; { const int q = nwg / NXCD, r = nwg % NXCD, xcd = wgid % NXCD, off = wgid / NXCD; wgid = (xcd < r ? xcd * (q + 1) : r * (q + 1) + (xcd - r) * q) + off; }
        const int nig = WGM * nN, gid = wgid / nig, fm = gid * WGM, gsz = (nM - fm) < WGM ? (nM - fm) : WGM;
        u.pm = fm + ((wgid % nig) % gsz); u.pn = (wgid % nig) / gsz; u.aux = 0; return true;
    }
    __device__ __forceinline__ void ptrs(const Gemm& g, const Unit& u, const char*& a, const char*& b) const { a = (const char*)g.A + (size_t)u.pm * (size_t)(BM * 2) * g.K; b = (const char*)g.Bt + (size_t)u.pn * (size_t)(BM * 2) * g.K; }
    __device__ __forceinline__ void a_ready(const Unit&) const {}
    __device__ __forceinline__ void done(const Unit&) const {}
};

typedef float f32x2_cv __attribute__((ext_vector_type(2))); typedef __bf16 bf16x2_cv __attribute__((ext_vector_type(2)));
__device__ __forceinline__ unsigned cvt_pk_bf16(float lo, float hi) { const f32x2_cv v = {lo, hi}; const bf16x2_cv b = __builtin_convertvector(v, bf16x2_cv); return __builtin_bit_cast(unsigned, b); }

typedef int i32x4_t __attribute__((ext_vector_type(4))); typedef int i32x8_t __attribute__((ext_vector_type(8)));
__device__ __forceinline__ i32x8_t cat8(const bf16x8& a, const bf16x8& b) { return __builtin_shufflevector(__builtin_bit_cast(i32x4_t, a), __builtin_bit_cast(i32x4_t, b), 0, 1, 2, 3, 4, 5, 6, 7); }
template <class Epi, class Sched, bool ALIGN_EPI = false, bool SP2 = false, bool RELAX = false, int OPM = 0>
__device__ __forceinline__ void gemm_phase(PG8_LAS unsigned char* lds, const Gemm g, const Sched& S, const Epi& E, const int tid_opaque) {
    constexpr bool F8 = (OPM == 1), I8 = (OPM == 2);
    constexpr float ACC0 = I8 ? I8_BIAS : 0.0f;
    const int tid = tid_opaque, wid = __builtin_amdgcn_readfirstlane(tid >> 6), lane = tid & 63, wr = wid >> 2, wc = wid & 3, fr = lane & 15, fq = lane >> 4;
    const int K = g.K, nt = g.ntk ? g.ntk : K / BK;
    unsigned voffA[2], voffB[2];
#pragma unroll
    for (int i = 0; i < 2; ++i) { int R, C; stage_rc(tid * 16 + i * 8192, R, C); const int Rb = Epi::PERM ? ((R & ~31) + perm32(R & 31)) : R;
        voffA[i] = (unsigned)(R * K + C) * 2u; voffB[i] = (unsigned)(Rb * K + C) * 2u; }
    const size_t kstep = (size_t)(BK * 2);
    const size_t hstep = (size_t)HALF * K * 2;
    const unsigned ldsw = (unsigned)wid * 1024u;
    const int aoff = lds_byte(wr * 64 + fr, fq * 8), boff = lds_byte(wc * 32 + fr, fq * 8);
#define PG8_SA(b, h) (((b) * 2 + (h)) * HTB)
#define PG8_SB(b, h) ((4 + (b) * 2 + (h)) * HTB)
    const unsigned ldsbase = (unsigned)__builtin_amdgcn_readfirstlane((int)(unsigned)(uintptr_t)lds) + ldsw;
#define PG8_STAGE(bufoff, gbase, voff) do { if constexpr (OPM != 0) { const unsigned long long gb_ = (unsigned long long)(uintptr_t)(gbase); \
        const unsigned long long gbu_ = ((unsigned long long)(unsigned)__builtin_amdgcn_readfirstlane((int)(unsigned)(gb_ >> 32)) << 32) | (unsigned)__builtin_amdgcn_readfirstlane((int)(unsigned)gb_); \
        _Pragma("unroll") for (int _i = 0; _i < 2; ++_i) { const unsigned la_ = ldsbase + (unsigned)(bufoff) + (unsigned)_i * 8192u; \
            asm volatile("s_mov_b32 m0, %0\n\ts_nop 0\n\tglobal_load_lds_dwordx4 %1, %2" :: "s"(la_), "v"((voff)[_i]), "s"(gbu_) : "memory"); } } \
      else { _Pragma("unroll") for (int _i = 0; _i < 2; ++_i) \
        __builtin_amdgcn_global_load_lds((const unsigned*)((const char*)(gbase) + (voff)[_i]), (PG8_LAS unsigned*)(lds + (bufoff) + ldsw + _i * 8192), 16, 0, 0); } } while (0)
#define PG8_LDA(dst, b, h) do { _Pragma("unroll") for (int m = 0; m < 4; ++m) _Pragma("unroll") for (int k = 0; k < 2; ++k) dst[m][k] = *(const PG8_LAS bf16x8*)(lds + PG8_SA(b, h) + aoff + m * 2048 + k * 1024); } while (0)
#define PG8_LDB(dst, b, h) do { _Pragma("unroll") for (int n = 0; n < 2; ++n) _Pragma("unroll") for (int k = 0; k < 2; ++k) dst[n][k] = *(const PG8_LAS bf16x8*)(lds + PG8_SB(b, h) + boff + n * 2048 + k * 1024); } while (0)
#define PG8_MMA(ai, bj, At, Bt) do { __builtin_amdgcn_s_setprio(1); \
        if constexpr (F8) { _Pragma("unroll") for (int m = 0; m < 4; ++m) _Pragma("unroll") for (int n = 0; n < 2; ++n) \
            acc[ai][bj][m][n] = __builtin_amdgcn_mfma_scale_f32_16x16x128_f8f6f4(cat8(Bt[n][0], Bt[n][1]), cat8(At[m][0], At[m][1]), acc[ai][bj][m][n], 0, 0, 0, 0, 0, 0); } \
        else if constexpr (I8) { _Pragma("unroll") for (int m = 0; m < 4; ++m) _Pragma("unroll") for (int n = 0; n < 2; ++n) _Pragma("unroll") for (int k = 0; k < 2; ++k) \
            acc[ai][bj][m][n] = __builtin_bit_cast(f32x4, __builtin_amdgcn_mfma_i32_16x16x64_i8(__builtin_bit_cast(i32x4_t, Bt[n][k]), __builtin_bit_cast(i32x4_t, At[m][k]), __builtin_bit_cast(i32x4_t, acc[ai][bj][m][n]), 0, 0, 0)); } \
        else { _Pragma("unroll") for (int m = 0; m < 4; ++m) _Pragma("unroll") for (int n = 0; n < 2; ++n) _Pragma("unroll") for (int k = 0; k < 2; ++k) \
            acc[ai][bj][m][n] = __builtin_amdgcn_mfma_f32_16x16x32_bf16(Bt[n][k], At[m][k], acc[ai][bj][m][n], 0, 0, 0); } \
        __builtin_amdgcn_s_setprio(0); } while (0)
#define PG8_WAIT_V(n) asm volatile("s_waitcnt vmcnt(" #n ")" ::: "memory")
#define PG8_WAIT_L(n) asm volatile("s_waitcnt lgkmcnt(" #n ")" ::: "memory")
#define PG8_BAR __builtin_amdgcn_s_barrier()
#define PG8_SCHED __builtin_amdgcn_sched_barrier(0)
    Unit cur, nxt; int ui = 0;
    if (!S.next(0, cur)) return;
    f32x4 acc[2][2][4][2];
    float a0_ = ACC0; if constexpr (I8) asm volatile("" : "+s"(a0_));
#pragma unroll
    for (int a = 0; a < 2; ++a)
#pragma unroll
        for (int b = 0; b < 2; ++b)
#pragma unroll
            for (int m = 0; m < 4; ++m)
#pragma unroll
                for (int n = 0; n < 2; ++n) acc[a][b][m][n] = (f32x4){a0_, a0_, a0_, a0_};
    bf16x8 At[4][2], B0[2][2], B1[2][2];
    const char* cA; const char* cB; S.ptrs(g, cur, cA, cB);
    S.a_ready(cur);
    if constexpr (SP2) {
        PG8_STAGE(PG8_SB(0, 0), cB, voffB); PG8_STAGE(PG8_SB(0, 1), cB + hstep, voffB); PG8_STAGE(PG8_SA(0, 0), cA, voffA); PG8_STAGE(PG8_SA(0, 1), cA + hstep, voffA);
        if (wr == 1) PG8_BAR;
        PG8_WAIT_V(2); PG8_BAR;
        PG8_STAGE(PG8_SB(1, 0), cB + kstep, voffB); PG8_STAGE(PG8_SA(1, 0), cA + kstep, voffA); PG8_STAGE(PG8_SB(1, 1), cB + hstep + kstep, voffB);
        PG8_WAIT_V(6); PG8_BAR;
    } else {
        PG8_STAGE(PG8_SB(0, 0), cB, voffB); PG8_STAGE(PG8_SA(0, 0), cA, voffA); PG8_STAGE(PG8_SB(0, 1), cB + hstep, voffB); PG8_STAGE(PG8_SA(0, 1), cA + hstep, voffA);
        if (wr == 1) PG8_BAR;
        PG8_WAIT_V(4); PG8_BAR;
        PG8_STAGE(PG8_SB(1, 0), cB + kstep, voffB); PG8_STAGE(PG8_SA(1, 0), cA + kstep, voffA); PG8_STAGE(PG8_SB(1, 1), cB + hstep + kstep, voffB);
        PG8_WAIT_V(6); PG8_BAR;
    }
    static_assert(SP2, "the relaxed waits are written for the two-super-phase loop");
    constexpr int NV = RELAX ? Epi::NVMEM : 0;
#define PG8_WAIT_VRELAX() do { if constexpr (NV >= 32) PG8_WAIT_V(42); else if constexpr (NV >= 16) PG8_WAIT_V(26); else if constexpr (NV >= 8) PG8_WAIT_V(18); else PG8_WAIT_V(8); } while (0)
#define PG8_WAIT_V8() PG8_WAIT_V(8)
#define PG8_KITER(t, WAITX, STAGE1) do { \
            const bool last = ((t) == nt - 2); \
            const char* a1 = cA + (size_t)((t) + 1) * kstep; \
            const char* a2 = last ? nA : cA + (size_t)((t) + 2) * kstep; const char* b2 = last ? nB : cB + (size_t)((t) + 2) * kstep; \
            const char* a3 = a2 + kstep; const char* b3 = b2 + kstep; \
            if (last && has_next) S.a_ready(nxt); \
              \
            PG8_LDB(B0, 0, 0); PG8_LDB(B1, 0, 1); PG8_SCHED; PG8_LDA(At, 0, 0); if (STAGE1) PG8_STAGE(PG8_SA(1, 1), a1 + hstep, voffA); \
            WAITX(); PG8_WAIT_L(0); PG8_BAR; PG8_MMA(0, 0, At, B0); PG8_MMA(0, 1, At, B1); PG8_BAR; PG8_SCHED; \
              \
            PG8_LDA(At, 0, 1); PG8_STAGE(PG8_SB(0, 0), b2, voffB); PG8_STAGE(PG8_SB(0, 1), b2 + hstep, voffB); PG8_STAGE(PG8_SA(0, 0), a2, voffA); \
            WAITX(); PG8_WAIT_L(0); PG8_BAR; PG8_MMA(1, 0, At, B0); PG8_MMA(1, 1, At, B1); PG8_BAR; PG8_SCHED; \
              \
            PG8_LDB(B0, 1, 0); PG8_LDB(B1, 1, 1); PG8_SCHED; PG8_LDA(At, 1, 0); PG8_STAGE(PG8_SA(0, 1), a2 + hstep, voffA); \
            WAITX(); PG8_WAIT_L(0); PG8_BAR; PG8_MMA(0, 0, At, B0); PG8_MMA(0, 1, At, B1); PG8_BAR; PG8_SCHED; \
              \
            PG8_LDA(At, 1, 1); PG8_STAGE(PG8_SB(1, 0), b3, voffB); PG8_STAGE(PG8_SB(1, 1), b3 + hstep, voffB); PG8_STAGE(PG8_SA(1, 0), a3, voffA); \
            PG8_WAIT_V(8); PG8_WAIT_L(0); PG8_BAR; PG8_MMA(1, 0, At, B0); PG8_MMA(1, 1, At, B1); PG8_BAR; PG8_SCHED; } while (0)
    for (;;) {
        const bool has_next = S.next(ui + 1, nxt);
        const char* nA = cA; const char* nB = cB; if (has_next) S.ptrs(g, nxt, nA, nB);
        int t = 0;
        if constexpr (NV > 0) if (ui > 0) { PG8_KITER(0, PG8_WAIT_VRELAX, true); t = 2; }
#pragma unroll 1
        for (; t < nt; t += 2) PG8_KITER(t, PG8_WAIT_V8, true);
        if constexpr (ALIGN_EPI) { if (wr == 0) PG8_BAR; }
        if (has_next && NV > 0) PG8_STAGE(PG8_SA(1, 1), nA + kstep + hstep, voffA);
        if constexpr (!Epi::AFTER_DRAIN) { int el_; asm volatile("v_mbcnt_lo_u32_b32 %0, -1, 0\n\tv_mbcnt_hi_u32_b32 %0, -1, %0" : "=v"(el_)); const int efr = el_ & 15, efq = el_ >> 4;
            E(acc, cur, wr, wc, efr, efq); S.done(cur); }
        if (!has_next) break;
        float a1_ = ACC0; if constexpr (I8) asm volatile("" : "+s"(a1_));
        if (E.zero_after(cur))
#pragma unroll
        for (int a = 0; a < 2; ++a)
#pragma unroll
            for (int b = 0; b < 2; ++b)
#pragma unroll
                for (int m = 0; m < 4; ++m)
#pragma unroll
                    for (int n = 0; n < 2; ++n) acc[a][b][m][n] = (f32x4){a1_, a1_, a1_, a1_};
        cur = nxt; cA = nA; cB = nB; ++ui;
        if constexpr (ALIGN_EPI) { if (wr == 1) PG8_BAR; }
    }
    PG8_WAIT_V(0);
    if constexpr (!ALIGN_EPI) { if (wr == 0) PG8_BAR; }
    PG8_BAR;
    if constexpr (Epi::AFTER_DRAIN) { E.fused(acc, cur, wr, wc, fr, fq, lds, wid, lane); S.done(cur); }
#undef PG8_SA
#undef PG8_SB
#undef PG8_STAGE
#undef PG8_LDA
#undef PG8_LDB
#undef PG8_MMA
#undef PG8_WAIT_V
#undef PG8_WAIT_VRELAX
#undef PG8_WAIT_V8
#undef PG8_KITER
#undef PG8_WAIT_L
#undef PG8_BAR
#undef PG8_SCHED
}
}

namespace pg8 {
typedef unsigned u32x2 __attribute__((ext_vector_type(2)));
__device__ __forceinline__ float fsigmoid(float x) { return __builtin_amdgcn_rcpf(1.0f + __builtin_amdgcn_exp2f(x * -1.4426950408889634f)); }
__device__ __forceinline__ u32x4 pack8(const f32x4& a, const f32x4& b) { u32x4 w; w.x = cvt_pk_bf16(a[0], a[1]); w.y = cvt_pk_bf16(a[2], a[3]); w.z = cvt_pk_bf16(b[0], b[1]); w.w = cvt_pk_bf16(b[2], b[3]); return w; }

constexpr int STG_ROW = 144, STG_WAVE = 16 * STG_ROW;
template <bool ST = true> __device__ __forceinline__ void st_rows_bf16(PG8_LAS unsigned char* st, int fr, int fq, const u32x4& w0, const u32x4& w1, bf16_t* gdst, size_t ldc) {
    *(PG8_LAS u32x4*)(st + fr * STG_ROW + 16 * fq) = w0; *(PG8_LAS u32x4*)(st + fr * STG_ROW + 64 + 16 * fq) = w1;
    const int lane = fq * 16 + fr, rr = lane >> 3, ch = lane & 7;
    const u32x4 a = *(const PG8_LAS u32x4*)(st + rr * STG_ROW + ch * 16), b = *(const PG8_LAS u32x4*)(st + (rr + 8) * STG_ROW + ch * 16);
    if (ST) { *(u32x4*)(gdst + (size_t)rr * ldc + ch * 8) = a; *(u32x4*)(gdst + (size_t)(rr + 8) * ldc + ch * 8) = b; } else asm volatile("" :: "v"(a), "v"(b));
}
__device__ __forceinline__ void ld_rows_bf16(PG8_LAS unsigned char* st, int fr, int fq, const bf16_t* gsrc, size_t ldc, u32x4& g0, u32x4& g1) {
    const int lane = fq * 16 + fr, rr = lane >> 3, ch = lane & 7;
    const u32x4 a = *(const u32x4*)(gsrc + (size_t)rr * ldc + ch * 8), b = *(const u32x4*)(gsrc + (size_t)(rr + 8) * ldc + ch * 8);
    *(PG8_LAS u32x4*)(st + rr * STG_ROW + ch * 16) = a; *(PG8_LAS u32x4*)(st + (rr + 8) * STG_ROW + ch * 16) = b;
    g0 = *(const PG8_LAS u32x4*)(st + fr * STG_ROW + 16 * fq); g1 = *(const PG8_LAS u32x4*)(st + fr * STG_ROW + 64 + 16 * fq);
}
template <bool ST = true> __device__ __forceinline__ void st_rows_f32(PG8_LAS unsigned char* st, int fr, int fq, int c0, int c1, const f32x4& v0, const f32x4& v1, float* gdst, const float* gbase, size_t ldc) {
    *(PG8_LAS f32x4*)(st + fr * STG_ROW + c0) = v0; *(PG8_LAS f32x4*)(st + fr * STG_ROW + c1) = v1;
    const int lane = fq * 16 + fr, rr = lane >> 3, ch = lane & 7;
    f32x4 a = *(const PG8_LAS f32x4*)(st + rr * STG_ROW + ch * 16), b = *(const PG8_LAS f32x4*)(st + (rr + 8) * STG_ROW + ch * 16);
    if (gbase) { a += *(const f32x4*)(gbase + (size_t)rr * ldc + ch * 4); b += *(const f32x4*)(gbase + (size_t)(rr + 8) * ldc + ch * 4); }
    if (ST) { *(f32x4*)(gdst + (size_t)rr * ldc + ch * 4) = a; *(f32x4*)(gdst + (size_t)(rr + 8) * ldc + ch * 4) = b; } else asm volatile("" :: "v"(a), "v"(b));
}

struct EpiF32 {
    static constexpr int NVMEM = 32;
    static constexpr bool PERM = false, AFTER_DRAIN = false;
    float* C; int ldc; const float* base; PG8_LAS unsigned char* stg; float sc = 1.0f;
    __device__ __forceinline__ bool zero_after(const Unit&) const { return true; }
    __device__ __forceinline__ void operator()(f32x4 (&acc)[2][2][4][2], const Unit& u, int wr, int wc, int fr, int fq) const {
        PG8_LAS unsigned char* st = stg + (wr * 4 + wc) * STG_WAVE;
        const int row0 = u.pm * BM + wr * 64, col0 = u.pn * BM + wc * 64;
        const int lane = fq * 16 + fr, rr = lane >> 3, ch = lane & 7;
#pragma unroll
        for (int ai = 0; ai < 2; ++ai) {
            f32x4 bv[4][2][2];
            if (base) {
#pragma unroll
                for (int m = 0; m < 4; ++m)
#pragma unroll
                    for (int bj = 0; bj < 2; ++bj) { const float* bp = base + (size_t)(row0 + ai * HALF + m * 16 + rr) * ldc + col0 + 32 * bj + ch * 4;
                        bv[m][bj][0] = *(const f32x4*)bp; bv[m][bj][1] = *(const f32x4*)(bp + (size_t)8 * ldc); }
            }
#pragma unroll
            for (int m = 0; m < 4; ++m)
#pragma unroll
                for (int bj = 0; bj < 2; ++bj) {
                    *(PG8_LAS f32x4*)(st + fr * STG_ROW + 16 * fq) = acc[ai][bj][m][0] * sc; *(PG8_LAS f32x4*)(st + fr * STG_ROW + 64 + 16 * fq) = acc[ai][bj][m][1] * sc;
                    f32x4 a = *(const PG8_LAS f32x4*)(st + rr * STG_ROW + ch * 16), b = *(const PG8_LAS f32x4*)(st + (rr + 8) * STG_ROW + ch * 16);
                    if (base) { a += bv[m][bj][0]; b += bv[m][bj][1]; }
                    float* cp = C + (size_t)(row0 + ai * HALF + m * 16 + rr) * ldc + col0 + 32 * bj + ch * 4;
                    *(f32x4*)cp = a; *(f32x4*)(cp + (size_t)8 * ldc) = b; }
        }
    }
};
template <bool BASEF32, bool SSQ = false>
struct EpiResBf16 {
    static constexpr int NVMEM = 16;
    static constexpr bool PERM = true, AFTER_DRAIN = false;
    bf16_t* O; const void* base; PG8_LAS unsigned char* stg; float* ssq; unsigned char* o8; float sc;
    __device__ __forceinline__ bool zero_after(const Unit&) const { return true; }
    __device__ __forceinline__ void operator()(f32x4 (&acc)[2][2][4][2], const Unit& u, int wr, int wc, int fr, int fq) const {
        PG8_LAS unsigned char* st = stg + (wr * 4 + wc) * STG_WAVE;
        const int row0 = u.pm * BM + wr * 64, col0 = u.pn * BM + wc * 64;
        const int lane = fq * 16 + fr, rr = lane >> 3, ch = lane & 7;
#pragma unroll
        for (int ai = 0; ai < 2; ++ai) {
            if (BASEF32) {
                f32x4 bb[4][2][2];
#pragma unroll
                for (int m = 0; m < 4; ++m)
#pragma unroll
                    for (int bj = 0; bj < 2; ++bj) { const float* bp = (const float*)base + (size_t)(row0 + ai * HALF + m * 16 + fr) * 1024 + col0 + 32 * bj + 8 * fq;
                        bb[m][bj][0] = *(const f32x4*)bp; bb[m][bj][1] = *(const f32x4*)(bp + 4); }
#pragma unroll
                for (int m = 0; m < 4; ++m) { const f32x4 x00 = acc[ai][0][m][0] * sc + bb[m][0][0], x01 = acc[ai][0][m][1] * sc + bb[m][0][1], x10 = acc[ai][1][m][0] * sc + bb[m][1][0], x11 = acc[ai][1][m][1] * sc + bb[m][1][1];
                    const u32x4 w0 = pack8(x00, x01), w1 = pack8(x10, x11);
                    if (o8) { unsigned char* p8 = o8 + (size_t)(row0 + ai * HALF + m * 16 + fr) * 1024 + col0 + 8 * fq; u32x2 a8, b8;
                        a8.x = i8x4(x00[0] * I8_X1, x00[1] * I8_X1, x00[2] * I8_X1, x00[3] * I8_X1); a8.y = i8x4(x01[0] * I8_X1, x01[1] * I8_X1, x01[2] * I8_X1, x01[3] * I8_X1);
                        b8.x = i8x4(x10[0] * I8_X1, x10[1] * I8_X1, x10[2] * I8_X1, x10[3] * I8_X1); b8.y = i8x4(x11[0] * I8_X1, x11[1] * I8_X1, x11[2] * I8_X1, x11[3] * I8_X1);
                        *(u32x2*)p8 = a8; *(u32x2*)(p8 + 32) = b8; }
                    if (SSQ) { float s = 0.f;
#pragma unroll
                        for (int i = 0; i < 4; ++i) { const float a0 = __uint_as_float(w0[i] << 16), a1 = __uint_as_float(w0[i] & 0xffff0000u), b0 = __uint_as_float(w1[i] << 16), b1 = __uint_as_float(w1[i] & 0xffff0000u); s += (a0 * a0 + a1 * a1) + (b0 * b0 + b1 * b1); }
                        s += shx(s, 16, lane); s += shx(s, 32, lane);
                        if (fq == 0) ssq[(size_t)(row0 + ai * HALF + m * 16 + fr) * 16 + 4 * u.pn + wc] = s; }
                    st_rows_bf16(st, fr, fq, w0, w1, O + (size_t)(row0 + ai * HALF + m * 16) * 1024 + col0, 1024); }
            } else {
                u32x4 rb[4][2];
#pragma unroll
                for (int m = 0; m < 4; ++m) { const bf16_t* bp = (const bf16_t*)base + (size_t)(row0 + ai * HALF + m * 16 + rr) * 1024 + col0 + ch * 8; rb[m][0] = *(const u32x4*)bp; rb[m][1] = *(const u32x4*)(bp + (size_t)8 * 1024); }
#pragma unroll
                for (int m = 0; m < 4; ++m) { u32x4 g[2];
                    *(PG8_LAS u32x4*)(st + rr * STG_ROW + ch * 16) = rb[m][0]; *(PG8_LAS u32x4*)(st + (rr + 8) * STG_ROW + ch * 16) = rb[m][1];
                    g[0] = *(const PG8_LAS u32x4*)(st + fr * STG_ROW + 16 * fq); g[1] = *(const PG8_LAS u32x4*)(st + fr * STG_ROW + 64 + 16 * fq);
                    f32x4 v[2][2];
#pragma unroll
                    for (int bj = 0; bj < 2; ++bj) { v[bj][0] = acc[ai][bj][m][0] * sc + (f32x4){__uint_as_float(g[bj][0] << 16), __uint_as_float(g[bj][0] & 0xffff0000u), __uint_as_float(g[bj][1] << 16), __uint_as_float(g[bj][1] & 0xffff0000u)};
                        v[bj][1] = acc[ai][bj][m][1] * sc + (f32x4){__uint_as_float(g[bj][2] << 16), __uint_as_float(g[bj][2] & 0xffff0000u), __uint_as_float(g[bj][3] << 16), __uint_as_float(g[bj][3] & 0xffff0000u)}; }
                    st_rows_bf16(st, fr, fq, pack8(v[0][0], v[0][1]), pack8(v[1][0], v[1][1]), O + (size_t)(row0 + ai * HALF + m * 16) * 1024 + col0, 1024); }
            }
        }
    }
};
struct EpiBf16P {
    static constexpr int NVMEM = 16;
    static constexpr bool PERM = true, AFTER_DRAIN = false;
    bf16_t* O; int ldc; PG8_LAS unsigned char* stg; float sc = 1.0f;
    __device__ __forceinline__ bool zero_after(const Unit&) const { return true; }
    __device__ __forceinline__ void operator()(f32x4 (&acc)[2][2][4][2], const Unit& u, int wr, int wc, int fr, int fq) const {
        PG8_LAS unsigned char* st = stg + (wr * 4 + wc) * STG_WAVE;
        const int row0 = u.pm * BM + wr * 64, col0 = u.pn * BM + wc * 64;
#pragma unroll
        for (int ai = 0; ai < 2; ++ai)
#pragma unroll
            for (int m = 0; m < 4; ++m)
                st_rows_bf16(st, fr, fq, pack8(acc[ai][0][m][0] * sc, acc[ai][0][m][1] * sc), pack8(acc[ai][1][m][0] * sc, acc[ai][1][m][1] * sc), O + (size_t)(row0 + ai * HALF + m * 16) * ldc + col0, (size_t)ldc);
    }
};
template <bool RSTD = false, bool F8O = false, int I8A = 0>
struct EpiSwiGLUT {
    static constexpr int NVMEM = 8;
    static constexpr bool PERM = true, AFTER_DRAIN = false;
    bf16_t* O; int ldc; const float* ssq;
    __device__ __forceinline__ bool zero_after(const Unit&) const { return true; }
    __device__ __forceinline__ void operator()(f32x4 (&acc)[2][2][4][2], const Unit& u, int wr, int wc, int fr, int fq) const {
        const int row0 = u.pm * BM + wr * 64 + fr, col0 = u.pn * HALF + wc * 32 + 8 * fq;
        float rsv[2][4];
        if (RSTD) { f32x4 p[2][4];
#pragma unroll
            for (int ai = 0; ai < 2; ++ai)
#pragma unroll
                for (int m = 0; m < 4; ++m) p[ai][m] = *(const f32x4*)(ssq + (size_t)(row0 + ai * HALF + m * 16) * 16 + 4 * fq);
#pragma unroll
            for (int ai = 0; ai < 2; ++ai)
#pragma unroll
                for (int m = 0; m < 4; ++m) { float s = (p[ai][m][0] + p[ai][m][1]) + (p[ai][m][2] + p[ai][m][3]); s += shx(s, 16, fq * 16 + fr); s += shx(s, 32, fq * 16 + fr); rsv[ai][m] = __builtin_amdgcn_rsqf(s * (1.0f / 1024.0f) + EPS); } }
#pragma unroll
        for (int ai = 0; ai < 2; ++ai)
#pragma unroll
            for (int m = 0; m < 4; ++m) { bf16_t* rowp = O + (size_t)(row0 + ai * HALF + m * 16) * ldc + col0; f32x4 r[2]; const float rs = RSTD ? rsv[ai][m] : 1.0f;
#pragma unroll
                for (int n = 0; n < 2; ++n) { constexpr float qa = I8A == 2 ? I8_X1 : I8_H, sg = I8A ? LOG2E / (qa * I8_W) : 1.0f, su = (I8A ? 0.6931471805599453f / (qa * I8_W) : 1.0f) * (F8O ? F8_ACT : 1.0f);
                    const float cg = rs * sg, cu = rs * su, og = I8A ? -I8_BIAS * cg : 0.0f, ou = I8A ? -I8_BIAS * cu : 0.0f;
                    const f32x4 g = acc[ai][0][m][n] * cg + og, up = acc[ai][1][m][n] * cu + ou;
#pragma unroll
                    for (int i = 0; i < 4; ++i) r[n][i] = g[i] * up[i] * __builtin_amdgcn_rcpf(1.0f + __builtin_amdgcn_exp2f(g[i])); }
                if (F8O) { u32x2 w; w.x = f8x4(r[0][0], r[0][1], r[0][2], r[0][3]); w.y = f8x4(r[1][0], r[1][1], r[1][2], r[1][3]); *(u32x2*)((unsigned char*)O + (size_t)(row0 + ai * HALF + m * 16) * ldc + col0) = w; }
                else *(u32x4*)rowp = pack8(r[0], r[1]); }
    }
};
typedef EpiSwiGLUT<false> EpiSwiGLU; typedef EpiSwiGLUT<false, true, 1> EpiSwiGLU8;
template <bool ST = true, bool I8 = false> struct EpiInProjT {
    static constexpr int NVMEM = (ST ? 16 : 0);
    static constexpr bool PERM = true, AFTER_DRAIN = false;
    unsigned char* arena; const float *qg, *kg; PG8_LAS unsigned char* stg;
    __device__ __forceinline__ bool zero_after(const Unit&) const { return true; }
    __device__ __forceinline__ void operator()(f32x4 (&acc)[2][2][4][2], const Unit& u, int wr, int wc, int fr, int fq) const {
        PG8_LAS unsigned char* st = stg + (wr * 4 + wc) * STG_WAVE;
        const int row0 = u.pm * BM + wr * 64, pn = u.pn;
        constexpr float ds = I8 ? 1.0f / (I8_H * I8_W) : 1.0f, dg = I8 ? LOG2E / (I8_H * I8_W) : 1.0f, bs = I8 ? -I8_BIAS * ds : 0.0f, bg = I8 ? -I8_BIAS * dg : 0.0f, b0 = I8 ? I8_BIAS : 0.0f;
        if (pn < 2 || (pn >= 6 && pn < 10)) {
            bf16_t* base = (pn < 2 ? (bf16_t*)(arena + AR_U) + 256 * pn : (pn < 8 ? (bf16_t*)(arena + AR_V) + 256 * (pn - 6) : (bf16_t*)(arena + AR_MQ) + 256 * (pn - 8))) + wc * 64;
#pragma unroll
            for (int ai = 0; ai < 2; ++ai)
#pragma unroll
                for (int m = 0; m < 4; ++m)
                    st_rows_bf16<ST>(st, fr, fq, pack8(acc[ai][0][m][0] * ds + bs, acc[ai][0][m][1] * ds + bs), pack8(acc[ai][1][m][0] * ds + bs, acc[ai][1][m][1] * ds + bs), base + (size_t)(row0 + ai * HALF + m * 16) * 512, 512);
        } else if (pn < 6) {
            const bool isq = pn < 4; const int head = 4 * (pn - (isq ? 2 : 4)) + wc; const float* gg = isq ? qg : kg; const float sc = isq ? C2F : 1.0f;
            f32x4 gv[2][2];
#pragma unroll
            for (int bj = 0; bj < 2; ++bj)
#pragma unroll
                for (int n = 0; n < 2; ++n) gv[bj][n] = *(const f32x4*)(gg + 32 * bj + 8 * fq + 4 * n) * sc;
            bf16_t* base = (bf16_t*)(arena + (isq ? AR_Q : AR_K)) + head * 64;
#pragma unroll
            for (int ai = 0; ai < 2; ++ai)
#pragma unroll
                for (int m = 0; m < 4; ++m) { float ss = 0.f;
#pragma unroll
                    for (int bj = 0; bj < 2; ++bj)
#pragma unroll
                        for (int n = 0; n < 2; ++n) { const f32x4 x = acc[ai][bj][m][n] - b0; acc[ai][bj][m][n] = x; ss += (x[0] * x[0] + x[1] * x[1]) + (x[2] * x[2] + x[3] * x[3]); }
                    ss += shx(ss, 16, fq * 16 + fr); ss += shx(ss, 32, fq * 16 + fr);
                    const float rstd = ds / sqrtf(ss * (ds * ds / 64.0f) + EPS);
                    st_rows_bf16<ST>(st, fr, fq, pack8(acc[ai][0][m][0] * rstd * gv[0][0], acc[ai][0][m][1] * rstd * gv[0][1]), pack8(acc[ai][1][m][0] * rstd * gv[1][0], acc[ai][1][m][1] * rstd * gv[1][1]),
                                 base + (size_t)(row0 + ai * HALF + m * 16) * 512, 512); }
        } else {
            bf16_t* base = (bf16_t*)(arena + AR_G) + 256 * (pn - 10) + wc * 64;
#pragma unroll
            for (int ai = 0; ai < 2; ++ai)
#pragma unroll
                for (int m = 0; m < 4; ++m) { f32x4 r[2][2];
#pragma unroll
                    for (int bj = 0; bj < 2; ++bj)
#pragma unroll
                        for (int n = 0; n < 2; ++n)
#pragma unroll
                            for (int i = 0; i < 4; ++i) r[bj][n][i] = fminf(1.0f + __builtin_amdgcn_exp2f(__builtin_fmaf(acc[ai][bj][m][n][i], dg, bg)), 1e30f);
                    st_rows_bf16<ST>(st, fr, fq, pack8(r[0][0], r[0][1]), pack8(r[1][0], r[1][1]), base + (size_t)(row0 + ai * HALF + m * 16) * 3072, 3072); }
        }
    }
};
typedef EpiInProjT<true> EpiInProj; typedef EpiInProjT<true, true> EpiInProj8;
struct EpiMerge {
    static constexpr int NVMEM = 0;
    static constexpr bool PERM = true, AFTER_DRAIN = false;
    const bf16_t* G; bf16_t* O; PG8_LAS unsigned char* stg;
    __device__ __forceinline__ bool zero_after(const Unit& u) const { return u.aux == 2; }
    __device__ __forceinline__ void operator()(f32x4 (&acc)[2][2][4][2], const Unit& u, int wr, int wc, int fr, int fq) const {
        PG8_LAS unsigned char* st = stg + (wr * 4 + wc) * STG_WAVE;
        const int row0 = u.pm * BM + wr * 64, col0 = u.pn * BM + wc * 64, seg = u.aux;
        const int lane = fq * 16 + fr, rr = lane >> 3, ch = lane & 7;
        u32x4 ra[2][2][2], rb[2][2][2];
#define MRG_LOAD(bf, q) do { _Pragma("unroll") for (int mm = 0; mm < 2; ++mm) { const bf16_t* gp = G + (size_t)(row0 + ((q) >> 1) * HALF + (((q) & 1) * 2 + mm) * 16 + rr) * 3072 + col0 + seg * 1024 + ch * 8; \
            ra[bf][mm][0] = *(const u32x4*)gp; ra[bf][mm][1] = *(const u32x4*)(gp + (size_t)8 * 3072); \
            if (seg < 2) { rb[bf][mm][0] = *(const u32x4*)(gp + 1024); rb[bf][mm][1] = *(const u32x4*)(gp + 1024 + (size_t)8 * 3072); } } } while (0)
        MRG_LOAD(0, 0);
#pragma unroll
        for (int q = 0; q < 4; ++q) { const int ai = q >> 1, bf = q & 1;
            if (q == 0) MRG_LOAD(1, 1); else if (q == 1) MRG_LOAD(0, 2); else if (q == 2) MRG_LOAD(1, 3);
#pragma unroll
            for (int mm = 0; mm < 2; ++mm) { const int m = (q & 1) * 2 + mm; const size_t row = (size_t)(row0 + ai * HALF + m * 16);
                u32x4 ga[2];
                *(PG8_LAS u32x4*)(st + rr * STG_ROW + ch * 16) = ra[bf][mm][0]; *(PG8_LAS u32x4*)(st + (rr + 8) * STG_ROW + ch * 16) = ra[bf][mm][1];
                ga[0] = *(const PG8_LAS u32x4*)(st + fr * STG_ROW + 16 * fq); ga[1] = *(const PG8_LAS u32x4*)(st + fr * STG_ROW + 64 + 16 * fq);
                float f[2][8];
#pragma unroll
                for (int bj = 0; bj < 2; ++bj)
#pragma unroll
                    for (int i = 0; i < 4; ++i) { f[bj][2 * i] = __builtin_amdgcn_rcpf(__uint_as_float(ga[bj][i] << 16)); f[bj][2 * i + 1] = __builtin_amdgcn_rcpf(__uint_as_float(ga[bj][i] & 0xffff0000u)); }
                if (seg < 2) { u32x4 gb[2];
                    *(PG8_LAS u32x4*)(st + rr * STG_ROW + ch * 16) = rb[bf][mm][0]; *(PG8_LAS u32x4*)(st + (rr + 8) * STG_ROW + ch * 16) = rb[bf][mm][1];
                    gb[0] = *(const PG8_LAS u32x4*)(st + fr * STG_ROW + 16 * fq); gb[1] = *(const PG8_LAS u32x4*)(st + fr * STG_ROW + 64 + 16 * fq);
#pragma unroll
                    for (int bj = 0; bj < 2; ++bj)
#pragma unroll
                        for (int i = 0; i < 4; ++i) { f[bj][2 * i] *= __uint_as_float(gb[bj][i] << 16); f[bj][2 * i + 1] *= __uint_as_float(gb[bj][i] & 0xffff0000u); } }
#pragma unroll
                for (int bj = 0; bj < 2; ++bj)
#pragma unroll
                    for (int i = 0; i < 4; ++i) { acc[ai][bj][m][0][i] *= f[bj][i]; acc[ai][bj][m][1][i] *= f[bj][4 + i]; }
                if (seg == 2) st_rows_bf16(st, fr, fq, pack8(acc[ai][0][m][0], acc[ai][0][m][1]), pack8(acc[ai][1][m][0], acc[ai][1][m][1]), O + row * 1024 + col0, 1024); }
        }
#undef MRG_LOAD
    }
};
struct EpiNull {
    static constexpr int NVMEM = 0;
    static constexpr bool PERM = true, AFTER_DRAIN = false;
    __device__ __forceinline__ bool zero_after(const Unit&) const { return true; }
    __device__ __forceinline__ void operator()(f32x4 (&acc)[2][2][4][2], const Unit& u, int wr, int wc, int fr, int fq) const {
#pragma unroll
        for (int ai = 0; ai < 2; ++ai)
#pragma unroll
            for (int m = 0; m < 4; ++m)
#pragma unroll
                for (int bj = 0; bj < 2; ++bj) { asm volatile("" :: "v"(acc[ai][bj][m][0]), "v"(acc[ai][bj][m][1])); }
    }
};
template <size_t O0, size_t O1, size_t O2>
struct MergeOrder {
    StaticOrder so; const char* arena; const char* Bbase;
    __device__ __forceinline__ bool next(int i, Unit& u) const { const int ti = i / 3; if (!so.next(ti, u)) return false; u.aux = i - 3 * ti; return true; }
    __device__ __forceinline__ void ptrs(const Gemm& g, const Unit& u, const char*& a, const char*& b) const {
        const size_t oa = u.aux == 0 ? O0 : (u.aux == 1 ? O1 : O2);
        a = arena + oa + (size_t)u.pm * (size_t)(BM * 2) * g.K; b = Bbase + (size_t)u.aux * (size_t)(1024 * 512 * 2) + (size_t)u.pn * (size_t)(BM * 2) * g.K; }
    __device__ __forceinline__ void a_ready(const Unit&) const {}
    __device__ __forceinline__ void done(const Unit&) const {}
};
struct GroupedOrder {
    StaticOrder so; const volatile PG8_LAS int* tile_e; size_t bstride;
    __device__ __forceinline__ bool next(int i, Unit& u) const { if (!so.next(i, u)) return false; u.aux = __builtin_amdgcn_readfirstlane(tile_e[u.pm]); return true; }
    __device__ __forceinline__ void ptrs(const Gemm& g, const Unit& u, const char*& a, const char*& b) const {
        a = (const char*)g.A + (size_t)u.pm * (size_t)(BM * 2) * g.K; b = (const char*)g.Bt + (size_t)u.aux * bstride + (size_t)u.pn * (size_t)(BM * 2) * g.K; }
    __device__ __forceinline__ void a_ready(const Unit&) const {}
    __device__ __forceinline__ void done(const Unit&) const {}
};
constexpr int TAIL_KS = 7, TAIL_NTK = 4, TAIL_T0 = 256, TAIL_ROWS = 8 * 256;
struct TailOrder {
    int nunits, G, c; const volatile PG8_LAS int* tile_e; size_t bstride;
    __device__ __forceinline__ bool next(int i, Unit& u) const { const int L = i * G + c; if (L >= nunits) return false;
        const int sl = L % TAIL_KS, r = L / TAIL_KS, p = r >> 2; u.pm = sl * 8 + p; u.pn = r & 3; u.aux = __builtin_amdgcn_readfirstlane(tile_e[TAIL_T0 + p]) | (p << 8) | (sl << 16); return true; }
    __device__ __forceinline__ void ptrs(const Gemm& g, const Unit& u, const char*& a, const char*& b) const { const int e = u.aux & 255, p = (u.aux >> 8) & 255, sl = u.aux >> 16;
        a = (const char*)g.A + (size_t)(TAIL_T0 + p) * (size_t)(BM * 2) * g.K + (size_t)sl * (TAIL_NTK * BK * 2); b = (const char*)g.Bt + (size_t)e * bstride + (size_t)u.pn * (size_t)(BM * 2) * g.K + (size_t)sl * (TAIL_NTK * BK * 2); }
    __device__ __forceinline__ void a_ready(const Unit&) const {}
    __device__ __forceinline__ void done(const Unit&) const {}
};
}

constexpr size_t W_IN = 8 * MiB, W_KV = 30 * MiB, W_BR = 34 * MiB, W_OUT = 40 * MiB, W_GU = 44 * MiB, W_DN = 55 * MiB, W_EGU = 64 * MiB, W_EDN = 176 * MiB;
constexpr size_t WS_SLOT = 4 * MiB, WS_META = 4 * MiB + 512 * 1024;
constexpr size_t WS_HS = 264 * MiB, WS_YB = WS_HS, WS_ACTE = 434 * MiB, WS_H2 = 434 * MiB, WS_XB8 = (328 + 192) * MiB;
constexpr int MAXTILES = 264;

struct ConvItem { const float* src; bf16* dst; int K; float sc; bool ok; };
__device__ __forceinline__ int map_w64(int nb) { const int pn = nb >> 3, q = nb & 7; return 256 * pn + 64 * (q & 3) + 32 * (q >> 2); }
__device__ __forceinline__ int map_in(int nb) { const int pn = nb >> 3, q = nb & 7, w = 64 * (q & 3) + 32 * (q >> 2);
    if (pn < 2) return 256 * pn + w;
    if (pn < 4) return OFF_Q + 256 * (pn - 2) + w;
    if (pn < 6) return OFF_K + 256 * (pn - 4) + w;
    if (pn < 8) return OFF_V + 256 * (pn - 6) + w;
    if (pn < 10) return OFF_MQ + 256 * (pn - 8) + w;
    return OFF_G + 256 * (pn - 10) + w; }
__device__ __forceinline__ int map_gu(int nb, int FF) { const int pn = nb >> 3, q = nb & 7; return q < 4 ? 128 * pn + 32 * q : FF + 128 * pn + 32 * (q - 4); }
constexpr int CI_L = 2816 + 512 + 256 + 256 + 512, CI_GU = 2 * CI_L, CI_DN = CI_GU + 2816, CI_E = CI_DN + 1408, CI_PER_E = 3584 + 1792, CI_TOTAL = CI_E + NE * CI_PER_E;
__device__ __forceinline__ void conv_item(Frame& F, int g, const float*& src, int& ldw, unsigned char*& dst, int& K, float& sc, const float*& ksc, int& qk) {
    ksc = nullptr; qk = 0;
    unsigned char* ws = F.ws; int r, nblk, mt = 0, FF = 0; const float* W; bf16* WT;
    if (g < CI_GU) { const int l = g >= CI_L ? 1 : 0; r = g - l * CI_L;
        if (r < 2816) { W = inptr(F, I_WIN) + (size_t)l * D * NIN; ldw = NIN; K = D; nblk = 176; mt = 1; WT = (bf16*)(ws + W_IN + (size_t)l * 5632 * 1024); qk = 2; }
        else if (r < 3328) { r -= 2816; W = inptr(F, I_WKV) + (size_t)l * D * 1024; ldw = 1024; K = D; nblk = 32; WT = (bf16*)(ws + W_KV) + (size_t)l * 1024 * 1024; }
        else if (r < 3584) { r -= 3328; W = inptr(F, I_WFBR) + (size_t)l * 512 * D; ldw = D; K = 512; nblk = 32; WT = (bf16*)(ws + W_BR) + (size_t)(l * 3 + 1) * 1024 * 512; }
        else if (r < 3840) { r -= 3584; W = inptr(F, I_WMBR) + (size_t)l * 512 * D; ldw = D; K = 512; nblk = 32; WT = (bf16*)(ws + W_BR) + (size_t)(l * 3 + 2) * 1024 * 512; }
        else { r -= 3840; W = inptr(F, I_WOUT) + (size_t)l * D * D; ldw = D; K = D; nblk = 32; WT = (bf16*)(ws + W_OUT) + (size_t)l * 1024 * 1024; } }
    else if (g < CI_DN) { r = g - CI_GU; W = inptr(F, I_WGU); ldw = 2 * DFF; K = D; nblk = 176; mt = 2; FF = DFF; WT = (bf16*)(ws + W_GU); ksc = inptr(F, I_FFNG); qk = 2; }
    else if (g < CI_E) { r = g - CI_DN; W = inptr(F, I_WDN); ldw = D; K = DFF; nblk = 32; WT = (bf16*)(ws + W_DN); qk = 1; }
    else { r = g - CI_E; const int e = r / CI_PER_E; r -= e * CI_PER_E;
        if (r < 3584) { W = inptr(F, I_WEGU) + (size_t)e * D * 2 * DEXP; ldw = 2 * DEXP; K = D; nblk = 224; mt = 2; FF = DEXP; WT = (bf16*)(ws + W_EGU + (size_t)e * 7168 * 1024); qk = 2; }
        else { qk = 1; r -= 3584; W = inptr(F, I_WEDN) + (size_t)e * DEXP * D; ldw = D; K = DEXP; nblk = 32; WT = (bf16*)(ws + W_EDN + (size_t)e * 1024 * DEXP); } }
    const int rp = r >> 1, kbp = rp / nblk, nb = rp - kbp * nblk, kb = 2 * kbp + (r & 1);
    const int n0 = mt == 0 ? map_w64(nb) : (mt == 1 ? map_in(nb) : map_gu(nb, FF));
    sc = mt == 1 ? ((nb >> 3) >= 10 ? -LOG2E : 1.0f) : (mt == 2 ? ((nb & 7) < 4 ? -LOG2E : -0.6931471805599453f) : 1.0f);
    if (qk == 2) sc = (sc < 0.f ? -I8_W : I8_W); else if (qk == 1) sc *= F8_WDN;
    const int es = qk ? 1 : 2;
    src = W + (size_t)(64 * kb) * ldw + n0; dst = (unsigned char*)WT + ((size_t)(32 * nb) * K + 64 * kb) * es; if (ksc) ksc += 64 * kb;
}
__device__ __forceinline__ void conv_phase(Frame& F) {
    LAS float* scr = (LAS float*)(F.lds + RING_OFF + F.wave * 16384);
    const int lane = F.lane, gw = F.vcu * NWAVES + F.wave, NGW = F.G * NWAVES;
    const int lr = lane >> 3, lc = (lane & 7) * 4;
    f32x4 v[8]; const float* src; unsigned char* dst; int ldw, K, qk; float sc; const float* ksc;
    int g = 2 * gw;
    if (g < CI_TOTAL) { conv_item(F, g, src, ldw, dst, K, sc, ksc, qk);
#pragma unroll
        for (int i = 0; i < 8; ++i) { v[i] = *(const f32x4*)(src + (size_t)(8 * i + lr) * ldw + lc); if (ksc) v[i] *= ksc[8 * i + lr]; } }
    while (g < CI_TOTAL) {
#pragma unroll
        for (int i = 0; i < 8; ++i) *(LAS f32x4*)(scr + (8 * i + lr) * 36 + ((lc + 4 * i) & 31)) = v[i] * sc;
        unsigned char* const cdst = dst; const int cK = K, cqk = qk;
        g = (g & 1) ? g + 2 * NGW - 1 : g + 1;
        if (g < CI_TOTAL) { conv_item(F, g, src, ldw, dst, K, sc, ksc, qk);
#pragma unroll
            for (int i = 0; i < 8; ++i) { v[i] = *(const f32x4*)(src + (size_t)(8 * i + lr) * ldw + lc); if (ksc) v[i] *= ksc[8 * i + lr]; } }
        asm volatile("s_waitcnt lgkmcnt(0)" ::: "memory");
        const int c = lane & 7;
#pragma unroll
        for (int j = 0; j < 4; ++j) { const int n = (lane >> 3) + 8 * j; const LAS float* s = scr + (8 * c) * 36 + ((n + 4 * c) & 31);
            if (cqk == 0) { v4u o; o.x = pk2(s[0 * 36], s[1 * 36]); o.y = pk2(s[2 * 36], s[3 * 36]); o.z = pk2(s[4 * 36], s[5 * 36]); o.w = pk2(s[6 * 36], s[7 * 36]);
                *(v4u*)(cdst + ((size_t)n * cK + 8 * c) * 2) = o; }
            else if (cqk == 1) { v2u o; o.x = f8x4(s[0 * 36], s[1 * 36], s[2 * 36], s[3 * 36]); o.y = f8x4(s[4 * 36], s[5 * 36], s[6 * 36], s[7 * 36]); *(v2u*)(cdst + (size_t)n * cK + 8 * c) = o; }
            else { v2u o; o.x = i8x4(s[0 * 36], s[1 * 36], s[2 * 36], s[3 * 36]); o.y = i8x4(s[4 * 36], s[5 * 36], s[6 * 36], s[7 * 36]); *(v2u*)(cdst + (size_t)n * cK + 8 * c) = o; } }
        asm volatile("s_waitcnt lgkmcnt(0)" ::: "memory");
    }
    for (int it = gw; it < 1024; it += NGW) { const int l = it >> 9, gg = (it >> 7) & 3, nb = (it >> 3) & 15, cb = it & 7;
        const float* pw = inptr(F, I_POOLW) + (size_t)l * 4 * 128 * 128 + (size_t)(gg * 128 + cb * 16) * 128; const float* ps = inptr(F, I_POOLS) + l * 512 + gg * 128;
        const float* wb = inptr(F, I_WPBR) + (size_t)l * 512 * D + (size_t)(gg * 128) * D + 64 * nb + lane;
        asm volatile("s_waitcnt lgkmcnt(0)" ::: "memory");
#pragma unroll
        for (int i = 0; i < 8; ++i) { const int e0 = 4 * (lane + 64 * i), c = e0 >> 7, d0 = e0 & 127; const f32x4 pv = *(const f32x4*)(pw + e0) * *(const f32x4*)(ps + d0);
#pragma unroll
            for (int j = 0; j < 4; ++j) scr[(d0 + j) * 16 + c] = pv[j]; }
        asm volatile("s_waitcnt lgkmcnt(0)" ::: "memory");
        float acc[16];
#pragma unroll
        for (int c = 0; c < 16; ++c) acc[c] = 0.f;
#pragma unroll 1
        for (int d0 = 0; d0 < 128; d0 += 8) { float w[8];
#pragma unroll
            for (int j = 0; j < 8; ++j) w[j] = wb[(size_t)(d0 + j) * D];
#pragma unroll
            for (int j = 0; j < 8; ++j) {
#pragma unroll
                for (int q = 0; q < 4; ++q) { const f32x4 p = *(const LAS f32x4*)(scr + (d0 + j) * 16 + 4 * q);
#pragma unroll
                    for (int i = 0; i < 4; ++i) acc[4 * q + i] = fmaf(p[i], w[j], acc[4 * q + i]); } } }
        const int n = 64 * nb + lane, c = n & 255;
        bf16* wp = (bf16*)(F.ws + W_BR) + (size_t)(l * 3) * 1024 * 512 + (size_t)((n & ~255) + 128 * ((c >> 5) & 1) + 32 * (c >> 6) + (c & 31)) * 512 + gg * 128 + cb * 16;
        v4u o0, o1; o0.x = pk2(acc[0], acc[1]); o0.y = pk2(acc[2], acc[3]); o0.z = pk2(acc[4], acc[5]); o0.w = pk2(acc[6], acc[7]); o1.x = pk2(acc[8], acc[9]); o1.y = pk2(acc[10], acc[11]); o1.z = pk2(acc[12], acc[13]); o1.w = pk2(acc[14], acc[15]);
        *(v4u*)wp = o0; *(v4u*)(wp + 8) = o1; }
}

__device__ __forceinline__ void moe_scatter_phase(Frame& F, const unsigned char* H2) {
    const int* WC = (const int*)(F.ws + WS_WCNT); LAS int* sh = (LAS int*)(F.lds + RING_OFF);
    const int tid = F.tid, lane = F.lane, wave = F.wave;
    int before[8], total[8];
    { int s[8];
#pragma unroll
      for (int e = 0; e < 8; ++e) s[e] = 0;
      for (int w = 0; w < 4; ++w) { const int gwv = 4 * tid + w;
#pragma unroll
          for (int e = 0; e < 8; ++e) s[e] += WC[gwv * 8 + e]; }
      const bool isb = tid < 2 * F.vcu;
#pragma unroll
      for (int e = 0; e < 8; ++e) { int t = s[e], b = isb ? s[e] : 0;
#pragma unroll
          for (int o = 1; o < 64; o <<= 1) { t += shxi(t, o, lane); b += shxi(b, o, lane); }
          if (lane == 0) { sh[wave * 16 + e] = b; sh[wave * 16 + 8 + e] = t; } }
      __syncthreads();
#pragma unroll
      for (int e = 0; e < 8; ++e) { int b = 0, t = 0;
#pragma unroll
          for (int w = 0; w < 8; ++w) { b += sh[w * 16 + e]; t += sh[w * 16 + 8 + e]; }
          before[e] = b; total[e] = t; } }
    int seg[8]; int ntile = 0;
#pragma unroll
    for (int e = 0; e < 8; ++e) { seg[e] = ntile * 256; ntile += (total[e] + 255) >> 8; }
    if (F.vcu == 0) { int* meta = (int*)(F.ws + WS_META); if (tid == 0) meta[0] = ntile;
        int te = 0;
#pragma unroll
        for (int e = 1; e < 8; ++e) te += (tid * 256 >= seg[e]) ? 1 : 0;
        if (tid < MAXTILES) meta[16 + tid] = te; }
    int base[8];
#pragma unroll
    for (int e = 0; e < 8; ++e) { int b = before[e]; for (int w = 0; w < wave; ++w) b += WC[(F.vcu * NWAVES + w) * 8 + e]; base[e] = seg[e] + b; }
    const int gw = F.vcu * NWAVES + wave, NGW = F.G * NWAVES;
    const int m = gw + (lane & 15) * NGW; const bool act = lane < 16 && m < T;
    Choice c; c.e1 = -1; c.e2 = -1; c.w1 = 0.f; c.w2 = 0.f;
    if (act) c = ((const Choice*)(F.ws + WS_CHOICE))[m];
    int s1 = 0, s2 = 0;
    const unsigned long long lt = (1ull << lane) - 1ull;
#pragma unroll
    for (int e = 0; e < 8; ++e) { const unsigned long long m1 = __ballot(act && c.e1 == e), m2 = __ballot(act && c.e2 == e);
        if (c.e1 == e) s1 = base[e] + __popcll(m1 & lt);
        if (c.e2 == e) s2 = base[e] + __popcll(m1) + __popcll(m2 & lt); }
    if (act) { int* sl = (int*)(F.ws + WS_SLOT) + 2 * m; sl[0] = s1; sl[1] = s2; }
    unsigned char* HS = F.ws + WS_HS;
    v4u xs[16];
#pragma unroll
    for (int i = 0; i < 16; ++i) { const int mi = gw + i * NGW; xs[i] = (v4u){0u, 0u, 0u, 0u}; if (mi < T) xs[i] = *(const v4u*)(H2 + (size_t)mi * D + 16 * lane); }
#pragma unroll
    for (int i = 0; i < 16; ++i) { const int mi = gw + i * NGW; const int d1 = shli(s1, i), d2 = shli(s2, i);
        if (mi < T) { *(v4u*)(HS + (size_t)d1 * D + 16 * lane) = xs[i]; *(v4u*)(HS + (size_t)d2 * D + 16 * lane) = xs[i]; } }
    __syncthreads();
}
constexpr size_t WS_PART = W_EGU;
__device__ __forceinline__ void yrow(const bf16* YB, const float* PART, int s, int col, f32x4 (&y)[2]) {
    if (s < pg8::TAIL_T0 * 256) { const v4u a = *(const v4u*)(YB + (size_t)s * D + col);
        y[0] = (f32x4){bf2f(a[0] & 0xffffu), bf2f(a[0] >> 16), bf2f(a[1] & 0xffffu), bf2f(a[1] >> 16)}; y[1] = (f32x4){bf2f(a[2] & 0xffffu), bf2f(a[2] >> 16), bf2f(a[3] & 0xffffu), bf2f(a[3] >> 16)}; }
    else { const float* p = PART + (size_t)(s - pg8::TAIL_T0 * 256) * D + col; y[0] = *(const f32x4*)p; y[1] = *(const f32x4*)(p + 4);
#pragma unroll
        for (int sl = 1; sl < pg8::TAIL_KS; ++sl) { y[0] += *(const f32x4*)(p + (size_t)sl * pg8::TAIL_ROWS * D); y[1] += *(const f32x4*)(p + (size_t)sl * pg8::TAIL_ROWS * D + 4); } }
}
__device__ __forceinline__ void moe_combine_phase(Frame& F) {
    const bf16* YB = (const bf16*)(F.ws + WS_YB); const int lane = F.lane;
    for (int m = F.vcu * NWAVES + F.wave; m < T; m += F.G * NWAVES) {
        const Choice c = ((const Choice*)(F.ws + WS_CHOICE))[m]; const int* sl = (const int*)(F.ws + WS_SLOT) + 2 * m; const int s1 = sl[0], s2 = sl[1];
#pragma unroll
        for (int h = 0; h < 2; ++h) { const v4u a = *(const v4u*)(YB + (size_t)s1 * D + 512 * h + 8 * lane), b = *(const v4u*)(YB + (size_t)s2 * D + 512 * h + 8 * lane);
            float* xp = F.X + (size_t)m * D + 512 * h + 8 * lane; f32x4 x0 = *(const f32x4*)xp, x1 = *(const f32x4*)(xp + 4);
#pragma unroll
            for (int i = 0; i < 2; ++i) { x0[2 * i] += c.w1 * bf2f(a[i] & 0xffffu) + c.w2 * bf2f(b[i] & 0xffffu); x0[2 * i + 1] += c.w1 * bf2f(a[i] >> 16) + c.w2 * bf2f(b[i] >> 16);
                x1[2 * i] += c.w1 * bf2f(a[2 + i] & 0xffffu) + c.w2 * bf2f(b[2 + i] & 0xffffu); x1[2 * i + 1] += c.w1 * bf2f(a[2 + i] >> 16) + c.w2 * bf2f(b[2 + i] >> 16); }
            *(f32x4*)xp = x0; *(f32x4*)(xp + 4) = x1; }
    }
}

namespace attn_body {
using bf16=__hip_bfloat16;
using bf16x8=__attribute__((ext_vector_type(8)))short;
using s16x4=__attribute__((ext_vector_type(4)))short;
using f32x16=__attribute__((ext_vector_type(16)))float;
using u32x4=__attribute__((ext_vector_type(4)))unsigned;
constexpr int BATCH=8,NHEAD=8,SEQ=4096,D=64,DM=NHEAD*D;
constexpr int NW=8,QBLK=32,QB=QBLK*NW,KVBLK=64,NQB=SEQ/QB;
constexpr int ATTN_PITCH=DM, ATTN_UNIT_ROWS=QB;
__device__ __forceinline__ int crow(int r,int hi){return (r&3)+8*(r>>2)+4*hi;}
#define SBAR() __builtin_amdgcn_sched_barrier(0)
__device__ __forceinline__ void cmask(f32x16&p0,f32x16&p1,int jb,int qrel,int hi){
  const float NEG=-INFINITY; int kb=64*jb+4*hi;
  #pragma unroll
  for(int r=0;r<16;++r){int kv=kb+(r&3)+8*(r>>2); if(kv>qrel)p0[r]=NEG; if(kv+32>qrel)p1[r]=NEG;}
}

constexpr int NSLOT=3, SLOTB=8192;
constexpr int LDS_K=0, LDS_V=NSLOT*SLOTB, LDS_WS=2*NSLOT*SLOTB, LDS_OST=LDS_WS+NW*64*4, LDS_BYTES=LDS_OST+NW*4096, LDS_CL=LDS_BYTES, LDS_BYTES_ALL=LDS_CL+SEQ*4;
constexpr float C2=0.125f*1.4426950408889634f;
__device__ __forceinline__ void glds16(const void*gsrc,unsigned lds_dst){unsigned keep;
  asm volatile("s_mov_b32 %0, m0\n\ts_mov_b32 m0, %2\n\ts_nop 0\n\tglobal_load_lds_dwordx4 %1, off\n\ts_mov_b32 m0, %0":"=&s"(keep):"v"(gsrc),"s"(lds_dst):"memory");}
__device__ __forceinline__ float max3f(float a,float b,float c){float r;asm("v_max3_f32 %0, %1, %2, %3":"=v"(r):"v"(a),"v"(b),"v"(c));return r;}
__device__ __forceinline__ float max2f(float a,float b){float r;asm("v_max_f32_e32 %0, %1, %2":"=v"(r):"v"(a),"v"(b));return r;}
__device__ __forceinline__ float fadd_s(float a,float b){float r;asm("v_add_f32_e32 %0, %1, %2":"=v"(r):"v"(a),"v"(b));return r;}
__device__ __forceinline__ float fsub_s(float a,float b){float r;asm("v_sub_f32_e32 %0, %1, %2":"=v"(r):"v"(a),"v"(b));return r;}
typedef float f32x2_t __attribute__((ext_vector_type(2))); typedef __bf16 bf16x2_t __attribute__((ext_vector_type(2)));
__device__ __forceinline__ unsigned cvtpk_s(float lo,float hi){f32x2_t v={lo,hi};bf16x2_t b=__builtin_convertvector(v,bf16x2_t);return __builtin_bit_cast(unsigned,b);}
#define WAIT_BAR(N) asm volatile("s_waitcnt vmcnt(" #N ") lgkmcnt(0)\n\ts_barrier":::"memory")

__device__ __forceinline__ void qkt(f32x16&p0,f32x16&p1,const char*Kslot,const bf16x8*qr,const f32x16&ci0,const f32x16&ci1,int r32,int hi){
  const char*kb=Kslot+hi*1024+r32*16;
  #pragma unroll
  for(int d0=0;d0<4;++d0){
    const bf16x8 b0=*reinterpret_cast<const bf16x8*>(kb+d0*2048);
    const bf16x8 b1=*reinterpret_cast<const bf16x8*>(kb+d0*2048+512);
    if(d0==0){p0=__builtin_amdgcn_mfma_f32_32x32x16_bf16(b0,qr[0],ci0,0,0,0);p1=__builtin_amdgcn_mfma_f32_32x32x16_bf16(b1,qr[0],ci1,0,0,0);}
    else{p0=__builtin_amdgcn_mfma_f32_32x32x16_bf16(b0,qr[d0],p0,0,0,0);p1=__builtin_amdgcn_mfma_f32_32x32x16_bf16(b1,qr[d0],p1,0,0,0);}}
}
typedef __attribute__((address_space(3))) const char* lds_cptr;
typedef short v4i16_t __attribute__((ext_vector_type(4)));
__device__ __forceinline__ void kload8(bf16x8*kf,lds_cptr kp){
  kf[0]=*(const __attribute__((address_space(3))) bf16x8*)(kp);      kf[1]=*(const __attribute__((address_space(3))) bf16x8*)(kp+512);
  kf[2]=*(const __attribute__((address_space(3))) bf16x8*)(kp+2048); kf[3]=*(const __attribute__((address_space(3))) bf16x8*)(kp+2560);
  kf[4]=*(const __attribute__((address_space(3))) bf16x8*)(kp+4096); kf[5]=*(const __attribute__((address_space(3))) bf16x8*)(kp+4608);
  kf[6]=*(const __attribute__((address_space(3))) bf16x8*)(kp+6144); kf[7]=*(const __attribute__((address_space(3))) bf16x8*)(kp+6656);
}
__device__ __forceinline__ void kload2(bf16x8*kf,lds_cptr kp,int j){ kf[2*j]=*(const __attribute__((address_space(3))) bf16x8*)(kp+j*2048); kf[2*j+1]=*(const __attribute__((address_space(3))) bf16x8*)(kp+j*2048+512); }
__device__ __forceinline__ s16x4 vtr(lds_cptr p){ return __builtin_bit_cast(s16x4,__builtin_amdgcn_ds_read_tr16_b64_v4i16((__attribute__((address_space(3))) v4i16_t*)p)); }
__device__ __forceinline__ float rowmax(const f32x16&p0,const f32x16&p1){
  float a=max3f(p0[0],p0[1],p1[0]),b=max3f(p0[2],p0[3],p1[1]);a=max3f(a,p1[2],p1[3]);
  #pragma unroll
  for(int r=4;r<16;r+=4){a=max3f(a,p0[r],p0[r+1]);b=max3f(b,p0[r+2],p0[r+3]);a=max3f(a,p1[r],p1[r+1]);b=max3f(b,p1[r+2],p1[r+3]);}
  const float m=max2f(a,b);
  auto rr=__builtin_amdgcn_permlane32_swap(__float_as_uint(m),__float_as_uint(m),false,false);
  return max2f(__uint_as_float(rr[0]),__uint_as_float(rr[1]));
}
__device__ __forceinline__ void pv(f32x16*o,int vb,bf16x8 pa0,bf16x8 pa1,bf16x8 pa2,bf16x8 pa3){
  #pragma unroll
  for(int d0=0;d0<2;++d0){s16x4 lo[4],hi[4];
    #pragma unroll
    for(int ks=0;ks<4;++ks){
      asm volatile("ds_read_b64_tr_b16 %0,%1 offset:%c2":"=&v"(lo[ks]):"v"(vb),"i"(d0*4096+ks*1024):"memory");
      asm volatile("ds_read_b64_tr_b16 %0,%1 offset:%c2":"=&v"(hi[ks]):"v"(vb),"i"(d0*4096+ks*1024+512):"memory");}
    asm volatile("s_waitcnt lgkmcnt(0)":::"memory");SBAR();
    #define PK(k) (bf16x8){lo[k][0],lo[k][1],lo[k][2],lo[k][3],hi[k][0],hi[k][1],hi[k][2],hi[k][3]}
    o[d0]=__builtin_amdgcn_mfma_f32_32x32x16_bf16(pa0,PK(0),o[d0],0,0,0);
    o[d0]=__builtin_amdgcn_mfma_f32_32x32x16_bf16(pa1,PK(1),o[d0],0,0,0);
    o[d0]=__builtin_amdgcn_mfma_f32_32x32x16_bf16(pa2,PK(2),o[d0],0,0,0);
    o[d0]=__builtin_amdgcn_mfma_f32_32x32x16_bf16(pa3,PK(3),o[d0],0,0,0);
    #undef PK
  }
}

#ifndef ATTN_STORE16
#define ATTN_STORE16(p,v) (*(u32x4*)(p)=(v))
#endif
__device__ __forceinline__ void attn_unit(int b,int h,int qb,const bf16*Q,const bf16*K,const bf16*V,bf16*O,const float*CLh,const int T0,char*shm,const int tid){
  const int lane=tid&63,r32=lane&31,hi=lane>>5; const int wid=__builtin_amdgcn_readfirstlane(tid>>6);
  const long rowbase=(long)b*SEQ; const int q0=qb*QB;
  const bf16*Qw=Q+(rowbase+q0+wid*QBLK)*DM+h*D;
  const bf16*Kh=K+(rowbase+(long)T0*KVBLK)*DM+h*D,*Vh=V+(rowbase+(long)T0*KVBLK)*DM+h*D;
  const unsigned lds0=(unsigned)(uintptr_t)shm;
  float*wsf=(float*)(shm+LDS_WS)+wid*64;
  const bf16*ksrc=Kh+(long)lane*DM+wid*8;
  const bf16*vsrc=Vh+(long)(16*(wid&3)+(lane>>2))*DM+(wid>>2)*32+(lane&3)*8;
  const unsigned kdst=lds0+LDS_K+wid*1024, vdst=lds0+LDS_V+wid*1024;
  #define DMA_K(t,slot) glds16(ksrc+(long)(t)*KVBLK*DM,(unsigned)__builtin_amdgcn_readfirstlane(kdst+(slot)))
  #define DMA_V(t,slot) glds16(vsrc+(long)(t)*KVBLK*DM,(unsigned)__builtin_amdgcn_readfirstlane(vdst+(slot)))
  const int vb0=(int)(lds0+LDS_V)+((lane>>4)&1)*32+(lane&3)*8+(4*hi+((lane&15)>>2))*64;
  const char*Kbase=shm+LDS_K; bf16x8 kf[8];
  const lds_cptr shm3=(lds_cptr)shm; const lds_cptr kp0=shm3+LDS_K+hi*1024+r32*16; const lds_cptr vp0=shm3+LDS_V+((lane>>4)&1)*32+(lane&3)*8+(4*hi+((lane&15)>>2))*64;
  const int NT=(q0+QB)/KVBLK-T0;
  typedef __attribute__((address_space(3))) const float* lds_fptr; const lds_fptr clt=(lds_fptr)(shm3+LDS_CL)+T0*KVBLK;
  { const int np=qb+1; if(wid<np)glds16(CLh+256*wid+4*lane,(unsigned)__builtin_amdgcn_readfirstlane(lds0+LDS_CL+1024*wid)); if(wid+8<np)glds16(CLh+256*(wid+8)+4*lane,(unsigned)__builtin_amdgcn_readfirstlane(lds0+LDS_CL+1024*(wid+8))); }
  DMA_K(0,0);DMA_V(0,0);DMA_K(1,SLOTB);
  bf16x8 qr[4];
  #pragma unroll
  for(int d0=0;d0<4;++d0)qr[d0]=*reinterpret_cast<const bf16x8*>(&Qw[(long)r32*DM+d0*16+hi*8]);
  float l_reg=0.f;f32x16 o[2];o[0]=f32x16{};o[1]=f32x16{};
  const float clq=CLh[q0+wid*QBLK+r32]; const float bq=hi?clq:1.0f;
  #define CINIT(c0,c1,t) do{ const float k0_=clt[(t)*KVBLK+r32],k1_=clt[(t)*KVBLK+32+r32]; c0=__builtin_amdgcn_mfma_f32_32x32x2f32(hi?1.0f:-k0_,bq,f32x16{},0,0,0); c1=__builtin_amdgcn_mfma_f32_32x32x2f32(hi?1.0f:-k1_,bq,f32x16{},0,0,0); }while(0)
  const int qrel=wid*QBLK+r32;
  #define CMASK(P0,P1,t) do{int jb_=(t)-(NT-4); if(jb_>=0)cmask(P0,P1,jb_,qrel,hi);}while(0)
  f32x16 pA0,pA1,pB0,pB1;
  int sl_prev=0,sl_cur=0,sl_next=SLOTB;
  #define ROT() do{sl_prev=sl_cur;sl_cur=sl_next;sl_next=(sl_next==(NSLOT-1)*SLOTB)?0:sl_next+SLOTB;}while(0)
  DMA_K(2,2*SLOTB);
  WAIT_BAR(3);
  { f32x16 ci0,ci1; CINIT(ci0,ci1,0); qkt(pA0,pA1,Kbase,qr,ci0,ci1,r32,hi); } asm volatile("s_nop 15\n\ts_nop 7":"+v"(pA0),"+v"(pA1));CMASK(pA0,pA1,0);
  _Pragma("unroll") for(int r=0;r<16;++r)pA0[r]=__builtin_amdgcn_exp2f(pA0[r]);
  _Pragma("unroll") for(int r=0;r<16;++r)pA1[r]=__builtin_amdgcn_exp2f(pA1[r]);
  WAIT_BAR(0);
  DMA_K(3,0);DMA_V(1,SLOTB);
  ROT();
  kload8(kf,kp0+sl_cur);
  WAIT_BAR(2);
  s16x4 vlo[8],vhi[8]; u32x4 pw0,pw1,pw2,pw3;
  #define PKW(P,B) cvtpk_s(P[B],P[B+1])
  #define PAF(k) __builtin_bit_cast(bf16x8,pw##k)
  #define VFR(i) (bf16x8){vlo[i][0],vlo[i][1],vlo[i][2],vlo[i][3],vhi[i][0],vhi[i][1],vhi[i][2],vhi[i][3]}
  #define PIN(x) asm volatile("":"+v"(x))
  #define MX3(a,b,c) __builtin_fmaxf(__builtin_fmaxf((a),(b)),(c))
  #define GAPA(MF,A0,A1,A2,A3,W0,W1,PW) do{ MF; sacc+=A0; sacc+=A1; sacc+=A2; sacc+=A3; PIN(sacc); W0; W1; PIN(PW); SBAR(); }while(0)
  #define EX(v) __builtin_amdgcn_exp2f(v)
  #define GAPB(MF,X,B) do{ MF; X[B]=EX(X[B]); X[B+1]=EX(X[B+1]); X[B+2]=EX(X[B+2]); X[B+3]=EX(X[B+3]); PIN(X); SBAR(); }while(0)
  #define VRD(i) do{ vlo[i]=vtr(vp_+(((i)>>2)*4096+((i)&3)*1024)); vhi[i]=vtr(vp_+(((i)>>2)*4096+((i)&3)*1024+512)); }while(0)
  #define KRD(G,j) do{ if(G){ kload2(kf,kp0+sl_next,j); SBAR(); } }while(0)
  #define STEP(C0,C1,P0,P1,t,GK,GV,GL) do{ SBAR(); \
    const lds_cptr vp_=vp0+sl_prev; \
    CINIT(C0,C1,t); SBAR(); \
    VRD(0); SBAR(); float sacc=(P0[0]+P0[1]); \
    GAPA(C0=__builtin_amdgcn_mfma_f32_32x32x16_bf16(kf[0],qr[0],C0,0,0,0), P0[2],P0[3],P0[4],P0[5],     pw0[0]=PKW(P0,0), pw0[1]=PKW(P0,2), pw0); \
    VRD(4); SBAR(); GAPA(C1=__builtin_amdgcn_mfma_f32_32x32x16_bf16(kf[1],qr[0],C1,0,0,0), P0[6],P0[7],P0[8],P0[9],     pw0[2]=PKW(P0,4), pw0[3]=PKW(P0,6), pw0); \
    VRD(1); SBAR(); GAPA(C0=__builtin_amdgcn_mfma_f32_32x32x16_bf16(kf[2],qr[1],C0,0,0,0),   P0[10],P0[11],P0[12],P0[13], pw1[0]=PKW(P0,8), pw1[1]=PKW(P0,10), pw1); \
    VRD(5); SBAR(); GAPA(C1=__builtin_amdgcn_mfma_f32_32x32x16_bf16(kf[3],qr[1],C1,0,0,0),   P0[14],P0[15],P1[0],P1[1],   pw1[2]=PKW(P0,12),pw1[3]=PKW(P0,14), pw1); \
    VRD(2); SBAR(); GAPA(C0=__builtin_amdgcn_mfma_f32_32x32x16_bf16(kf[4],qr[2],C0,0,0,0),   P1[2],P1[3],P1[4],P1[5],     pw2[0]=PKW(P1,0), pw2[1]=PKW(P1,2), pw2); \
    VRD(6); SBAR(); GAPA(C1=__builtin_amdgcn_mfma_f32_32x32x16_bf16(kf[5],qr[2],C1,0,0,0),   P1[6],P1[7],P1[8],P1[9],     pw2[2]=PKW(P1,4), pw2[3]=PKW(P1,6), pw2); \
    VRD(3); SBAR(); GAPA(C0=__builtin_amdgcn_mfma_f32_32x32x16_bf16(kf[6],qr[3],C0,0,0,0),   P1[10],P1[11],P1[12],P1[13], pw3[0]=PKW(P1,8), pw3[1]=PKW(P1,10), pw3); \
    VRD(7); SBAR(); GAPA(C1=__builtin_amdgcn_mfma_f32_32x32x16_bf16(kf[7],qr[3],C1,0,0,0),   P1[14],P1[15],0.f,0.f,       pw3[2]=PKW(P1,12),pw3[3]=PKW(P1,14), pw3); \
    l_reg+=sacc; \
    if(GK){DMA_K((t)+3,sl_cur);} if(GV){DMA_V((t)+1,sl_next);} \
    CMASK(C0,C1,t); \
    SBAR(); \
    GAPB(o[0]=__builtin_amdgcn_mfma_f32_32x32x16_bf16(PAF(0),VFR(0),o[0],0,0,0), C0,0); \
    GAPB(o[1]=__builtin_amdgcn_mfma_f32_32x32x16_bf16(PAF(0),VFR(4),o[1],0,0,0), C0,4); \
    KRD(GL,0); GAPB(o[0]=__builtin_amdgcn_mfma_f32_32x32x16_bf16(PAF(1),VFR(1),o[0],0,0,0), C0,8); \
    KRD(GL,1); GAPB(o[1]=__builtin_amdgcn_mfma_f32_32x32x16_bf16(PAF(1),VFR(5),o[1],0,0,0), C0,12); \
    KRD(GL,2); GAPB(o[0]=__builtin_amdgcn_mfma_f32_32x32x16_bf16(PAF(2),VFR(2),o[0],0,0,0), C1,0); \
    KRD(GL,3); GAPB(o[1]=__builtin_amdgcn_mfma_f32_32x32x16_bf16(PAF(2),VFR(6),o[1],0,0,0), C1,4); \
    GAPB(o[0]=__builtin_amdgcn_mfma_f32_32x32x16_bf16(PAF(3),VFR(3),o[0],0,0,0), C1,8); \
    GAPB(o[1]=__builtin_amdgcn_mfma_f32_32x32x16_bf16(PAF(3),VFR(7),o[1],0,0,0), C1,12); \
    }while(0)
  int t=1;
  #undef CMASK
  #define CMASK(P0,P1,t) do{}while(0)
  for(;t+5<NT;t+=2){
    STEP(pB0,pB1,pA0,pA1,t,true,true,true);     WAIT_BAR(2); ROT();
    STEP(pA0,pA1,pB0,pB1,t+1,true,true,true);   WAIT_BAR(2); ROT();
  }
  #undef CMASK
  #define CMASK(P0,P1,t) do{int jb_=(t)-(NT-4); if(jb_>=0)cmask(P0,P1,jb_,qrel,hi);}while(0)
  #define ENDW(tt) do{ if((tt)+3<NT){WAIT_BAR(2);} else if((tt)+2<NT){WAIT_BAR(1);} else {WAIT_BAR(0);} }while(0)
  for(;t+1<NT;t+=2){
    STEP(pB0,pB1,pA0,pA1,t,(t+3<NT),(t+1<NT),(t+1<NT));       ENDW(t);   ROT();
    STEP(pA0,pA1,pB0,pB1,t+1,(t+4<NT),(t+2<NT),(t+2<NT));     ENDW(t+1); ROT();
  }
  STEP(pB0,pB1,pA0,pA1,NT-1,false,false,false);
  { float sacc=pB0[0]+pB0[1]; _Pragma("unroll") for(int r=2;r<16;++r)sacc+=pB0[r]; _Pragma("unroll") for(int r=0;r<16;++r)sacc+=pB1[r]; l_reg+=sacc;
    pw0=(u32x4){PKW(pB0,0),PKW(pB0,2),PKW(pB0,4),PKW(pB0,6)};pw1=(u32x4){PKW(pB0,8),PKW(pB0,10),PKW(pB0,12),PKW(pB0,14)};pw2=(u32x4){PKW(pB1,0),PKW(pB1,2),PKW(pB1,4),PKW(pB1,6)};pw3=(u32x4){PKW(pB1,8),PKW(pB1,10),PKW(pB1,12),PKW(pB1,14)};
    SBAR(); pv(o,vb0+sl_cur,PAF(0),PAF(1),PAF(2),PAF(3)); }
  #undef PKW
  #undef PAF
  #undef VFR
  #undef PIN
  #undef MX3
  #undef GAPA
  #undef GAPB
  #undef EX
  #undef VRD
  #undef KRD
  #undef STEP
  #undef ENDW
  {auto rr=__builtin_amdgcn_permlane32_swap(__float_as_uint(l_reg),__float_as_uint(l_reg),false,false);l_reg=__uint_as_float(rr[0])+__uint_as_float(rr[1]);}
  if(hi==0)wsf[32+r32]=l_reg;asm volatile("s_waitcnt lgkmcnt(0)":::"memory");
  float rli[16];
  #pragma unroll
  for(int r=0;r<16;++r)rli[r]=__builtin_amdgcn_rcpf(wsf[32+crow(r,hi)]);
  bf16*Ow=O+(rowbase+q0+wid*QBLK)*DM+h*D;
  { bf16*stg=(bf16*)(shm+LDS_OST)+wid*2048;
    #pragma unroll
    for(int r=0;r<16;++r){const int orow=crow(r,hi);
      #pragma unroll
      for(int d0=0;d0<2;++d0)stg[orow*64+d0*32+r32]=__float2bfloat16(o[d0][r]*rli[r]);}
    asm volatile("s_waitcnt lgkmcnt(0)":::"memory");
    #pragma unroll
    for(int i=0;i<4;++i){const int row=i*8+(lane>>3),ch=lane&7; const u32x4 v=*(const u32x4*)(stg+row*64+ch*8); ATTN_STORE16(Ow+(long)row*DM+ch*8,v);} }
  asm volatile("s_waitcnt lgkmcnt(0)\n\ts_barrier":::"memory");
  #undef DMA_K
  #undef DMA_V
  #undef CMASK
  #undef CINIT
  #undef ROT
}
constexpr int ATTN_LDS_BYTES=LDS_BYTES;
struct AttnTensors { const bf16* Q; const bf16* K; const bf16* V; bf16* O; const float* CL; };
struct AttnUnit { int bh; int qb; };
struct StaticOrder {
  int vcu;
  __device__ __forceinline__ explicit StaticOrder(int v):vcu(v){}
  __device__ __forceinline__ bool next(int i,AttnUnit&u)const{ if(i>=4)return false; const int s=vcu&3; u.bh=vcu>>2; u.qb=(i==0)?15-s:(i==1)?8+s:(i==2)?7-s:s; return true; }
};
__device__ __forceinline__ int first_tile(const float*CLh,int qb,float thr,int lane){
  const float c0=CLh[qb*QB]; const float ct=CLh[lane*KVBLK+KVBLK-1];
  const unsigned long long skip=__ballot((c0-ct)<-thr);
  int t0=(int)__builtin_ctzll(~skip);
  const int cap=4*qb; t0=t0<cap?t0:cap; return __builtin_amdgcn_readfirstlane(t0&~1);
}
struct QueueOrder { unsigned* head; volatile __attribute__((address_space(3))) unsigned* slot; int batch; };
template<class Sched> __device__ __forceinline__ void attn_phase(char*lds,const AttnTensors&T,const float*THR,const Sched&S,const int tid){
  for(;;){
    if(tid==0){ const unsigned u_=__hip_atomic_fetch_add(S.head,1u,__ATOMIC_RELAXED,__HIP_MEMORY_SCOPE_AGENT); S.slot[0]=u_; }
    asm volatile("s_waitcnt vmcnt(0) lgkmcnt(0)\n\ts_barrier":::"memory");
    const unsigned ui=S.slot[0];
    asm volatile("s_waitcnt lgkmcnt(0)\n\ts_barrier":::"memory");
    if(ui>=(unsigned)(NHEAD*NQB))break;
    const int qb=NQB-1-(int)(ui>>3),h=(int)(ui&7),bh=S.batch*NHEAD+h; const float*CLh=T.CL+(size_t)bh*SEQ;
    const int T0=first_tile(CLh,qb,THR[bh],tid&63);
    attn_unit(S.batch,h,qb,T.Q,T.K,T.V,T.O,CLh,T0,lds,tid);
  }
}
#undef SBAR
#undef WAIT_BAR
}

namespace memattn {
using namespace attn_body;
typedef float f32x4_t __attribute__((ext_vector_type(4)));
constexpr int MPITCH = 512;
__device__ __forceinline__ void mem_unit(int b, int head, int qb0, int nqb, const float* MQ, const attn_body::bf16* KM, const attn_body::bf16* VM, attn_body::bf16* MO, const float* mqg, char* shm, const int tid) {
    const int lane = tid & 63, r32 = lane & 31, hi = lane >> 5; const int wid = __builtin_amdgcn_readfirstlane(tid >> 6);
    const unsigned lds0 = (unsigned)(uintptr_t)shm;
    const attn_body::bf16* Kh = KM + (size_t)b * 256 * MPITCH + head * 128; const attn_body::bf16* Vh = VM + (size_t)b * 256 * MPITCH + head * 128;
#pragma unroll
    for (int t = 0; t < 4; ++t)
#pragma unroll
        for (int pp = 0; pp < 2; ++pp) { const int p = wid + 8 * pp;
            glds16(Kh + (size_t)(64 * t + lane) * MPITCH + p * 8, (unsigned)__builtin_amdgcn_readfirstlane(lds0 + t * 32768 + p * 1024));
            glds16(Vh + (size_t)(64 * t + 16 * (p & 3) + (lane >> 2)) * MPITCH + (p >> 2) * 32 + (lane & 3) * 8, (unsigned)__builtin_amdgcn_readfirstlane(lds0 + t * 32768 + 16384 + p * 1024)); }
    const lds_cptr shm3 = (lds_cptr)shm;
    const lds_cptr kp0 = shm3 + hi * 1024 + r32 * 16;
    const lds_cptr vp0 = shm3 + 16384 + ((lane >> 4) & 1) * 32 + (lane & 3) * 8 + (4 * hi + ((lane & 15) >> 2)) * 64;
    asm volatile("s_waitcnt vmcnt(0) lgkmcnt(0)\n\ts_barrier" ::: "memory");
    for (int qi = 0; qi < nqb; ++qi) {
        const size_t row0 = (size_t)b * ::SEQ + (size_t)(qb0 + qi) * 256 + wid * 32;
        bf16x8 qr[8];
        { f32x4_t x[8][2]; float ss = 0.f; const unsigned short* qp = (const unsigned short*)MQ + (row0 + r32) * MPITCH + head * 128 + 8 * hi;
#pragma unroll
          for (int d0 = 0; d0 < 8; ++d0) { const u32x4 w = *(const u32x4*)(qp + 16 * d0);
              x[d0][0] = (f32x4_t){__uint_as_float(w.x << 16), __uint_as_float(w.x & 0xffff0000u), __uint_as_float(w.y << 16), __uint_as_float(w.y & 0xffff0000u)}; x[d0][1] = (f32x4_t){__uint_as_float(w.z << 16), __uint_as_float(w.z & 0xffff0000u), __uint_as_float(w.w << 16), __uint_as_float(w.w & 0xffff0000u)};
#pragma unroll
              for (int j = 0; j < 4; ++j) ss += x[d0][0][j] * x[d0][0][j] + x[d0][1][j] * x[d0][1][j]; }
          { auto rr = __builtin_amdgcn_permlane32_swap(__float_as_uint(ss), __float_as_uint(ss), false, false); ss = __uint_as_float(rr[0]) + __uint_as_float(rr[1]); }
          const float rstd = C2M / sqrtf(ss * (1.0f / 128.0f) + EPS);
#pragma unroll
          for (int d0 = 0; d0 < 8; ++d0) { const f32x4_t a = x[d0][0] * rstd * *(const f32x4_t*)(mqg + 16 * d0 + 8 * hi), c = x[d0][1] * rstd * *(const f32x4_t*)(mqg + 16 * d0 + 8 * hi + 4);
              u32x4 w; w.x = cvtpk_s(a[0], a[1]); w.y = cvtpk_s(a[2], a[3]); w.z = cvtpk_s(c[0], c[1]); w.w = cvtpk_s(c[2], c[3]); qr[d0] = __builtin_bit_cast(bf16x8, w); } }
        f32x16 o[4]; o[0] = f32x16{}; o[1] = f32x16{}; o[2] = f32x16{}; o[3] = f32x16{}; float l_reg = 0.f;
#pragma unroll 1
        for (int t = 0; t < 4; ++t) {
            const lds_cptr kp = kp0 + t * 32768; f32x16 p0 = f32x16{}, p1 = f32x16{};
#pragma unroll
            for (int d0 = 0; d0 < 8; ++d0) { const bf16x8 b0 = *(const __attribute__((address_space(3))) bf16x8*)(kp + d0 * 2048), b1 = *(const __attribute__((address_space(3))) bf16x8*)(kp + d0 * 2048 + 512);
                p0 = __builtin_amdgcn_mfma_f32_32x32x16_bf16(b0, qr[d0], p0, 0, 0, 0); p1 = __builtin_amdgcn_mfma_f32_32x32x16_bf16(b1, qr[d0], p1, 0, 0, 0); }
            float sacc = 0.f;
#pragma unroll
            for (int r = 0; r < 16; ++r) { p0[r] = __builtin_amdgcn_exp2f(p0[r]); p1[r] = __builtin_amdgcn_exp2f(p1[r]); sacc += p0[r] + p1[r]; }
            l_reg += sacc;
            u32x4 pw0, pw1, pw2, pw3;
            pw0 = (u32x4){cvtpk_s(p0[0], p0[1]), cvtpk_s(p0[2], p0[3]), cvtpk_s(p0[4], p0[5]), cvtpk_s(p0[6], p0[7])}; pw1 = (u32x4){cvtpk_s(p0[8], p0[9]), cvtpk_s(p0[10], p0[11]), cvtpk_s(p0[12], p0[13]), cvtpk_s(p0[14], p0[15])};
            pw2 = (u32x4){cvtpk_s(p1[0], p1[1]), cvtpk_s(p1[2], p1[3]), cvtpk_s(p1[4], p1[5]), cvtpk_s(p1[6], p1[7])}; pw3 = (u32x4){cvtpk_s(p1[8], p1[9]), cvtpk_s(p1[10], p1[11]), cvtpk_s(p1[12], p1[13]), cvtpk_s(p1[14], p1[15])};
            const lds_cptr vp = vp0 + t * 32768;
#pragma unroll
            for (int d0 = 0; d0 < 4; ++d0) {
#pragma unroll
                for (int ks = 0; ks < 4; ++ks) { const s16x4 lo = vtr(vp + d0 * 4096 + ks * 1024), hh = vtr(vp + d0 * 4096 + ks * 1024 + 512);
                    const bf16x8 vf = (bf16x8){lo[0], lo[1], lo[2], lo[3], hh[0], hh[1], hh[2], hh[3]};
                    const bf16x8 pa = ks == 0 ? __builtin_bit_cast(bf16x8, pw0) : (ks == 1 ? __builtin_bit_cast(bf16x8, pw1) : (ks == 2 ? __builtin_bit_cast(bf16x8, pw2) : __builtin_bit_cast(bf16x8, pw3)));
                    o[d0] = __builtin_amdgcn_mfma_f32_32x32x16_bf16(pa, vf, o[d0], 0, 0, 0); } }
        }
        { auto rr = __builtin_amdgcn_permlane32_swap(__float_as_uint(l_reg), __float_as_uint(l_reg), false, false); l_reg = __uint_as_float(rr[0]) + __uint_as_float(rr[1]); }
        const float il = __builtin_amdgcn_rcpf(l_reg);
        { const lds_cptr stg = shm3 + STG_OFF + wid * (16 * 144); float ilr[16];
#pragma unroll
          for (int r = 0; r < 16; ++r) ilr[r] = shl(il, crow(r, hi));
          attn_body::bf16* Ob = MO + row0 * MPITCH + head * 128;
#pragma unroll
          for (int rh = 0; rh < 2; ++rh)
#pragma unroll
              for (int chh = 0; chh < 2; ++chh) {
#pragma unroll
                  for (int r8 = 0; r8 < 8; ++r8) { const int r = 8 * rh + r8; const int rowl = crow(r, hi) - 16 * rh;
#pragma unroll
                      for (int dd = 0; dd < 2; ++dd) { const float v = o[2 * chh + dd][r] * ilr[r];
                          *(__attribute__((address_space(3))) unsigned short*)(stg + rowl * 144 + (32 * dd + r32) * 2) = (unsigned short)(cvtpk_s(v, v) & 0xffffu); } }
                  const int rr = lane >> 3, ch = lane & 7;
                  const u32x4 a = *(const __attribute__((address_space(3))) u32x4*)(stg + rr * 144 + ch * 16), b = *(const __attribute__((address_space(3))) u32x4*)(stg + (rr + 8) * 144 + ch * 16);
                  *(u32x4*)(Ob + (size_t)(16 * rh + rr) * MPITCH + 64 * chh + ch * 8) = a; *(u32x4*)(Ob + (size_t)(16 * rh + rr + 8) * MPITCH + 64 * chh + ch * 8) = b; } }
    }
    asm volatile("s_waitcnt lgkmcnt(0)\n\ts_barrier" ::: "memory");
}
}

#ifndef PROBE_PHASE
#define PROBE_PHASE (-1)
#endif
struct MemKvOrder {
    int G, c;
    __device__ __forceinline__ bool next(int i, pg8::Unit& u) const { const int L = i * G + c; if (L >= 64) return false; const int l = L >> 5, r = L & 31; u.pm = 8 * l + (r >> 2); u.pn = r & 3; u.aux = l; return true; }
    __device__ __forceinline__ void ptrs(const pg8::Gemm& g, const pg8::Unit& u, const char*& a, const char*& b) const {
        a = (const char*)g.A + (size_t)u.pm * (size_t)(256 * 2) * g.K; b = (const char*)g.Bt + (size_t)u.aux * (size_t)(1024 * 1024 * 2) + (size_t)u.pn * (size_t)(256 * 2) * g.K; }
    __device__ __forceinline__ void a_ready(const pg8::Unit&) const {}
    __device__ __forceinline__ void done(const pg8::Unit&) const {}
};

__global__ void __launch_bounds__(NTHREADS, 2) mk_fwd(Args args) {
    extern __shared__ __attribute__((aligned(16))) unsigned char lds[];
    Frame F;
    F.lds = (LAS unsigned char*)lds; F.MISC = (volatile LAS unsigned*)(F.lds + MISC_OFF);
    F.tid = threadIdx.x; F.lane = F.tid & 63; F.wave = __builtin_amdgcn_readfirstlane(F.tid >> 6);
    F.G = gridDim.x; { const int bx = blockIdx.x; F.vcu = (F.G % 8 == 0) ? (bx % 8) * (F.G / 8) + bx / 8 : bx; }
    F.ws = args.ws; F.ctl = (gu32*)(args.ws + WS_CTL); F.X = args.out;
    for (int u = F.tid; u < (LDS_BYTES - LDSCTL_OFF) / 4; u += NTHREADS) ((LAS unsigned*)(F.lds + LDSCTL_OFF))[u] = 0u;
    __syncthreads();
    (void)xcd_barrier_post((unsigned*)(F.ctl + CW_BAR), F.MISC + 8);
    unsigned long long t0_ = 0ull;
#define REFRESH() do { int w_ = F.wave; asm volatile("" : "+s"(w_)); F.wave = w_; int l_; asm volatile("v_mbcnt_lo_u32_b32 %0, -1, 0\n\tv_mbcnt_hi_u32_b32 %0, -1, %0" : "=v"(l_)); F.lane = l_; F.tid = w_ * 64 + l_; \
    int v_ = F.vcu; asm volatile("" : "+s"(v_)); F.vcu = v_; \
    GAS unsigned char* g_ = (GAS unsigned char*)F.ws; asm volatile("" : "+s"(g_)); F.ws = (unsigned char*)g_; GAS float* x_ = (GAS float*)F.X; asm volatile("" : "+s"(x_)); F.X = (float*)x_; } while (0)
#define SEAM(k) do { if (PROBE_PHASE >= 0 && PROBE_PHASE == (k)) { const unsigned long long n_ = __builtin_amdgcn_s_memrealtime(), d_ = n_ - t0_; while (__builtin_amdgcn_s_memrealtime() - n_ < d_) __builtin_amdgcn_s_sleep(8); } \
    XcdBarrier b_; b_.bar = (unsigned*)(F.ws + WS_CTL) + CW_BAR; b_.x = xb_xcc_id(); b_.st = (volatile LAS unsigned*)(F.lds + MISC_OFF) + 8; xcd_barrier(b_); REFRESH(); \
    if (PROBE_PHASE >= 0) t0_ = __builtin_amdgcn_s_memrealtime(); } while (0)
    { volatile LAS unsigned long long* PT = (volatile LAS unsigned long long*)(F.lds + PTR_OFF);
      if (F.tid == 0) {
#define PUT_(i) PT[i] = (unsigned long long)(uintptr_t)args.in[i];
        PUT_(0) PUT_(1) PUT_(2) PUT_(3) PUT_(4) PUT_(5) PUT_(6) PUT_(7) PUT_(8) PUT_(9) PUT_(10) PUT_(11) PUT_(12) PUT_(13) PUT_(14) PUT_(15) PUT_(16) PUT_(17) PUT_(18) PUT_(19) PUT_(20) PUT_(21) PUT_(22) PUT_(23)
#undef PUT_
      }
      __syncthreads(); }
#define INP(i) inptr(F, (i))
#ifndef DUP_PHASE
#define DUP_PHASE (-1)
#endif
#define RUN(k, ...) do { __VA_ARGS__ if (DUP_PHASE >= 0 && DUP_PHASE == (k)) { SEAM(99); __VA_ARGS__ } } while (0)
#define WSP (F.ws)
#define XBP ((bf16*)((unsigned char*)F.X + 64 * MiB))
#define ARP (F.ws + WS_AR)
#ifndef STAG_G
#define STAG_G 1
#define STAG_US 8
#endif
#define STAGGER() do { if (STAG_G > 1) { const unsigned long long s0_ = __builtin_amdgcn_s_memrealtime(), sd_ = (unsigned long long)(((bx >> 3) % STAG_G) * STAG_US * 100); while (__builtin_amdgcn_s_memrealtime() - s0_ < sd_) __builtin_amdgcn_s_sleep(4); } } while (0)
    LAS unsigned char* const ring = F.lds + RING_OFF;
    const int bx = (int)blockIdx.x;
    if (PROBE_PHASE >= 0) t0_ = __builtin_amdgcn_s_memrealtime();

    conv_phase(F); REFRESH();
    memnorm_phase(F, INP(I_MEM), INP(I_MEMG)); SEAM(0);

#pragma unroll 1
    for (int l = 0; l < DEPTH; ++l) {
        REFRESH();
        const int pb = 16 * l;
        const float* xin = (l == 0) ? INP(I_X) : (const float*)XBP;
        if (l == 0) {
            if (bx < 64) { pg8::Gemm g{(const bf16*)(WSP + WS_MEMN), (const bf16*)(WSP + W_KV), DEPTH * MROWS, 1024, D}; MemKvOrder S{F.G, bx};
                pg8::EpiF32 E{(float*)(WSP + WS_KVF), 1024, nullptr, F.lds + STG_OFF};
                pg8::gemm_phase<pg8::EpiF32, MemKvOrder, true, true, false>(ring, g, S, E, F.tid); }
            else norm_phase<1>(F, xin, INP(I_MIXG) + l * D, INP(I_WIN) + (size_t)l * D * NIN + OFF_F, NIN, INP(I_BF) + l * FH, (bf16*)(WSP + WS_H), (bx - 64) * NWAVES + F.wave, (F.G - 64) * NWAVES);
        } else
            norm_phase<1, true>(F, xin, INP(I_MIXG) + l * D, INP(I_WIN) + (size_t)l * D * NIN + OFF_F, NIN, INP(I_BF) + l * FH, (bf16*)(WSP + WS_H), F.vcu * NWAVES + F.wave, F.G * NWAVES);
        SEAM(pb + 3);
        if (l == 0) { kvfin_phase(F, INP(I_MKG)); REFRESH(); }
        cumsum_phase(F, INP(I_FQG) + l * FD, INP(I_FKG) + l * FD); REFRESH();
        if (DUP_PHASE == 105 && l == 0) { pg8::Gemm g{(const bf16*)(WSP + WS_H), (const bf16*)(WSP + W_IN) + (size_t)l * 5632 * 1024, T, 5632, D}; pg8::StaticOrder S; S.init(T, 5632, F.G, bx);
          pg8::EpiInProjT<false> E{ARP, INP(I_FQG) + l * FD, INP(I_FKG) + l * FD, F.lds + STG_OFF};
          pg8::gemm_phase<pg8::EpiInProjT<false>, pg8::StaticOrder, true, true>(ring, g, S, E, F.tid); SEAM(99); }
        if (DUP_PHASE == 104 && l == 0) { pg8::Gemm g{(const bf16*)(WSP + WS_H), (const bf16*)(WSP + W_IN) + (size_t)l * 5632 * 1024, T, 5632, D}; pg8::StaticOrder S; S.init(T, 5632, F.G, bx);
          pg8::EpiNull E{}; pg8::gemm_phase<pg8::EpiNull, pg8::StaticOrder, true, true>(ring, g, S, E, F.tid); SEAM(99); }
        STAGGER(); RUN(pb + 4, { pg8::Gemm g{(const bf16*)(WSP + WS_H), (const bf16*)(WSP + W_IN + (size_t)l * 5632 * 1024), T, 5632, D / 2}; pg8::StaticOrder S; S.init(T, 5632, F.G, bx);
          pg8::EpiInProj8 E{ARP, INP(I_FQG) + l * FD, INP(I_FKG) + l * FD, F.lds + STG_OFF};
          pg8::gemm_phase<pg8::EpiInProj8, pg8::StaticOrder, true, true, true, 2>(ring, g, S, E, F.tid); });
        SEAM(pb + 4);
        pool_phase(F); REFRESH();
        { const int combo = F.vcu >> 3;
          memattn::mem_unit(combo >> 2, combo & 3, 2 * (F.vcu & 7), 2, (const float*)(ARP + AR_MQ), (const attn_body::bf16*)(WSP + WS_KM) + (size_t)l * MROWS * 512, (const attn_body::bf16*)(WSP + WS_VM) + (size_t)l * MROWS * 512,
                            (attn_body::bf16*)(ARP + AR_MO), INP(I_MQG) + l * MD, (char*)lds + RING_OFF, F.tid); }
        REFRESH();
        { static_assert(attn_body::LDS_BYTES_ALL <= RING_BYTES, "attention LDS");
          const attn_body::AttnTensors AT{(const attn_body::bf16*)(ARP + AR_Q), (const attn_body::bf16*)(ARP + AR_K), (const attn_body::bf16*)(ARP + AR_V), (attn_body::bf16*)(ARP + AR_Q), (const float*)(WSP + WS_CL)};
          attn_body::QueueOrder S; S.head = (unsigned*)(WSP + WS_CTL) + CW_ATTQ + 64 * (l * 8 + (F.vcu >> 5)); S.slot = (volatile LAS unsigned*)(F.lds + MISC_OFF) + 16; S.batch = F.vcu >> 5;
          attn_body::attn_phase<attn_body::QueueOrder>((char*)lds + RING_OFF, AT, (const float*)(WSP + WS_THR), S, F.tid); }
        SEAM(pb + 5);
        RUN(pb + 6, { pg8::Gemm g{nullptr, nullptr, T, 1024, 512}; typedef pg8::MergeOrder<AR_PD, AR_Q, AR_MO> MOrd; MOrd S; S.so.init(T, 1024, F.G, bx);
          S.arena = (const char*)ARP; S.Bbase = (const char*)(WSP + W_BR) + (size_t)(l * 3) * 1024 * 512 * 2;
          pg8::EpiMerge E{(const bf16*)(ARP + AR_G), (bf16*)(WSP + WS_H), F.lds + STG_OFF};
          pg8::gemm_phase<pg8::EpiMerge, MOrd, true, true>(ring, g, S, E, F.tid); });
        SEAM(pb + 6);
        if (l == 0) { pg8::Gemm g{(const bf16*)(WSP + WS_H), (const bf16*)(WSP + W_OUT) + (size_t)l * 1024 * 1024, T, 1024, D}; pg8::StaticOrder S; S.init(T, 1024, F.G, bx);
          pg8::EpiResBf16<true, true> E{XBP, xin, F.lds + STG_OFF, (float*)(WSP + WS_SSQ), WSP + WS_XB8, 1.0f};
          pg8::gemm_phase<pg8::EpiResBf16<true, true>, pg8::StaticOrder, true, true, false>(ring, g, S, E, F.tid);
        } else { pg8::Gemm g{(const bf16*)(WSP + WS_H), (const bf16*)(WSP + W_OUT) + (size_t)l * 1024 * 1024, T, 1024, D}; pg8::StaticOrder S; S.init(T, 1024, F.G, bx);
          pg8::EpiResBf16<false> E{XBP, XBP, F.lds + STG_OFF, nullptr, nullptr, 1.0f};
          pg8::gemm_phase<pg8::EpiResBf16<false>, pg8::StaticOrder, true, true, false>(ring, g, S, E, F.tid); }
        SEAM(pb + 7);
        if (l == 0) {
            REFRESH();
            STAGGER(); RUN(pb + 9, { pg8::Gemm g{(const bf16*)(WSP + WS_XB8), (const bf16*)(WSP + W_GU), T, 2 * DFF, D / 2}; pg8::StaticOrder S; S.init(T, 2 * DFF, F.G, bx);
              pg8::EpiSwiGLUT<true, true, 2> E{(bf16*)(ARP + AR_ACT), DFF, (const float*)(WSP + WS_SSQ)};
              pg8::gemm_phase<pg8::EpiSwiGLUT<true, true, 2>, pg8::StaticOrder, true, true, true, 2>(ring, g, S, E, F.tid); });
            SEAM(pb + 9);
            { pg8::Gemm g{(const bf16*)(ARP + AR_ACT), (const bf16*)(WSP + W_DN), T, 1024, DFF / 2}; pg8::StaticOrder S; S.init(T, 1024, F.G, bx);
              pg8::EpiResBf16<false> E{XBP, XBP, F.lds + STG_OFF, nullptr, nullptr, 1.0f / (F8_ACT * F8_WDN)};
              pg8::gemm_phase<pg8::EpiResBf16<false>, pg8::StaticOrder, true, true, false, 1>(ring, g, S, E, F.tid); }
            SEAM(pb + 10);
        } else {
            REFRESH();
            norm_phase<2, true>(F, (const float*)XBP, INP(I_FFNG) + l * D, INP(I_WR), NE, INP(I_BR), (bf16*)(WSP + WS_H2), F.vcu * NWAVES + F.wave, F.G * NWAVES); SEAM(pb + 8);
            moe_scatter_phase(F, (const unsigned char*)(WSP + WS_H2)); SEAM(pb + 11);
            const int ntile = __builtin_amdgcn_readfirstlane(((const int*)(WSP + WS_META))[0]);
            { volatile LAS int* te = (volatile LAS int*)(F.lds + TILE_OFF); const int* tg = (const int*)(WSP + WS_META) + 16; if (F.tid < MAXTILES) te[F.tid] = tg[F.tid]; __syncthreads(); }
            const volatile LAS int* tile_e = (const volatile LAS int*)(F.lds + TILE_OFF);
            STAGGER(); RUN(pb + 12, { pg8::Gemm g{(const bf16*)(WSP + WS_HS), (const bf16*)(WSP + W_EGU), ntile * 256, 2 * DEXP, D / 2}; pg8::GroupedOrder S; S.so.init(ntile * 256, 2 * DEXP, F.G, bx); S.tile_e = tile_e; S.bstride = (size_t)2 * DEXP * D;
              pg8::EpiSwiGLU8 E{(bf16*)(WSP + WS_ACTE), DEXP, nullptr};
              pg8::gemm_phase<pg8::EpiSwiGLU8, pg8::GroupedOrder, true, true, true, 2>(ring, g, S, E, F.tid); });
            SEAM(pb + 9);
            RUN(pb + 13, { pg8::Gemm g{(const bf16*)(WSP + WS_ACTE), (const bf16*)(WSP + W_EDN), pg8::TAIL_T0 * 256, 1024, DEXP / 2}; pg8::GroupedOrder S; S.so.init(pg8::TAIL_T0 * 256, 1024, F.G, bx); S.tile_e = tile_e; S.bstride = (size_t)DEXP * D;
              pg8::EpiBf16P E{(bf16*)(WSP + WS_YB), 1024, F.lds + STG_OFF, 1.0f / (F8_ACT * F8_WDN)};
              pg8::gemm_phase<pg8::EpiBf16P, pg8::GroupedOrder, true, true, true, 1>(ring, g, S, E, F.tid); });
            REFRESH();
            { pg8::Gemm g{(const bf16*)(WSP + WS_ACTE), (const bf16*)(WSP + W_EDN), 0, 1024, DEXP / 2, pg8::TAIL_NTK}; pg8::TailOrder S{(ntile - pg8::TAIL_T0) * 4 * pg8::TAIL_KS, F.G, bx, tile_e, (size_t)DEXP * D};
              pg8::EpiF32 E{(float*)(WSP + WS_PART), 1024, nullptr, F.lds + STG_OFF, 1.0f / (F8_ACT * F8_WDN)};
              pg8::gemm_phase<pg8::EpiF32, pg8::TailOrder, true, true, false, 1>(ring, g, S, E, F.tid); }
            REFRESH();
            { const int lane = F.lane, gw = F.vcu * NWAVES + F.wave, NGW = F.G * NWAVES; v4u xr[16][2];
#pragma unroll
              for (int i = 0; i < 16; ++i) { const bf16* xp = XBP + (size_t)(gw + i * NGW) * D + 16 * lane; xr[i][0] = *(const v4u*)xp; xr[i][1] = *(const v4u*)(xp + 8); }
              SEAM(pb + 10);
              const bf16* YB = (const bf16*)(WSP + WS_YB); const float* PART = (const float*)(WSP + WS_PART);
#pragma unroll
              for (int i = 0; i < 16; ++i) { const int m = gw + i * NGW; const Choice c = ((const Choice*)(WSP + WS_CHOICE))[m]; const int* sl = (const int*)(WSP + WS_SLOT) + 2 * m; const int s1 = __builtin_amdgcn_readfirstlane(sl[0]), s2 = __builtin_amdgcn_readfirstlane(sl[1]);
                  float* op = F.X + (size_t)m * D + 16 * lane;
#pragma unroll
                  for (int h = 0; h < 2; ++h) { const v4u x = xr[i][h]; f32x4 ya[2], yb[2];
                      yrow(YB, PART, s1, 16 * lane + 8 * h, ya); yrow(YB, PART, s2, 16 * lane + 8 * h, yb);
                      f32x4 o0, o1;
#pragma unroll
                      for (int q = 0; q < 2; ++q) { o0[2 * q] = bf2f(x[q] & 0xffffu) + c.w1 * ya[0][2 * q] + c.w2 * yb[0][2 * q]; o0[2 * q + 1] = bf2f(x[q] >> 16) + c.w1 * ya[0][2 * q + 1] + c.w2 * yb[0][2 * q + 1];
                          o1[2 * q] = bf2f(x[2 + q] & 0xffffu) + c.w1 * ya[1][2 * q] + c.w2 * yb[1][2 * q]; o1[2 * q + 1] = bf2f(x[2 + q] >> 16) + c.w1 * ya[1][2 * q + 1] + c.w2 * yb[1][2 * q + 1]; }
                      *(f32x4*)(op + 8 * h) = o0; *(f32x4*)(op + 8 * h + 4) = o1; } } }
        }
    }
}

#undef WSP
#undef ARP
extern "C" void kernel_launch(void* const* d_in, const int* in_sizes, int n_in, void* d_out, int out_size, void* d_ws, size_t ws_size, hipStream_t stream) {
    static int grid = 0;
    if (grid == 0) {
        if (n_in != N_IN_ || in_sizes[0] != T * D || out_size != T * D || ws_size < WS_END) {
            fprintf(stderr, "kernel_launch: unexpected shapes: n_in %d in0 %d out %d ws %zu (need %zu)\n", n_in, n_in > 0 ? in_sizes[0] : -1, out_size, ws_size, (size_t)WS_END); grid = -1; return; }
        int dev = 0, cus = 0, per_cu = 0;
        if (hipGetDevice(&dev) != hipSuccess || hipDeviceGetAttribute(&cus, hipDeviceAttributeMultiprocessorCount, dev) != hipSuccess) { grid = -1; return; }
        if (hipFuncSetAttribute((const void*)mk_fwd, hipFuncAttributeMaxDynamicSharedMemorySize, LDS_BYTES) != hipSuccess) { fprintf(stderr, "kernel_launch: hipFuncSetAttribute failed\n"); grid = -1; return; }
        if (hipOccupancyMaxActiveBlocksPerMultiprocessor(&per_cu, (const void*)mk_fwd, NTHREADS, LDS_BYTES) != hipSuccess || per_cu < 1) { fprintf(stderr, "kernel_launch: occupancy query says %d\n", per_cu); }
        (void)hipGetLastError();
        if (cus < 256) { fprintf(stderr, "kernel_launch: built for 256 CUs, found %d\n", cus); grid = -1; return; }
        grid = 256;
    }
    if (grid < 0) return;
    if (hipMemsetAsync((char*)d_ws + WS_CTL, 0, CTL_ZERO_BYTES, stream) != hipSuccess) return;
    Args a{};
    for (int i = 0; i < N_IN_; ++i) a.in[i] = (const float*)d_in[i];
    a.out = (float*)d_out; a.ws = (unsigned char*)d_ws; a.ph_lo = 0; a.ph_hi = 0;
    hipLaunchKernelGGL(mk_fwd, dim3(grid), dim3(NTHREADS), LDS_BYTES, stream, a);
}
```
